# Optimizing an MI355X kernel written in HIP

```python
import jax, jax.numpy as jnp
from jax import lax
import numpy as np

D_MODEL = 1024
BATCH = 16
SEQ = 2048
DEPTH = 4

D_MIX = D_MODEL
POOL_WIDTH = D_MIX // 4
POOL_WINDOWS = (2, 4, 8, 16)
POOL_GROUP = POOL_WIDTH // len(POOL_WINDOWS)
QK_NOPE = 128
QK_ROPE = 64
V_HEAD = 128
ATTN_WIDTH = D_MIX - POOL_WIDTH
N_HEADS = ATTN_WIDTH // V_HEAD
Q_LORA = 384
KV_LORA = 256
IN_WIDTH = POOL_WIDTH + Q_LORA + KV_LORA + QK_ROPE
ROPE_THETA = 10000.0
Q_BLOCK = 128
N_EXPERTS = 64
TOP_K = 8
N_GROUPS = 8
TOPK_GROUPS = 4
D_EXPERT = D_MODEL // 4
ROUTED_SCALE = 2.5
DISPATCH_BLOCK = 256
DEEPNORM_ALPHA = (2.0 * DEPTH) ** 0.25
DEEPNORM_BETA = (8.0 * DEPTH) ** -0.25
LN_EPS = 1e-5
RMS_EPS = 1e-6

kernel_name = "hybrid_pool_mla_moe_deepnorm_adaln"


def layer_norm(x, g, b):
    xf = x.astype(jnp.float32)
    mu = xf.mean(-1, keepdims=True)
    var = jnp.square(xf - mu).mean(-1, keepdims=True)
    return ((xf - mu) * lax.rsqrt(var + LN_EPS) * g.astype(jnp.float32) + b.astype(jnp.float32)).astype(x.dtype)


def rms_norm(x, g):
    xf = x.astype(jnp.float32)
    return (xf * lax.rsqrt(jnp.mean(xf * xf, -1, keepdims=True) + RMS_EPS) * g.astype(jnp.float32)).astype(x.dtype)


def apply_rope(x, positions):
    half = QK_ROPE // 2
    inv_freq = ROPE_THETA ** (-jnp.arange(half, dtype=jnp.float32) / half)
    ang = positions.astype(jnp.float32)[..., None] * inv_freq
    cos, sin = jnp.cos(ang), jnp.sin(ang)
    if x.ndim == 4:
        cos, sin = cos[:, :, None, :], sin[:, :, None, :]
    xf = x.astype(jnp.float32)
    x1, x2 = xf[..., :half], xf[..., half:]
    return jnp.concatenate([x1 * cos - x2 * sin, x2 * cos + x1 * sin], axis=-1).astype(x.dtype)


def causal_pool_mixer(u, w_pool, pool_scale):
    S = u.shape[1]
    uf = u.astype(jnp.float32)
    t = jnp.arange(S)
    outs = []
    for gi, w in enumerate(POOL_WINDOWS):
        ug = uf[..., gi * POOL_GROUP:(gi + 1) * POOL_GROUP]
        cs = jnp.cumsum(ug, axis=1)
        lagged = jnp.pad(cs, ((0, 0), (w, 0), (0, 0)))[:, :S]
        count = jnp.minimum(t + 1, w).astype(jnp.float32)[None, :, None]
        token_mix = (cs - lagged) / count - ug
        outs.append(jnp.einsum('bsc,cd->bsd', token_mix.astype(u.dtype), w_pool[gi]))
    return jnp.concatenate(outs, axis=-1) * pool_scale


def mla_mixer(q_lat, kv_lat, k_rope, positions, q_norm_g, kv_norm_g, w_uq, w_ukv):
    B, S, _ = q_lat.shape
    q = (rms_norm(q_lat, q_norm_g) @ w_uq).reshape(B, S, N_HEADS, QK_NOPE + QK_ROPE)
    q_nope, q_rope = q[..., :QK_NOPE], apply_rope(q[..., QK_NOPE:], positions)
    kv = (rms_norm(kv_lat, kv_norm_g) @ w_ukv).reshape(B, S, N_HEADS, QK_NOPE + V_HEAD)
    k_nope, v = kv[..., :QK_NOPE], kv[..., QK_NOPE:]
    k_rope = apply_rope(k_rope, positions)
    scale = (QK_NOPE + QK_ROPE) ** -0.5
    outs = []
    for i in range(S // Q_BLOCK):
        q0, q1 = i * Q_BLOCK, (i + 1) * Q_BLOCK
        s = (jnp.einsum('bqhd,bkhd->bhqk', q_nope[:, q0:q1], k_nope[:, :q1])
             + jnp.einsum('bqhr,bkr->bhqk', q_rope[:, q0:q1], k_rope[:, :q1])).astype(jnp.float32) * scale
        causal = jnp.arange(q0, q1)[:, None] >= jnp.arange(q1)[None, :]
        p = jax.nn.softmax(jnp.where(causal, s, -jnp.inf), axis=-1).astype(v.dtype)
        outs.append(jnp.einsum('bhqk,bkhd->bqhd', p, v[:, :q1]))
    return jnp.concatenate(outs, axis=1).reshape(B, S, ATTN_WIDTH)


def swiglu(x, w_gate, w_up, w_down):
    return (jax.nn.silu(x @ w_gate) * (x @ w_up)) @ w_down


def route(ht, w_router, router_bias):
    T = ht.shape[0]
    scores = jax.nn.sigmoid(ht.astype(jnp.float32) @ w_router.astype(jnp.float32))
    choice = (scores + router_bias.astype(jnp.float32)).reshape(T, N_GROUPS, N_EXPERTS // N_GROUPS)
    group_score = lax.top_k(choice, 2)[0].sum(-1)
    _, top_groups = lax.top_k(group_score, TOPK_GROUPS)
    group_mask = jax.nn.one_hot(top_groups, N_GROUPS, dtype=jnp.float32).sum(1) > 0
    masked = jnp.where(group_mask[:, :, None], choice, -jnp.inf).reshape(T, N_EXPERTS)
    _, idx = lax.top_k(masked, TOP_K)
    w = jnp.take_along_axis(scores, idx, axis=-1)
    w = w / w.sum(-1, keepdims=True) * ROUTED_SCALE
    return idx, w


def routed_moe(h, w_router, router_bias, w_gate, w_up, w_down):
    B, S, D = h.shape
    T = B * S
    ht = h.reshape(T, D)
    idx, gates = route(ht, w_router, router_bias)
    A = T * TOP_K
    flat_e = idx.reshape(A)
    flat_tok = (jnp.arange(A) // TOP_K).astype(jnp.int32)
    flat_g = gates.reshape(A)
    order = jnp.argsort(flat_e)
    e_sorted = flat_e[order]
    counts = jnp.bincount(flat_e, length=N_EXPERTS)
    start = jnp.cumsum(counts) - counts
    padded = (counts + DISPATCH_BLOCK - 1) // DISPATCH_BLOCK * DISPATCH_BLOCK
    pad_end = jnp.cumsum(padded)
    pad_start = pad_end - padded
    dest = pad_start[e_sorted] + (jnp.arange(A) - start[e_sorted])
    P = (-(-A // DISPATCH_BLOCK) + N_EXPERTS) * DISPATCH_BLOCK
    NB = P // DISPATCH_BLOCK
    buf_tok = jnp.zeros((P,), jnp.int32).at[dest].set(flat_tok[order])
    buf_gate = jnp.zeros((P,), jnp.float32).at[dest].set(flat_g[order])
    blk_expert = jnp.minimum(jnp.searchsorted(pad_end, jnp.arange(NB) * DISPATCH_BLOCK, side='right'),
                             N_EXPERTS - 1)

    def expert_block(acc, xs):
        e, tok, g = xs
        y = swiglu(ht[tok], w_gate[e], w_up[e], w_down[e])
        return acc.at[tok].add(g[:, None] * y.astype(jnp.float32)), None

    acc, _ = lax.scan(expert_block, jnp.zeros((T, D), jnp.float32),
                      (blk_expert, buf_tok.reshape(NB, DISPATCH_BLOCK), buf_gate.reshape(NB, DISPATCH_BLOCK)))
    return acc.astype(h.dtype).reshape(B, S, D)


def setup_inputs(seed: int = 0) -> dict:
    key = jax.random.key(seed)
    ks = jax.random.split(key, 26)
    L, D, E, F = DEPTH, D_MODEL, N_EXPERTS, D_EXPERT

    def nrm(k, shape, scale):
        return jax.random.normal(k, shape, jnp.float32) * scale

    return {
        "x": nrm(ks[0], (BATCH, SEQ, D), 1.0),
        "c": nrm(ks[1], (BATCH, D), 1.0),
        "positions": (jnp.arange(SEQ, dtype=jnp.int32)[None, :]
                      + jax.random.randint(ks[2], (BATCH, 1), 0, 4096, dtype=jnp.int32)),
        "w_ada": nrm(ks[3], (L, D, 6 * D), D ** -0.5),
        "b_ada": nrm(ks[4], (L, 6 * D), 0.01),
        "w_in": nrm(ks[5], (L, D, IN_WIDTH), D ** -0.5),
        "q_norm_g": 1.0 + nrm(ks[6], (L, Q_LORA), 0.01),
        "kv_norm_g": 1.0 + nrm(ks[7], (L, KV_LORA), 0.01),
        "w_uq": nrm(ks[8], (L, Q_LORA, N_HEADS * (QK_NOPE + QK_ROPE)), Q_LORA ** -0.5),
        "w_ukv": nrm(ks[9], (L, KV_LORA, N_HEADS * (QK_NOPE + V_HEAD)), KV_LORA ** -0.5),
        "w_pool": nrm(ks[10], (L, len(POOL_WINDOWS), POOL_GROUP, POOL_GROUP), POOL_GROUP ** -0.5),
        "pool_scale": 1.0 + nrm(ks[11], (L, POOL_WIDTH), 0.1),
        "w_out": nrm(ks[12], (L, D_MIX, D), DEEPNORM_BETA * D_MIX ** -0.5),
        "ln1_g": 1.0 + nrm(ks[13], (L, D), 0.01),
        "ln1_b": nrm(ks[14], (L, D), 0.01),
        "w_router": nrm(ks[15], (L, D, E), D ** -0.5),
        "router_bias": nrm(ks[16], (L, E), 0.01),
        "w_exp_gate": nrm(ks[17], (L, E, D, F), D ** -0.5),
        "w_exp_up": nrm(ks[18], (L, E, D, F), D ** -0.5),
        "w_exp_down": nrm(ks[19], (L, E, F, D), DEEPNORM_BETA * F ** -0.5),
        "w_sh_gate": nrm(ks[20], (L, D, F), D ** -0.5),
        "w_sh_up": nrm(ks[21], (L, D, F), D ** -0.5),
        "w_sh_down": nrm(ks[22], (L, F, D), DEEPNORM_BETA * F ** -0.5),
        "ln2_g": 1.0 + nrm(ks[23], (L, D), 0.01),
        "ln2_b": nrm(ks[24], (L, D), 0.01),
    }


def reference(x, c, positions, w_ada, b_ada, w_in, q_norm_g, kv_norm_g, w_uq, w_ukv, w_pool, pool_scale,
              w_out, ln1_g, ln1_b, w_router, router_bias, w_exp_gate, w_exp_up, w_exp_down,
              w_sh_gate, w_sh_up, w_sh_down, ln2_g, ln2_b):
    cond = jax.nn.silu(c)
    split_cols = [POOL_WIDTH, POOL_WIDTH + Q_LORA, POOL_WIDTH + Q_LORA + KV_LORA]
    for l in range(DEPTH):
        mod = (cond @ w_ada[l] + b_ada[l])[:, None, :]
        sh1, sc1, g1, sh2, sc2, g2 = jnp.split(mod, 6, axis=-1)
        h = x * (1.0 + sc1) + sh1
        u, q_lat, kv_lat, k_rope = jnp.split(h @ w_in[l], split_cols, axis=-1)
        pooled = causal_pool_mixer(u, w_pool[l], pool_scale[l])
        attn = mla_mixer(q_lat, kv_lat, k_rope, positions, q_norm_g[l], kv_norm_g[l], w_uq[l], w_ukv[l])
        mixed = jnp.concatenate([pooled, attn], axis=-1) @ w_out[l]
        x = layer_norm(DEEPNORM_ALPHA * x + g1 * mixed, ln1_g[l], ln1_b[l])
        h = x * (1.0 + sc2) + sh2
        ffn = (swiglu(h, w_sh_gate[l], w_sh_up[l], w_sh_down[l])
               + routed_moe(h, w_router[l], router_bias[l], w_exp_gate[l], w_exp_up[l], w_exp_down[l]))
        x = layer_norm(DEEPNORM_ALPHA * x + g2 * ffn, ln2_g[l], ln2_b[l])
    return x
```

```cpp
#include <hip/hip_runtime.h>
#include <stdint.h>
#include <cstdio>

#define LAS __attribute__((address_space(3)))
typedef unsigned short bf16_t;
typedef short bf16x8 __attribute__((ext_vector_type(8)));
typedef float f32x4 __attribute__((ext_vector_type(4)));
typedef float f32x2 __attribute__((ext_vector_type(2)));
typedef unsigned u32x4 __attribute__((ext_vector_type(4)));
typedef unsigned u32x2 __attribute__((ext_vector_type(2)));

constexpr int D = 1024, NB = 16, S = 2048, T = NB * S, NL = 4;
constexpr int NE = 64, TOPK = 8, FE = 256, NH = 6;
constexpr int INW = 960;
constexpr int A_TOT = T * 9;
constexpr float ALPHA = 1.6817928305074290f;
constexpr float LN_EPS = 1e-5f, RMS_EPS = 1e-6f;
constexpr float QSCALE = 0.07216878364870322f * 1.4426950408889634f;
constexpr int NTHREADS = 512, NWAVES = 8;
constexpr int LDS_BYTES = 163840, LDS_MISC = 131072;
constexpr int PH_PER_LAYER = 12, NSEG = 1 + NL * PH_PER_LAYER;

constexpr size_t al256(size_t x) { return (x + 255) & ~(size_t)255; }
constexpr size_t WS_CTL = 0, CTL_BYTES = 1u << 20;
constexpr size_t CW_BAR = 4096;
constexpr size_t CW_CNT = 16384;
constexpr size_t WS_MOD = WS_CTL + CTL_BYTES;
constexpr size_t WS_CS = al256(WS_MOD + (size_t)NL * 16 * 6144 * 4);
constexpr size_t WS_RSQ = al256(WS_CS + (size_t)T * 32 * 8);
constexpr size_t WS_RSKV = al256(WS_RSQ + (size_t)T * 4);
constexpr size_t WS_WIN = al256(WS_RSKV + (size_t)T * 4);
constexpr size_t WS_WUQ = al256(WS_WIN + (size_t)NL * 1024 * 1024 * 2);
constexpr size_t WS_WUKV = al256(WS_WUQ + (size_t)NL * 1280 * 384 * 2);
constexpr size_t WS_WOUT = al256(WS_WUKV + (size_t)NL * 1536 * 256 * 2);
constexpr size_t WS_WR = al256(WS_WOUT + (size_t)NL * 1024 * 1024 * 2);
constexpr size_t WS_WGU = al256(WS_WR + (size_t)NL * 256 * 1024 * 2);
constexpr size_t WS_WD = al256(WS_WGU + (size_t)65 * 512 * 1024 * 2);
constexpr size_t WS_H = al256(WS_WD + (size_t)65 * 1024 * 256 * 2);
constexpr size_t WS_R = al256(WS_H + (size_t)T * 1024 * 2);
constexpr size_t WS_P = WS_R;
constexpr size_t WS_Q = al256(WS_P + (size_t)T * 1024 * 2);
constexpr size_t WS_KF = al256(WS_Q + (size_t)T * 1152 * 2);
constexpr size_t WS_V = al256(WS_KF + (size_t)T * 1152 * 2);
constexpr size_t WS_MIX = al256(WS_V + (size_t)T * 768 * 2);
constexpr size_t WS_MIX_END = al256(WS_MIX + (size_t)T * 1024 * 2);
constexpr size_t WS_ACT = WS_R;
constexpr size_t WS_LOG = al256(WS_ACT + (size_t)(A_TOT + 1) * 256 * 2);
constexpr size_t WS_TG = al256(WS_LOG + (size_t)T * 64 * 4);
constexpr size_t WS_LIST = al256(WS_TG + (size_t)T * 8 * 4);
constexpr size_t WS_Y = al256(WS_LIST + (size_t)64 * T * 4);
constexpr size_t WS_END = al256(WS_Y + (size_t)(A_TOT + 1) * 1024 * 2);
static_assert(WS_MIX_END <= WS_END && WS_END < 1000000000ull, "workspace map");

struct Params {
    const float *x, *c; const int* pos;
    const float *w_ada, *b_ada, *w_in, *qg, *kvg, *w_uq, *w_ukv, *w_pool, *pool_scale, *w_out, *ln1g, *ln1b, *w_router, *rbias;
    const float *weg, *weu, *wed, *wsg, *wsu, *wsd, *ln2g, *ln2b;
    float* out; unsigned char* ws;
};

__device__ __forceinline__ unsigned cvt_pk_bf16(float lo, float hi) { unsigned r; asm volatile("v_cvt_pk_bf16_f32 %0, %1, %2" : "=v"(r) : "v"(lo), "v"(hi)); return r; }
__device__ __forceinline__ float bf2f(bf16_t b) { return __uint_as_float(((unsigned)b) << 16); }
__device__ __forceinline__ float bflo(unsigned w) { return __uint_as_float(w << 16); }
__device__ __forceinline__ float bfhi(unsigned w) { return __uint_as_float(w & 0xffff0000u); }
__device__ __forceinline__ float wave_sum(float v) {
#pragma unroll
    for (int o = 1; o < 64; o <<= 1) v += __shfl_xor(v, o);
    return v;
}
__device__ __forceinline__ float wave_max(float v) {
#pragma unroll
    for (int o = 1; o < 64; o <<= 1) v = fmaxf(v, __shfl_xor(v, o));
    return v;
}
__device__ __forceinline__ void store8_bf16(bf16_t* p, f32x4 a, f32x4 b) {
    u32x4 w; w.x = cvt_pk_bf16(a[0], a[1]); w.y = cvt_pk_bf16(a[2], a[3]); w.z = cvt_pk_bf16(b[0], b[1]); w.w = cvt_pk_bf16(b[2], b[3]);
    *(u32x4*)p = w;
}

template <class Tp> __device__ __forceinline__ Tp* launder(Tp* p) { asm volatile("" : "+s"(p)); return p; }
#define PHASE_Q Params q = p; q.ws = launder(p.ws); q.out = launder(p.out); q.x = launder(p.x); unsigned char* ws = q.ws; (void)ws; \
    Ctx c = c0; asm volatile("" : "+v"(c.tid), "+v"(c.lane)); asm volatile("" : "+s"(c.gw), "+s"(c.wid), "+s"(c.bid));

#define XB_TMO      128
#define XB_XCNT(j)  (256  + 64 * (j))
#define XB_XSUB(j)  (1280 + 64 * (j))
#define XB_XGEN(j)  (2304 + 64 * (j))
#define XB_TOP      3328
#define XB_TOPGEN   3392
#define XCD_BAR_WORDS 3456
#define XB_SPIN_CAP (1u << 20)
__device__ __forceinline__ unsigned xb_ld(unsigned* p)              { return __hip_atomic_load(p, __ATOMIC_RELAXED, __HIP_MEMORY_SCOPE_AGENT); }
__device__ __forceinline__ unsigned xb_add(unsigned* p, unsigned v) { return __hip_atomic_fetch_add(p, v, __ATOMIC_RELAXED, __HIP_MEMORY_SCOPE_AGENT); }
__device__ __forceinline__ unsigned xb_xcc_id() { return (unsigned)__builtin_amdgcn_s_getreg((3 << 11) | 20) & 0xFu; }
#define XB_SPIN(cond, bar) do { unsigned _sp = 0; while (cond) { __builtin_amdgcn_s_sleep(1); \
    if ((++_sp & 255u) == 0u) { if (xb_ld(&(bar)[XB_TMO])) break; if (_sp > XB_SPIN_CAP) { atomicAdd(&(bar)[XB_TMO], 1u); break; } } } } while (0)
struct XcdBarrier { unsigned* bar; unsigned x; volatile LAS unsigned* st; };
__device__ __forceinline__ XcdBarrier xcd_barrier_post(unsigned* bar, volatile LAS unsigned* st) {
    XcdBarrier b; b.bar = bar; b.x = xb_xcc_id(); b.st = st;
    if (threadIdx.x == 0) (void)xb_add(&bar[XB_XCNT(b.x)], 1u);
    return b;
}
__device__ __forceinline__ void xcd_barrier_complete(unsigned* bar, unsigned x, unsigned& nloc, unsigned& nx) {
    const unsigned G = gridDim.x * gridDim.y * gridDim.z;
    unsigned sum, cnt, mine, sp = 0u;
    for (;;) {
        sum = 0u; cnt = 0u; mine = 0u;
#pragma unroll
        for (unsigned j = 0; j < 16; ++j) { const unsigned c = xb_ld(&bar[XB_XCNT(j)]); sum += c; cnt += (c > 0u) ? 1u : 0u; mine = (j == x) ? c : mine; }
        if (sum == G) break;
        __builtin_amdgcn_s_sleep(1);
        if ((++sp & 255u) == 0u) { if (xb_ld(&bar[XB_TMO])) break; if (sp > XB_SPIN_CAP) { atomicAdd(&bar[XB_TMO], 1u); break; } }
    }
    nloc = mine > 0u ? mine : 1u; nx = cnt > 0u ? cnt : 1u;
}
__device__ __forceinline__ void xcd_barrier(const XcdBarrier& b) {
    asm volatile("s_waitcnt vmcnt(0)" ::: "memory");
    __syncthreads();
    if (threadIdx.x == 0) {
        unsigned* bar = b.bar;
        __builtin_amdgcn_s_waitcnt(0);
        unsigned nloc = b.st[0], nx = b.st[1];
        if (nloc == 0u) { xcd_barrier_complete(bar, b.x, nloc, nx); b.st[0] = nloc; b.st[1] = nx; }
        const unsigned old = xb_add(&bar[XB_XSUB(b.x)], 1u);
        const unsigned gen = old / nloc;
        if (old + 1u == (gen + 1u) * nloc) {
            __builtin_amdgcn_fence(__ATOMIC_RELEASE, "agent");
            asm volatile("s_waitcnt vmcnt(0)" ::: "memory");
            const unsigned og = xb_add(&bar[XB_TOP], 1u);
            const unsigned tg = og / nx;
            if (og + 1u == (tg + 1u) * nx) xb_add(&bar[XB_TOPGEN], 1u);
            else XB_SPIN(xb_ld(&bar[XB_TOPGEN]) == tg, bar);
            __builtin_amdgcn_fence(__ATOMIC_ACQUIRE, "agent");
            xb_add(&bar[XB_XGEN(b.x)], 1u);
            asm volatile("s_waitcnt vmcnt(0)" ::: "memory");
        } else {
            XB_SPIN(xb_ld(&bar[XB_XGEN(b.x)]) == gen, bar);
            __builtin_amdgcn_fence(__ATOMIC_ACQUIRE, "agent");
            asm volatile("s_waitcnt vmcnt(0)" ::: "memory");
        }
    }
    __syncthreads();
}

struct Unit { const bf16_t* Bt; int pm, pn, e, base, cnt; };
struct GemmDesc { const bf16_t* A; int lda, ldb, K; };

struct DenseSched {
    const bf16_t* Bt; int ldb, nM, nN, G, c;
    __device__ __forceinline__ bool next(int i, Unit& u) const {
        const int Lx = i * G + c; if (Lx >= nM * nN) return false;
        const int nig = 8 * nN, gid = Lx / nig, fm = gid * 8, gsz = (nM - fm) < 8 ? (nM - fm) : 8, w = Lx % nig;
        u.pm = fm + (w % gsz); u.pn = w / gsz; u.e = 0; u.base = u.pm * 256; u.cnt = 256;
        u.Bt = Bt + (size_t)u.pn * 256 * ldb; return true;
    }
    __device__ __forceinline__ int arow(const Unit& u, int r) const { return u.base + r; }
    __device__ __forceinline__ int orow(const Unit& u, int r) const { return u.base + r; }
};
struct MoeSched {
    const bf16_t* W; size_t w_estride; int ldb; const int* lists; const int* cnt; const LAS int* tp; int nsub, G, c; bool up;
    __device__ __forceinline__ bool next(int i, Unit& u) const {
        const int Lx = i * G + c, ntile = tp[65]; if (Lx >= ntile * nsub) return false;
        int e = 0;
#pragma unroll 1
        for (int s = 32; s >= 1; s >>= 1) if (e + s <= 64 && tp[e + s] * nsub <= Lx) e += s;
        if (e < 64 && tp[e + 1] * nsub <= Lx) e += 1;
        const int nt_e = tp[e + 1] - tp[e], w = Lx - tp[e] * nsub, sub = w / nt_e, ti = w % nt_e;
        u.e = e; u.pn = sub; u.pm = ti; u.base = ti * 256; u.cnt = (e < 64) ? cnt[e] : T;
        u.Bt = W + (size_t)e * w_estride + (size_t)sub * 256 * ldb; return true;
    }
    __device__ __forceinline__ int asg(const Unit& u, int r) const {
        const int pos = u.base + r;
        if (u.e == 64) return 8 * T + pos;
        return pos < u.cnt ? lists[(size_t)u.e * T + pos] : A_TOT;
    }
    __device__ __forceinline__ int arow(const Unit& u, int r) const {
        const int a = asg(u, r);
        if (!up) return a;
        return a < 8 * T ? (a >> 3) : (a < A_TOT ? a - 8 * T : 0);
    }
    __device__ __forceinline__ int orow(const Unit& u, int r) const { return asg(u, r); }
};
__device__ __forceinline__ void moe_build_tiles(LAS int* tp, const int* cnt) {
    if (threadIdx.x == 0) { int s = 0; for (int e = 0; e < 64; ++e) { tp[e] = s; s += (cnt[e] + 255) >> 8; } tp[64] = s; tp[65] = s + T / 256; }
    __syncthreads();
}

template <bool PERM, class Sch, class Epi>
__device__ __forceinline__ void gemm_naive(LAS unsigned char* lds, int tid, const GemmDesc g, const Sch& Sc, const Epi& E) {
    const int wid = tid >> 6, lane = tid & 63, wr = wid >> 2, wc = wid & 3, fr = lane & 15, fq = lane >> 4;
    constexpr int LP = 260;
    LAS float* As = (LAS float*)lds; LAS float* Bs = As + 32 * LP;
    const int sr = tid >> 1, kh = tid & 1;
    Unit u;
    for (int i = 0; Sc.next(i, u); ++i) {
        f32x4 acc[2][2][4][2];
#pragma unroll
        for (int a = 0; a < 2; ++a)
#pragma unroll
            for (int b = 0; b < 2; ++b)
#pragma unroll
                for (int m = 0; m < 4; ++m)
#pragma unroll
                    for (int n = 0; n < 2; ++n) acc[a][b][m][n] = (f32x4){0.f, 0.f, 0.f, 0.f};
        const bf16_t* ap = g.A + (size_t)Sc.arow(u, sr) * g.lda + kh * 16;
        const bf16_t* bp = u.Bt + (size_t)sr * g.ldb + kh * 16;
        for (int k0 = 0; k0 < g.K; k0 += 32) {
            const u32x4 a0 = *(const u32x4*)(ap + k0), a1 = *(const u32x4*)(ap + k0 + 8);
            const u32x4 b0 = *(const u32x4*)(bp + k0), b1 = *(const u32x4*)(bp + k0 + 8);
            __syncthreads();
#pragma unroll
            for (int j = 0; j < 4; ++j) {
                As[(kh * 16 + 2 * j) * LP + sr] = bflo(a0[j]); As[(kh * 16 + 2 * j + 1) * LP + sr] = bfhi(a0[j]);
                As[(kh * 16 + 8 + 2 * j) * LP + sr] = bflo(a1[j]); As[(kh * 16 + 9 + 2 * j) * LP + sr] = bfhi(a1[j]);
                Bs[(kh * 16 + 2 * j) * LP + sr] = bflo(b0[j]); Bs[(kh * 16 + 2 * j + 1) * LP + sr] = bfhi(b0[j]);
                Bs[(kh * 16 + 8 + 2 * j) * LP + sr] = bflo(b1[j]); Bs[(kh * 16 + 9 + 2 * j) * LP + sr] = bfhi(b1[j]);
            }
            __syncthreads();
#pragma unroll 4
            for (int kk = 0; kk < 32; ++kk) {
                float av[2][4]; f32x4 bv[2][2];
#pragma unroll
                for (int ai = 0; ai < 2; ++ai)
#pragma unroll
                    for (int m = 0; m < 4; ++m) av[ai][m] = As[kk * LP + 128 * ai + 64 * wr + 16 * m + fr];
#pragma unroll
                for (int bj = 0; bj < 2; ++bj)
#pragma unroll
                    for (int n = 0; n < 2; ++n) bv[bj][n] = *(const LAS f32x4*)&Bs[kk * LP + 128 * bj + 32 * wc + (PERM ? 8 * fq + 4 * n : 16 * n + 4 * fq)];
#pragma unroll
                for (int ai = 0; ai < 2; ++ai)
#pragma unroll
                    for (int bj = 0; bj < 2; ++bj)
#pragma unroll
                        for (int m = 0; m < 4; ++m)
#pragma unroll
                            for (int n = 0; n < 2; ++n) acc[ai][bj][m][n] += bv[bj][n] * av[ai][m];
            }
        }
        E(acc, u, Sc, wr, wc, fr, fq);
    }
    __syncthreads();
}

#define EPI_ROWS(ai, m) (128 * (ai) + 64 * wr + 16 * (m) + fr)
struct EpiP {
    static constexpr bool PERM = true;
    bf16_t* P;
    template <class Sch> __device__ __forceinline__ void operator()(const f32x4 (&acc)[2][2][4][2], const Unit& u, const Sch& Sc, int wr, int wc, int fr, int fq) const {
#pragma unroll
        for (int ai = 0; ai < 2; ++ai)
#pragma unroll
            for (int m = 0; m < 4; ++m) { bf16_t* rp = P + (size_t)Sc.orow(u, EPI_ROWS(ai, m)) * 1024 + u.pn * 256 + 32 * wc + 8 * fq;
#pragma unroll
                for (int bj = 0; bj < 2; ++bj) store8_bf16(rp + 128 * bj, acc[ai][bj][m][0], acc[ai][bj][m][1]); }
    }
};
struct EpiQ {
    static constexpr bool PERM = true;
    bf16_t* Q; const float* rsq; const f32x2* cs;
    template <class Sch> __device__ __forceinline__ void operator()(const f32x4 (&acc)[2][2][4][2], const Unit& u, const Sch& Sc, int wr, int wc, int fr, int fq) const {
#pragma unroll
        for (int ai = 0; ai < 2; ++ai)
#pragma unroll
            for (int m = 0; m < 4; ++m) {
                const int row = Sc.orow(u, EPI_ROWS(ai, m)); const float rs = rsq[row];
                if (u.pn < 3) {
#pragma unroll
                    for (int bj = 0; bj < 2; ++bj) store8_bf16(Q + (size_t)row * 1152 + (2 * u.pn + bj) * 192 + 32 * wc + 8 * fq, acc[ai][bj][m][0] * rs, acc[ai][bj][m][1] * rs);
                } else {
                    const int head = (u.pn == 3) ? wc : 4 + wc;
                    if (head < NH) {
                        const f32x2* cp = cs + (size_t)row * 32 + 8 * fq;
                        f32x4 lo[2], hi[2];
#pragma unroll
                        for (int n = 0; n < 2; ++n)
#pragma unroll
                            for (int j = 0; j < 4; ++j) { const f32x2 c = cp[4 * n + j]; const float x1 = acc[ai][0][m][n][j], x2 = acc[ai][1][m][n][j];
                                lo[n][j] = (x1 * c.x - x2 * c.y) * rs; hi[n][j] = (x2 * c.x + x1 * c.y) * rs; }
                        bf16_t* qp = Q + (size_t)row * 1152 + head * 192 + 128 + 8 * fq;
                        store8_bf16(qp, lo[0], lo[1]); store8_bf16(qp + 32, hi[0], hi[1]);
                    }
                }
            }
    }
};
struct EpiKV {
    static constexpr bool PERM = true;
    bf16_t* Kf; bf16_t* V; const float* rskv;
    template <class Sch> __device__ __forceinline__ void operator()(const f32x4 (&acc)[2][2][4][2], const Unit& u, const Sch& Sc, int wr, int wc, int fr, int fq) const {
#pragma unroll
        for (int ai = 0; ai < 2; ++ai)
#pragma unroll
            for (int m = 0; m < 4; ++m) {
                const int row = Sc.orow(u, EPI_ROWS(ai, m)); const float rs = rskv[row];
                store8_bf16(Kf + (size_t)row * 1152 + u.pn * 192 + 32 * wc + 8 * fq, acc[ai][0][m][0] * rs, acc[ai][0][m][1] * rs);
                store8_bf16(V + (size_t)row * 768 + u.pn * 128 + 32 * wc + 8 * fq, acc[ai][1][m][0] * rs, acc[ai][1][m][1] * rs);
            }
    }
};
struct EpiOut {
    static constexpr bool PERM = false;
    const float* xin; float* y; const float* g1;
    template <class Sch> __device__ __forceinline__ void operator()(const f32x4 (&acc)[2][2][4][2], const Unit& u, const Sch& Sc, int wr, int wc, int fr, int fq) const {
        const int b = (u.pm * 256) / S; const int col0 = u.pn * 256 + 32 * wc + 4 * fq;
        f32x4 gv[2][2];
#pragma unroll
        for (int bj = 0; bj < 2; ++bj)
#pragma unroll
            for (int n = 0; n < 2; ++n) gv[bj][n] = *(const f32x4*)(g1 + (size_t)b * 6144 + col0 + 128 * bj + 16 * n);
#pragma unroll
        for (int ai = 0; ai < 2; ++ai)
#pragma unroll
            for (int m = 0; m < 4; ++m) { const size_t off = (size_t)Sc.orow(u, EPI_ROWS(ai, m)) * 1024 + col0;
#pragma unroll
                for (int bj = 0; bj < 2; ++bj)
#pragma unroll
                    for (int n = 0; n < 2; ++n) { const f32x4 xv = *(const f32x4*)(xin + off + 128 * bj + 16 * n);
                        *(f32x4*)(y + off + 128 * bj + 16 * n) = xv * ALPHA + gv[bj][n] * acc[ai][bj][m][n]; } }
    }
};
struct EpiRouter {
    static constexpr bool PERM = false;
    float* logits;
    template <class Sch> __device__ __forceinline__ void operator()(const f32x4 (&acc)[2][2][4][2], const Unit& u, const Sch& Sc, int wr, int wc, int fr, int fq) const {
        if (wc < 2) {
#pragma unroll
            for (int ai = 0; ai < 2; ++ai)
#pragma unroll
                for (int m = 0; m < 4; ++m) { float* rp = logits + (size_t)Sc.orow(u, EPI_ROWS(ai, m)) * 64 + 32 * wc + 4 * fq;
#pragma unroll
                    for (int n = 0; n < 2; ++n) *(f32x4*)(rp + 16 * n) = acc[ai][0][m][n]; }
        }
    }
};
struct EpiSwiglu {
    static constexpr bool PERM = true;
    bf16_t* act;
    template <class Sch> __device__ __forceinline__ void operator()(const f32x4 (&acc)[2][2][4][2], const Unit& u, const Sch& Sc, int wr, int wc, int fr, int fq) const {
#pragma unroll
        for (int ai = 0; ai < 2; ++ai)
#pragma unroll
            for (int m = 0; m < 4; ++m) { f32x4 o[2];
#pragma unroll
                for (int n = 0; n < 2; ++n)
#pragma unroll
                    for (int j = 0; j < 4; ++j) { const float gt = acc[ai][0][m][n][j], up = acc[ai][1][m][n][j]; o[n][j] = gt / (1.f + __expf(-gt)) * up; }
                store8_bf16(act + (size_t)Sc.orow(u, EPI_ROWS(ai, m)) * 256 + u.pn * 128 + 32 * wc + 8 * fq, o[0], o[1]); }
    }
};
struct EpiDown {
    static constexpr bool PERM = true;
    bf16_t* Y;
    template <class Sch> __device__ __forceinline__ void operator()(const f32x4 (&acc)[2][2][4][2], const Unit& u, const Sch& Sc, int wr, int wc, int fr, int fq) const {
#pragma unroll
        for (int ai = 0; ai < 2; ++ai)
#pragma unroll
            for (int m = 0; m < 4; ++m) { bf16_t* rp = Y + (size_t)Sc.orow(u, EPI_ROWS(ai, m)) * 1024 + u.pn * 256 + 32 * wc + 8 * fq;
#pragma unroll
                for (int bj = 0; bj < 2; ++bj) store8_bf16(rp + 128 * bj, acc[ai][bj][m][0], acc[ai][bj][m][1]); }
    }
};

__device__ __forceinline__ void xpose_item(const float* src, int ld, bf16_t* dst, int Kdst, const float* kscale  , float mul, LAS float* scr, int lane) {
#pragma unroll 8
    for (int i = 0; i < 32; ++i) { const int kk = 2 * i + (lane >> 5); float v = src[(size_t)kk * ld + (lane & 31)]; if (kscale) v *= kscale[kk]; scr[kk * 33 + (lane & 31)] = v * mul; }
    asm volatile("s_waitcnt lgkmcnt(0)" ::: "memory");
    const int c = lane & 7;
#pragma unroll
    for (int j = 0; j < 4; ++j) { const int n = (lane >> 3) + 8 * j; const LAS float* s = scr + (8 * c) * 33 + n;
        u32x4 o; o.x = cvt_pk_bf16(s[0 * 33], s[1 * 33]); o.y = cvt_pk_bf16(s[2 * 33], s[3 * 33]); o.z = cvt_pk_bf16(s[4 * 33], s[5 * 33]); o.w = cvt_pk_bf16(s[6 * 33], s[7 * 33]);
        *(u32x4*)(dst + (size_t)n * Kdst + 8 * c) = o; }
    asm volatile("s_waitcnt lgkmcnt(0)" ::: "memory");
}
__device__ __forceinline__ void zero_rows(bf16_t* dst, size_t nelem, int gw, int ngw, int lane) {
    for (size_t i = ((size_t)gw * 64 + lane) * 8; i < nelem; i += (size_t)ngw * 64 * 8) *(u32x4*)(dst + i) = (u32x4){0u, 0u, 0u, 0u};
}
__device__ __forceinline__ int uq_srccol(int g) {
    const int n = 32 * g;
    if (n < 768) return (n / 128) * 192 + (n % 128);
    if (n < 1024) { const int q = n - 768, half = q / 128, hh = (q % 128) / 32; return hh * 192 + 128 + half * 32; }
    { const int q = n - 1024, half = q / 128, w = q % 128; if (w >= 64) return -1; return (4 + w / 32) * 192 + 128 + half * 32; }
}

struct Ctx { LAS unsigned char* lds; int tid, lane, wid, gw, ngw, G, bid; };

__device__ __forceinline__ void ph_prologue(const Params& p, const Ctx& c) {
    unsigned char* ws = p.ws;
    float* mod = (float*)(ws + WS_MOD);
    {
        LAS float* cond = (LAS float*)c.lds;
        LAS float* red = cond + 16 * 1024;
        for (int i = c.tid; i < 16 * 1024; i += NTHREADS) { const float v = p.c[i]; cond[i] = v / (1.f + __expf(-v)); }
        __syncthreads();
        const int nc = c.tid & 127, kq = c.tid >> 7;
        for (int u = c.bid; u < NL * 48; u += c.G) {
            const int l = u / 48, n0 = (u % 48) * 128;
            float acc[16];
#pragma unroll
            for (int b = 0; b < 16; ++b) acc[b] = 0.f;
            const float* wp = p.w_ada + ((size_t)l * 1024 + kq * 256) * 6144 + n0 + nc;
#pragma unroll 4
            for (int k = 0; k < 256; ++k) { const float w = wp[(size_t)k * 6144];
#pragma unroll
                for (int b = 0; b < 16; ++b) acc[b] += cond[b * 1024 + kq * 256 + k] * w; }
#pragma unroll
            for (int b = 0; b < 16; ++b) red[(kq * 16 + b) * 128 + nc] = acc[b];
            __syncthreads();
            for (int o = c.tid; o < 2048; o += NTHREADS) { const int b = o >> 7, n = o & 127;
                mod[((size_t)l * 16 + b) * 6144 + n0 + n] = red[(0 * 16 + b) * 128 + n] + red[(1 * 16 + b) * 128 + n] + red[(2 * 16 + b) * 128 + n] + red[(3 * 16 + b) * 128 + n] + p.b_ada[l * 6144 + n0 + n]; }
            __syncthreads();
        }
    }
    {
        f32x2* cs = (f32x2*)(ws + WS_CS);
        for (int i = c.bid * NTHREADS + c.tid; i < T * 32; i += c.G * NTHREADS) {
            const int t = i >> 5, k = i & 31; const float inv = powf(10000.f, -(float)k / 32.f); const float ang = (float)p.pos[t] * inv;
            float sn, cn; sincosf(ang, &sn, &cn); cs[i] = (f32x2){cn, sn};
        }
    }
    {
        LAS float* scr = (LAS float*)(c.lds + c.wid * 16384);
        bf16_t* WinT = (bf16_t*)(ws + WS_WIN); bf16_t* WuqT = (bf16_t*)(ws + WS_WUQ); bf16_t* WukvT = (bf16_t*)(ws + WS_WUKV);
        bf16_t* WoutT = (bf16_t*)(ws + WS_WOUT); bf16_t* WrT = (bf16_t*)(ws + WS_WR);
        constexpr int I_IN = 30 * 16, I_UQ = 40 * 6, I_UKV = 48 * 4, I_OUT = 32 * 16, I_R = 2 * 16, I_L = I_IN + I_UQ + I_UKV + I_OUT + I_R;
        for (int it = c.gw; it < NL * I_L; it += c.ngw) {
            const int l = it / I_L; int r = it % I_L;
            if (r < I_IN) { const int g = r / 16, kb = r % 16; xpose_item(p.w_in + ((size_t)l * 1024 + 64 * kb) * INW + 32 * g, INW, WinT + ((size_t)l * 1024 + 32 * g) * 1024 + 64 * kb, 1024, nullptr, 1.f, scr, c.lane); continue; } r -= I_IN;
            if (r < I_UQ) { const int g = r / 6, kb = r % 6, sc = uq_srccol(g); bf16_t* dst = WuqT + ((size_t)l * 1280 + 32 * g) * 384 + 64 * kb;
                if (sc >= 0) xpose_item(p.w_uq + ((size_t)l * 384 + 64 * kb) * 1152 + sc, 1152, dst, 384, p.qg + l * 384 + 64 * kb, QSCALE, scr, c.lane);
                else { const int n = c.lane >> 1, h8 = (c.lane & 1) * 32; for (int q = 0; q < 4; ++q) *(u32x4*)(dst + (size_t)n * 384 + h8 + 8 * q) = (u32x4){0u, 0u, 0u, 0u}; }
                continue; } r -= I_UQ;
            if (r < I_UKV) { const int g = r / 4, kb = r % 4; xpose_item(p.w_ukv + ((size_t)l * 256 + 64 * kb) * 1536 + 32 * g, 1536, WukvT + ((size_t)l * 1536 + 32 * g) * 256 + 64 * kb, 256, p.kvg + l * 256 + 64 * kb, 1.f, scr, c.lane); continue; } r -= I_UKV;
            if (r < I_OUT) { const int g = r / 16, kb = r % 16; xpose_item(p.w_out + ((size_t)l * 1024 + 64 * kb) * 1024 + 32 * g, 1024, WoutT + ((size_t)l * 1024 + 32 * g) * 1024 + 64 * kb, 1024, nullptr, 1.f, scr, c.lane); continue; } r -= I_OUT;
            { const int g = r / 16, kb = r % 16; xpose_item(p.w_router + ((size_t)l * 1024 + 64 * kb) * 64 + 32 * g, 64, WrT + ((size_t)l * 256 + 32 * g) * 1024 + 64 * kb, 1024, nullptr, 1.f, scr, c.lane); }
        }
        for (int l = 0; l < NL; ++l) {
            zero_rows(WinT + ((size_t)l * 1024 + 960) * 1024, (size_t)64 * 1024, c.gw, c.ngw, c.lane);
            zero_rows(WrT + ((size_t)l * 256 + 64) * 1024, (size_t)192 * 1024, c.gw, c.ngw, c.lane);
        }
    }
}

__device__ __forceinline__ void write_mod_row(const f32x4 (&v)[4], const float* sh, const float* sc, bf16_t* hrow, int lane) {
#pragma unroll
    for (int j = 0; j < 4; ++j) { const f32x4 s1 = *(const f32x4*)(sc + 4 * lane + 256 * j), s0 = *(const f32x4*)(sh + 4 * lane + 256 * j);
        const f32x4 o = v[j] * (s1 + 1.f) + s0; u32x2 w; w.x = cvt_pk_bf16(o[0], o[1]); w.y = cvt_pk_bf16(o[2], o[3]);
        *(u32x2*)(hrow + 4 * lane + 256 * j) = w; }
}

__device__ __forceinline__ void ph_prep(const Params& p, const Ctx& c, int l) {
    unsigned char* ws = p.ws;
    LAS float* scr = (LAS float*)(c.lds + c.wid * 16384);
    bf16_t* Wgu = (bf16_t*)(ws + WS_WGU); bf16_t* Wd = (bf16_t*)(ws + WS_WD);
    constexpr int I_GU = 16 * 16, I_D = 32 * 4, I_E = I_GU + I_D;
    for (int it = c.gw; it < 65 * I_E; it += c.ngw) {
        const int e = it / I_E; int r = it % I_E;
        if (r < I_GU) { const int g = r / 16, kb = r % 16, r0 = 32 * g, cb = r0 >> 8, half = (r0 >> 7) & 1, c0 = cb * 128 + (r0 & 127);
            const float* src = (e < 64) ? ((half ? p.weu : p.weg) + ((size_t)(l * 64 + e) * 1024) * 256) : ((half ? p.wsu : p.wsg) + (size_t)l * 1024 * 256);
            xpose_item(src + (size_t)(64 * kb) * 256 + c0, 256, Wgu + ((size_t)e * 512 + r0) * 1024 + 64 * kb, 1024, nullptr, 1.f, scr, c.lane);
        } else { r -= I_GU; const int g = r / 4, kb = r % 4;
            const float* src = (e < 64) ? (p.wed + ((size_t)(l * 64 + e) * 256) * 1024) : (p.wsd + (size_t)l * 256 * 1024);
            xpose_item(src + (size_t)(64 * kb) * 1024 + 32 * g, 1024, Wd + ((size_t)e * 1024 + 32 * g) * 256 + 64 * kb, 256, nullptr, 1.f, scr, c.lane);
        }
    }
    if (l == 0) {
        const float* mod = (const float*)(ws + WS_MOD); bf16_t* H = (bf16_t*)(ws + WS_H);
        for (int t = c.gw; t < T; t += c.ngw) { const int b = t / S; f32x4 v[4];
#pragma unroll
            for (int j = 0; j < 4; ++j) v[j] = *(const f32x4*)(p.x + (size_t)t * 1024 + 4 * c.lane + 256 * j);
            write_mod_row(v, mod + (size_t)b * 6144 + 0, mod + (size_t)b * 6144 + 1024, H + (size_t)t * 1024, c.lane); }
    }
}

__device__ __forceinline__ void ph_post_in(const Params& p, const Ctx& c, int l) {
    unsigned char* ws = p.ws;
    const bf16_t* P = (const bf16_t*)(ws + WS_P); bf16_t* Kf = (bf16_t*)(ws + WS_KF); bf16_t* MIX = (bf16_t*)(ws + WS_MIX);
    float* rsq = (float*)(ws + WS_RSQ); float* rskv = (float*)(ws + WS_RSKV); const f32x2* cs = (const f32x2*)(ws + WS_CS);
    LAS float* wp = (LAS float*)c.lds;
    for (int i = c.tid; i < 4 * 64 * 64; i += NTHREADS) wp[i] = p.w_pool[(size_t)l * 16384 + i];
    __syncthreads();
    const int lane = c.lane;
    for (int t = c.gw; t < T; t += c.ngw) {
        const bf16_t* row = P + (size_t)t * 1024;
        { const unsigned* q32 = (const unsigned*)(row + 256) + lane * 3; float s = 0.f;
#pragma unroll
            for (int j = 0; j < 3; ++j) { const unsigned w = q32[j]; const float a = bflo(w), b = bfhi(w); s += a * a + b * b; }
            s = wave_sum(s); if (lane == 0) rsq[t] = 1.0f / sqrtf(s * (1.f / 384.f) + RMS_EPS); }
        { const u32x2 w = *((const u32x2*)(row + 640) + lane); const float a = bflo(w.x), b = bfhi(w.x), c2 = bflo(w.y), d2 = bfhi(w.y);
            float s = a * a + b * b + c2 * c2 + d2 * d2; s = wave_sum(s); if (lane == 0) rskv[t] = 1.0f / sqrtf(s * (1.f / 256.f) + RMS_EPS); }
        if (lane < 32) { const float x1 = bf2f(row[896 + lane]), x2 = bf2f(row[928 + lane]); const f32x2 cc = cs[(size_t)t * 32 + lane];
            const unsigned o = cvt_pk_bf16(x1 * cc.x - x2 * cc.y, x2 * cc.x + x1 * cc.y);
#pragma unroll
            for (int h = 0; h < NH; ++h) { bf16_t* kp = Kf + (size_t)t * 1152 + h * 192 + 128; kp[lane] = (bf16_t)(o & 0xffffu); kp[32 + lane] = (bf16_t)(o >> 16); } }
        const int s = t % S;
        float tm[4];
#pragma unroll
        for (int g = 0; g < 4; ++g) { const int w = 2 << g, cnt = (s + 1 < w) ? s + 1 : w; float sum = 0.f;
            for (int j = 0; j < cnt; ++j) sum += bf2f(P[(size_t)(t - j) * 1024 + 64 * g + lane]);
            tm[g] = sum / (float)cnt - bf2f(row[64 * g + lane]); }
#pragma unroll
        for (int g = 0; g < 4; ++g) { float o = 0.f;
            for (int cc = 0; cc < 64; ++cc) o += __int_as_float(__builtin_amdgcn_readlane(__float_as_int(tm[g]), cc)) * wp[(g * 64 + cc) * 64 + lane];
            o *= p.pool_scale[l * 256 + 64 * g + lane];
            MIX[(size_t)t * 1024 + 64 * g + lane] = (bf16_t)(cvt_pk_bf16(o, 0.f) & 0xffffu); }
    }
}

__device__ __forceinline__ void ph_attn_naive(const Params& p, const Ctx& c) {
    unsigned char* ws = p.ws;
    const bf16_t* Q = (const bf16_t*)(ws + WS_Q); const bf16_t* Kf = (const bf16_t*)(ws + WS_KF); const bf16_t* V = (const bf16_t*)(ws + WS_V); bf16_t* MIX = (bf16_t*)(ws + WS_MIX);
    LAS float* qs = (LAS float*)(c.lds + c.wid * 8192);
    const int lane = c.lane;
    for (int item = c.bid; item < 96 * 32; item += c.G) {
        const int bh = item % 96, qb = 31 - item / 96, b = bh / NH, h = bh % NH;
        const int q0 = qb * 64 + c.wid * 8;
        for (int i = lane; i < 8 * 192; i += 64) { const int r = i / 192, d = i % 192; qs[i] = bf2f(Q[(size_t)(b * S + q0 + r) * 1152 + h * 192 + d]); }
        asm volatile("s_waitcnt lgkmcnt(0)" ::: "memory");
        float m[8], lsum[8], o0[8], o1[8];
#pragma unroll
        for (int r = 0; r < 8; ++r) { m[r] = -1e30f; lsum[r] = 0.f; o0[r] = 0.f; o1[r] = 0.f; }
        const int last = q0 + 7, nch = last / 64 + 1;
        for (int ch = 0; ch < nch; ++ch) {
            const int key = ch * 64 + lane; float sc[8];
#pragma unroll
            for (int r = 0; r < 8; ++r) sc[r] = 0.f;
            if (key <= last) {
                const bf16_t* kp = Kf + (size_t)(b * S + key) * 1152 + h * 192;
                for (int cc = 0; cc < 24; ++cc) { const u32x4 kw = *(const u32x4*)(kp + 8 * cc); float kf[8];
#pragma unroll
                    for (int j = 0; j < 4; ++j) { kf[2 * j] = bflo(kw[j]); kf[2 * j + 1] = bfhi(kw[j]); }
#pragma unroll
                    for (int r = 0; r < 8; ++r) { const f32x4 qa = *(const LAS f32x4*)&qs[r * 192 + 8 * cc], qb2 = *(const LAS f32x4*)&qs[r * 192 + 8 * cc + 4];
                        sc[r] += qa[0] * kf[0] + qa[1] * kf[1] + qa[2] * kf[2] + qa[3] * kf[3] + qb2[0] * kf[4] + qb2[1] * kf[5] + qb2[2] * kf[6] + qb2[3] * kf[7]; } }
            }
            float pr[8];
#pragma unroll
            for (int r = 0; r < 8; ++r) { const float sv = (key <= q0 + r) ? sc[r] : -__builtin_inff(); const float mx = wave_max(sv), mn = fmaxf(m[r], mx);
                const float al = __builtin_amdgcn_exp2f(m[r] - mn); const float pv = __builtin_amdgcn_exp2f(sv - mn);
                lsum[r] = lsum[r] * al + wave_sum(pv); o0[r] *= al; o1[r] *= al; m[r] = mn; pr[r] = pv; }
            const int kmax = (last - ch * 64 < 63) ? last - ch * 64 : 63;
            const bf16_t* vp = V + (size_t)(b * S + ch * 64) * 768 + h * 128 + 2 * lane;
            for (int kk = 0; kk <= kmax; ++kk) { const unsigned vw = *(const unsigned*)(vp + (size_t)kk * 768); const float v0 = bflo(vw), v1 = bfhi(vw);
#pragma unroll
                for (int r = 0; r < 8; ++r) { const float pk = __int_as_float(__builtin_amdgcn_readlane(__float_as_int(pr[r]), kk)); o0[r] += pk * v0; o1[r] += pk * v1; } }
        }
#pragma unroll
        for (int r = 0; r < 8; ++r) { const float il = 1.f / lsum[r];
            *(unsigned*)(MIX + (size_t)(b * S + q0 + r) * 1024 + 256 + h * 128 + 2 * lane) = cvt_pk_bf16(o0[r] * il, o1[r] * il); }
    }
}

__device__ __forceinline__ void ln_row(f32x4 (&v)[4], const float* g, const float* bta, int lane) {
    float s = 0.f;
#pragma unroll
    for (int j = 0; j < 4; ++j) s += (v[j][0] + v[j][1]) + (v[j][2] + v[j][3]);
    const float mean = wave_sum(s) * (1.f / D); float s2 = 0.f;
#pragma unroll
    for (int j = 0; j < 4; ++j) { v[j] = v[j] - mean; s2 += (v[j][0] * v[j][0] + v[j][1] * v[j][1]) + (v[j][2] * v[j][2] + v[j][3] * v[j][3]); }
    const float rstd = 1.0f / sqrtf(wave_sum(s2) * (1.f / D) + LN_EPS);
#pragma unroll
    for (int j = 0; j < 4; ++j) { const f32x4 gg = *(const f32x4*)(g + 4 * lane + 256 * j), bb = *(const f32x4*)(bta + 4 * lane + 256 * j); v[j] = v[j] * rstd * gg + bb; }
}

__device__ __forceinline__ void ph_ln1(const Params& p, const Ctx& c, int l) {
    const float* mod = (const float*)(p.ws + WS_MOD) + (size_t)l * 16 * 6144; bf16_t* H = (bf16_t*)(p.ws + WS_H);
    for (int t = c.gw; t < T; t += c.ngw) { const int b = t / S; f32x4 v[4]; float* xr = p.out + (size_t)t * 1024;
#pragma unroll
        for (int j = 0; j < 4; ++j) v[j] = *(const f32x4*)(xr + 4 * c.lane + 256 * j);
        ln_row(v, p.ln1g + l * 1024, p.ln1b + l * 1024, c.lane);
#pragma unroll
        for (int j = 0; j < 4; ++j) *(f32x4*)(xr + 4 * c.lane + 256 * j) = v[j];
        write_mod_row(v, mod + (size_t)b * 6144 + 3 * 1024, mod + (size_t)b * 6144 + 4 * 1024, H + (size_t)t * 1024, c.lane); }
}

__device__ __forceinline__ void ph_route(const Params& p, const Ctx& c, int l) {
    unsigned char* ws = p.ws;
    const float* logits = (const float*)(ws + WS_LOG); float* tg = (float*)(ws + WS_TG); int* lists = (int*)(ws + WS_LIST);
    unsigned* cnt = (unsigned*)(ws + WS_CTL) + CW_CNT + l * 64;
    LAS float* sc = (LAS float*)c.lds;
    LAS unsigned* lcnt = (LAS unsigned*)(c.lds + LDS_MISC + 1024); LAS unsigned* gbase = lcnt + 64;
    const int tid = c.tid;
    for (int t0 = c.bid * NTHREADS; t0 < T; t0 += c.G * NTHREADS) {
        const int t = t0 + tid;
        if (tid < 64) lcnt[tid] = 0u;
        const float* lr = logits + (size_t)t * 64;
#pragma unroll
        for (int q = 0; q < 16; ++q) { const f32x4 v = *(const f32x4*)(lr + 4 * q);
#pragma unroll
            for (int j = 0; j < 4; ++j) { const int e = 4 * q + j; sc[e * NTHREADS + tid] = 1.f / (1.f + __expf(-v[j])) + p.rbias[l * 64 + e]; } }
        float gs[8];
#pragma unroll
        for (int g = 0; g < 8; ++g) { float a = -__builtin_inff(), b2 = -__builtin_inff();
#pragma unroll
            for (int j = 0; j < 8; ++j) { const float v = sc[(8 * g + j) * NTHREADS + tid]; if (v > a) { b2 = a; a = v; } else if (v > b2) b2 = v; }
            gs[g] = a + b2; }
        unsigned gmask = 0u;
#pragma unroll
        for (int r = 0; r < 4; ++r) { float best = -__builtin_inff(); int bi = 0;
#pragma unroll
            for (int g = 0; g < 8; ++g) { const bool ok = !((gmask >> g) & 1u) && gs[g] > best; best = ok ? gs[g] : best; bi = ok ? g : bi; }
            gmask |= 1u << bi; }
        unsigned long long taken = 0ull; int ek[8]; float wk[8]; float wsum = 0.f;
#pragma unroll
        for (int k = 0; k < 8; ++k) { float best = -__builtin_inff(); int bi = 0;
            for (int e = 0; e < 64; ++e) { const bool ok = ((gmask >> (e >> 3)) & 1u) && !((taken >> e) & 1ull); const float v = sc[e * NTHREADS + tid]; if (ok && v > best) { best = v; bi = e; } }
            taken |= 1ull << bi; ek[k] = bi; const float w = 1.f / (1.f + __expf(-lr[bi])); wk[k] = w; wsum += w; }
        __syncthreads();
        unsigned rk[8];
#pragma unroll
        for (int k = 0; k < 8; ++k) rk[k] = atomicAdd((unsigned*)&lcnt[ek[k]], 1u);
        __syncthreads();
        if (tid < 64) gbase[tid] = atomicAdd(&cnt[tid], lcnt[tid]);
        __syncthreads();
        const float inv = 2.5f / wsum;
#pragma unroll
        for (int k = 0; k < 8; ++k) { tg[(size_t)t * 8 + k] = wk[k] * inv; lists[(size_t)ek[k] * T + gbase[ek[k]] + rk[k]] = t * 8 + k; }
        __syncthreads();
    }
}

__device__ __forceinline__ void ph_combine(const Params& p, const Ctx& c, int l) {
    unsigned char* ws = p.ws;
    const float* mod = (const float*)(ws + WS_MOD) + (size_t)l * 16 * 6144; const float* modn = mod + 16 * 6144; bf16_t* H = (bf16_t*)(ws + WS_H);
    const bf16_t* Y = (const bf16_t*)(ws + WS_Y); const float* tg = (const float*)(ws + WS_TG);
    for (int t = c.gw; t < T; t += c.ngw) { const int b = t / S; f32x4 f[4]; float* xr = p.out + (size_t)t * 1024;
        { const bf16_t* yr = Y + (size_t)(8 * T + t) * 1024;
#pragma unroll
            for (int j = 0; j < 4; ++j) { const u32x2 w = *(const u32x2*)(yr + 4 * c.lane + 256 * j); f[j] = (f32x4){bflo(w.x), bfhi(w.x), bflo(w.y), bfhi(w.y)}; } }
        f32x4 r4[4];
#pragma unroll
        for (int j = 0; j < 4; ++j) r4[j] = (f32x4){0.f, 0.f, 0.f, 0.f};
#pragma unroll
        for (int k = 0; k < 8; ++k) { const float gk = tg[(size_t)t * 8 + k]; const bf16_t* yr = Y + (size_t)(t * 8 + k) * 1024;
#pragma unroll
            for (int j = 0; j < 4; ++j) { const u32x2 w = *(const u32x2*)(yr + 4 * c.lane + 256 * j); r4[j] += (f32x4){bflo(w.x), bfhi(w.x), bflo(w.y), bfhi(w.y)} * gk; } }
        f32x4 v[4];
#pragma unroll
        for (int j = 0; j < 4; ++j) { const f32x4 g2 = *(const f32x4*)(mod + (size_t)b * 6144 + 5 * 1024 + 4 * c.lane + 256 * j); v[j] = *(const f32x4*)(xr + 4 * c.lane + 256 * j) * ALPHA + g2 * (f[j] + r4[j]); }
        ln_row(v, p.ln2g + l * 1024, p.ln2b + l * 1024, c.lane);
#pragma unroll
        for (int j = 0; j < 4; ++j) *(f32x4*)(xr + 4 * c.lane + 256 * j) = v[j];
        if (l + 1 < NL) write_mod_row(v, modn + (size_t)b * 6144 + 0, modn + (size_t)b * 6144 + 1024, H + (size_t)t * 1024, c.lane); }
}

#define GEMM_BODY gemm_naive

__global__ void __launch_bounds__(NTHREADS, 2) mk_fwd(Params p, int seg_lo, int seg_hi) {
    extern __shared__ __attribute__((aligned(16))) unsigned char lds_raw[];
    Ctx c0; c0.lds = (LAS unsigned char*)lds_raw; c0.tid = threadIdx.x; c0.lane = c0.tid & 63; c0.wid = __builtin_amdgcn_readfirstlane(c0.tid >> 6);
    c0.G = gridDim.x; c0.bid = blockIdx.x; c0.gw = c0.bid * NWAVES + c0.wid; c0.ngw = c0.G * NWAVES;
    volatile LAS unsigned* misc = (volatile LAS unsigned*)(c0.lds + LDS_MISC);
    if (c0.tid < 64) misc[c0.tid] = 0u;
    __syncthreads();
    XcdBarrier bar = xcd_barrier_post((unsigned*)(p.ws + WS_CTL) + CW_BAR, misc);
    LAS int* tp = (LAS int*)(c0.lds + LDS_MISC + 256);
#define IN(k) (seg_lo <= (k) && (k) < seg_hi)
#define SEAM(k) do { if (IN((k) + 1)) xcd_barrier(bar); } while (0)

    if (IN(0)) { PHASE_Q ph_prologue(q, c); SEAM(0); }
    for (int l = 0; l < NL; ++l) {
        const int sb = 1 + l * PH_PER_LAYER;
        if (IN(sb + 0)) { PHASE_Q ph_prep(q, c, l); SEAM(sb + 0); }
        if (IN(sb + 1)) {
            PHASE_Q
            GemmDesc g{(const bf16_t*)(ws + WS_H), 1024, 1024, 1024};
            DenseSched sc{(const bf16_t*)(ws + WS_WIN) + (size_t)l * 1024 * 1024, 1024, T / 256, 4, c.G, c.bid};
            EpiP e{(bf16_t*)(ws + WS_P)};
            GEMM_BODY<EpiP::PERM>(c.lds, c.tid, g, sc, e); SEAM(sb + 1); }
        if (IN(sb + 2)) { PHASE_Q ph_post_in(q, c, l); SEAM(sb + 2); }
        if (IN(sb + 3)) {
            PHASE_Q
            { GemmDesc g{(const bf16_t*)(ws + WS_P) + 256, 1024, 384, 384};
              DenseSched sc{(const bf16_t*)(ws + WS_WUQ) + (size_t)l * 1280 * 384, 384, T / 256, 5, c.G, c.bid};
              EpiQ e{(bf16_t*)(ws + WS_Q), (const float*)(ws + WS_RSQ), (const f32x2*)(ws + WS_CS)};
              GEMM_BODY<EpiQ::PERM>(c.lds, c.tid, g, sc, e); }
            { GemmDesc g{(const bf16_t*)(ws + WS_P) + 640, 1024, 256, 256};
              DenseSched sc{(const bf16_t*)(ws + WS_WUKV) + (size_t)l * 1536 * 256, 256, T / 256, 6, c.G, c.G - 1 - c.bid};
              EpiKV e{(bf16_t*)(ws + WS_KF), (bf16_t*)(ws + WS_V), (const float*)(ws + WS_RSKV)};
              GEMM_BODY<EpiKV::PERM>(c.lds, c.tid, g, sc, e); }
            SEAM(sb + 3); }
        if (IN(sb + 4)) { PHASE_Q ph_attn_naive(q, c); SEAM(sb + 4); }
        if (IN(sb + 5)) {
            PHASE_Q const float* mod = (const float*)(ws + WS_MOD) + (size_t)l * 16 * 6144;
            GemmDesc g{(const bf16_t*)(ws + WS_MIX), 1024, 1024, 1024};
            DenseSched sc{(const bf16_t*)(ws + WS_WOUT) + (size_t)l * 1024 * 1024, 1024, T / 256, 4, c.G, c.bid};
            EpiOut e{l == 0 ? q.x : q.out, q.out, mod + 2 * 1024};
            GEMM_BODY<EpiOut::PERM>(c.lds, c.tid, g, sc, e); SEAM(sb + 5); }
        if (IN(sb + 6)) { PHASE_Q ph_ln1(q, c, l); SEAM(sb + 6); }
        if (IN(sb + 7)) {
            PHASE_Q
            GemmDesc g{(const bf16_t*)(ws + WS_H), 1024, 1024, 1024};
            DenseSched sc{(const bf16_t*)(ws + WS_WR) + (size_t)l * 256 * 1024, 1024, T / 256, 1, c.G, c.bid};
            EpiRouter e{(float*)(ws + WS_LOG)};
            GEMM_BODY<EpiRouter::PERM>(c.lds, c.tid, g, sc, e); SEAM(sb + 7); }
        if (IN(sb + 8)) { PHASE_Q ph_route(q, c, l); SEAM(sb + 8); }
        if (IN(sb + 9)) {
            PHASE_Q
            moe_build_tiles(tp, (const int*)((unsigned*)(ws + WS_CTL) + CW_CNT + l * 64));
            GemmDesc g{(const bf16_t*)(ws + WS_H), 1024, 1024, 1024};
            MoeSched sc{(const bf16_t*)(ws + WS_WGU), (size_t)512 * 1024, 1024, (const int*)(ws + WS_LIST), (const int*)((unsigned*)(ws + WS_CTL) + CW_CNT + l * 64), tp, 2, c.G, c.bid, true};
            EpiSwiglu e{(bf16_t*)(ws + WS_ACT)};
            GEMM_BODY<EpiSwiglu::PERM>(c.lds, c.tid, g, sc, e); SEAM(sb + 9); }
        if (IN(sb + 10)) {
            PHASE_Q
            moe_build_tiles(tp, (const int*)((unsigned*)(ws + WS_CTL) + CW_CNT + l * 64));
            GemmDesc g{(const bf16_t*)(ws + WS_ACT), 256, 256, 256};
            MoeSched sc{(const bf16_t*)(ws + WS_WD), (size_t)1024 * 256, 256, (const int*)(ws + WS_LIST), (const int*)((unsigned*)(ws + WS_CTL) + CW_CNT + l * 64), tp, 4, c.G, c.bid, false};
            EpiDown e{(bf16_t*)(ws + WS_Y)};
            GEMM_BODY<EpiDown::PERM>(c.lds, c.tid, g, sc, e); SEAM(sb + 10); }
        if (IN(sb + 11)) { PHASE_Q ph_combine(q, c, l); SEAM(sb + 11); }
    }
#undef IN
#undef SEAM
}

#ifndef MK_ONE_LAUNCH
#define MK_ONE_LAUNCH 0
#endif
extern "C" void kernel_launch(void* const* d_in, const int* in_sizes, int n_in, void* d_out, int out_size, void* d_ws, size_t ws_size, hipStream_t stream) {
    static int grid = 0;
    if (grid == 0) {
        if (n_in != 25 || out_size != T * D || ws_size < WS_END) { fprintf(stderr, "kernel_launch: unexpected shapes (n_in %d out %d ws %zu need %zu)\n", n_in, out_size, ws_size, (size_t)WS_END); grid = -1; return; }
        int dev = 0, cus = 0, per_cu = 0;
        if (hipGetDevice(&dev) != hipSuccess || hipDeviceGetAttribute(&cus, hipDeviceAttributeMultiprocessorCount, dev) != hipSuccess) { grid = -1; return; }
        if (hipFuncSetAttribute((const void*)mk_fwd, hipFuncAttributeMaxDynamicSharedMemorySize, LDS_BYTES) != hipSuccess) { fprintf(stderr, "kernel_launch: hipFuncSetAttribute failed\n"); grid = -1; return; }
        if (hipOccupancyMaxActiveBlocksPerMultiprocessor(&per_cu, (const void*)mk_fwd, NTHREADS, LDS_BYTES) != hipSuccess || per_cu < 1) { fprintf(stderr, "kernel_launch: occupancy query says %d\n", per_cu); }
        (void)hipGetLastError();
        grid = cus;
    }
    if (grid < 0) return;
    (void)hipMemsetAsync((char*)d_ws + WS_CTL, 0, CTL_BYTES, stream);
    Params p{};
    p.x = (const float*)d_in[0]; p.c = (const float*)d_in[1]; p.pos = (const int*)d_in[2];
    p.w_ada = (const float*)d_in[3]; p.b_ada = (const float*)d_in[4]; p.w_in = (const float*)d_in[5]; p.qg = (const float*)d_in[6]; p.kvg = (const float*)d_in[7];
    p.w_uq = (const float*)d_in[8]; p.w_ukv = (const float*)d_in[9]; p.w_pool = (const float*)d_in[10]; p.pool_scale = (const float*)d_in[11]; p.w_out = (const float*)d_in[12];
    p.ln1g = (const float*)d_in[13]; p.ln1b = (const float*)d_in[14]; p.w_router = (const float*)d_in[15]; p.rbias = (const float*)d_in[16];
    p.weg = (const float*)d_in[17]; p.weu = (const float*)d_in[18]; p.wed = (const float*)d_in[19]; p.wsg = (const float*)d_in[20]; p.wsu = (const float*)d_in[21]; p.wsd = (const float*)d_in[22];
    p.ln2g = (const float*)d_in[23]; p.ln2b = (const float*)d_in[24];
    p.out = (float*)d_out; p.ws = (unsigned char*)d_ws;
#if MK_ONE_LAUNCH
    hipLaunchKernelGGL(mk_fwd, dim3(grid), dim3(NTHREADS), LDS_BYTES, stream, p, 0, NSEG);
#else
    for (int s = 0; s < NSEG; ++s) hipLaunchKernelGGL(mk_fwd, dim3(grid), dim3(NTHREADS), LDS_BYTES, stream, p, s, s + 1);
#endif
}
```

```cpp
#include <hip/hip_runtime.h>
#include <stdint.h>
#include <cstdio>

#define LAS __attribute__((address_space(3)))
typedef unsigned short bf16_t;
typedef short bf16x8 __attribute__((ext_vector_type(8)));
typedef float f32x4 __attribute__((ext_vector_type(4)));
typedef float f32x2 __attribute__((ext_vector_type(2)));
typedef unsigned u32x4 __attribute__((ext_vector_type(4)));
typedef unsigned u32x2 __attribute__((ext_vector_type(2)));

constexpr int D = 1024, NB = 16, S = 2048, T = NB * S, NL = 4;
constexpr int NE = 64, TOPK = 8, FE = 256, NH = 6;
constexpr int INW = 960;
constexpr int A_TOT = T * 9;
constexpr float ALPHA = 1.6817928305074290f;
constexpr float LN_EPS = 1e-5f, RMS_EPS = 1e-6f;
constexpr float QSCALE = 0.07216878364870322f * 1.4426950408889634f;
constexpr int NTHREADS = 512, NWAVES = 8;
constexpr int LDS_BYTES = 163840, LDS_MISC = 131072;
constexpr int PH_PER_LAYER = 12, NSEG = 1 + NL * PH_PER_LAYER;

constexpr size_t al256(size_t x) { return (x + 255) & ~(size_t)255; }
constexpr size_t WS_CTL = 0, CTL_BYTES = 1u << 20;
constexpr size_t CW_BAR = 4096;
constexpr size_t CW_CNT = 16384;
constexpr size_t WS_MOD = WS_CTL + CTL_BYTES;
constexpr size_t WS_CS = al256(WS_MOD + (size_t)NL * 16 * 6144 * 4);
constexpr size_t WS_RSQ = al256(WS_CS + (size_t)T * 32 * 8);
constexpr size_t WS_RSKV = al256(WS_RSQ + (size_t)T * 4);
constexpr size_t WS_WIN = al256(WS_RSKV + (size_t)T * 4);
constexpr size_t WS_WUQ = al256(WS_WIN + (size_t)NL * 1024 * 1024 * 2);
constexpr size_t WS_WUKV = al256(WS_WUQ + (size_t)NL * 1280 * 384 * 2);
constexpr size_t WS_WOUT = al256(WS_WUKV + (size_t)NL * 1536 * 256 * 2);
constexpr size_t WS_WR = al256(WS_WOUT + (size_t)NL * 1024 * 1024 * 2);
constexpr size_t WS_WGU = al256(WS_WR + (size_t)NL * 256 * 1024 * 2);
constexpr size_t WS_WD = al256(WS_WGU + (size_t)65 * 512 * 1024 * 2);
constexpr size_t WS_H = al256(WS_WD + (size_t)65 * 1024 * 256 * 2);
constexpr size_t WS_R = al256(WS_H + (size_t)T * 1024 * 2);
constexpr size_t WS_P = WS_R;
constexpr size_t WS_Q = al256(WS_P + (size_t)T * 1024 * 2);
constexpr size_t WS_KF = al256(WS_Q + (size_t)T * 1152 * 2);
constexpr size_t WS_V = al256(WS_KF + (size_t)T * 1152 * 2);
constexpr size_t WS_MIX = al256(WS_V + (size_t)T * 768 * 2);
constexpr size_t WS_MIX_END = al256(WS_MIX + (size_t)T * 1024 * 2);
constexpr size_t WS_ACT = WS_R;
constexpr size_t WS_LOG = al256(WS_ACT + (size_t)(A_TOT + 1) * 256 * 2);
constexpr size_t WS_TG = al256(WS_LOG + (size_t)T * 64 * 4);
constexpr size_t WS_LIST = al256(WS_TG + (size_t)T * 8 * 4);
constexpr size_t WS_Y = al256(WS_LIST + (size_t)64 * T * 4);
constexpr size_t WS_END = al256(WS_Y + (size_t)(A_TOT + 1) * 1024 * 2);
static_assert(WS_MIX_END <= WS_END && WS_END < 1000000000ull, "workspace map");

struct Params {
    const float *x, *c; const int* pos;
    const float *w_ada, *b_ada, *w_in, *qg, *kvg, *w_uq, *w_ukv, *w_pool, *pool_scale, *w_out, *ln1g, *ln1b, *w_router, *rbias;
    const float *weg, *weu, *wed, *wsg, *wsu, *wsd, *ln2g, *ln2b;
    float* out; unsigned char* ws;
};

__device__ __forceinline__ unsigned cvt_pk_bf16(float lo, float hi) { unsigned r; asm volatile("v_cvt_pk_bf16_f32 %0, %1, %2" : "=v"(r) : "v"(lo), "v"(hi)); return r; }
__device__ __forceinline__ float bf2f(bf16_t b) { return __uint_as_float(((unsigned)b) << 16); }
__device__ __forceinline__ float bflo(unsigned w) { return __uint_as_float(w << 16); }
__device__ __forceinline__ float bfhi(unsigned w) { return __uint_as_float(w & 0xffff0000u); }
__device__ __forceinline__ float wave_sum(float v) {
#pragma unroll
    for (int o = 1; o < 64; o <<= 1) v += __shfl_xor(v, o);
    return v;
}
__device__ __forceinline__ float wave_max(float v) {
#pragma unroll
    for (int o = 1; o < 64; o <<= 1) v = fmaxf(v, __shfl_xor(v, o));
    return v;
}
__device__ __forceinline__ void store8_bf16(bf16_t* p, f32x4 a, f32x4 b) {
    u32x4 w; w.x = cvt_pk_bf16(a[0], a[1]); w.y = cvt_pk_bf16(a[2], a[3]); w.z = cvt_pk_bf16(b[0], b[1]); w.w = cvt_pk_bf16(b[2], b[3]);
    *(u32x4*)p = w;
}

template <class Tp> __device__ __forceinline__ Tp* launder(Tp* p) { asm volatile("" : "+s"(p)); return p; }
#define PHASE_Q Params q = p; q.ws = launder(p.ws); q.out = launder(p.out); q.x = launder(p.x); unsigned char* ws = q.ws; (void)ws; \
    Ctx c = c0; asm volatile("" : "+v"(c.tid), "+v"(c.lane)); asm volatile("" : "+s"(c.gw), "+s"(c.wid), "+s"(c.bid));

#define XB_TMO      128
#define XB_XCNT(j)  (256  + 64 * (j))
#define XB_XSUB(j)  (1280 + 64 * (j))
#define XB_XGEN(j)  (2304 + 64 * (j))
#define XB_TOP      3328
#define XB_TOPGEN   3392
#define XCD_BAR_WORDS 3456
#define XB_SPIN_CAP (1u << 20)
__device__ __forceinline__ unsigned xb_ld(unsigned* p)              { return __hip_atomic_load(p, __ATOMIC_RELAXED, __HIP_MEMORY_SCOPE_AGENT); }
__device__ __forceinline__ unsigned xb_add(unsigned* p, unsigned v) { return __hip_atomic_fetch_add(p, v, __ATOMIC_RELAXED, __HIP_MEMORY_SCOPE_AGENT); }
__device__ __forceinline__ unsigned xb_xcc_id() { return (unsigned)__builtin_amdgcn_s_getreg((3 << 11) | 20) & 0xFu; }
#define XB_SPIN(cond, bar) do { unsigned _sp = 0; while (cond) { __builtin_amdgcn_s_sleep(1); \
    if ((++_sp & 255u) == 0u) { if (xb_ld(&(bar)[XB_TMO])) break; if (_sp > XB_SPIN_CAP) { atomicAdd(&(bar)[XB_TMO], 1u); break; } } } } while (0)
struct XcdBarrier { unsigned* bar; unsigned x; volatile LAS unsigned* st; };
__device__ __forceinline__ XcdBarrier xcd_barrier_post(unsigned* bar, volatile LAS unsigned* st) {
    XcdBarrier b; b.bar = bar; b.x = xb_xcc_id(); b.st = st;
    if (threadIdx.x == 0) (void)xb_add(&bar[XB_XCNT(b.x)], 1u);
    return b;
}
__device__ __forceinline__ void xcd_barrier_complete(unsigned* bar, unsigned x, unsigned& nloc, unsigned& nx) {
    const unsigned G = gridDim.x * gridDim.y * gridDim.z;
    unsigned sum, cnt, mine, sp = 0u;
    for (;;) {
        sum = 0u; cnt = 0u; mine = 0u;
#pragma unroll
        for (unsigned j = 0; j < 16; ++j) { const unsigned c = xb_ld(&bar[XB_XCNT(j)]); sum += c; cnt += (c > 0u) ? 1u : 0u; mine = (j == x) ? c : mine; }
        if (sum == G) break;
        __builtin_amdgcn_s_sleep(1);
        if ((++sp & 255u) == 0u) { if (xb_ld(&bar[XB_TMO])) break; if (sp > XB_SPIN_CAP) { atomicAdd(&bar[XB_TMO], 1u); break; } }
    }
    nloc = mine > 0u ? mine : 1u; nx = cnt > 0u ? cnt : 1u;
}
__device__ __forceinline__ void xcd_barrier(const XcdBarrier& b) {
    asm volatile("s_waitcnt vmcnt(0)" ::: "memory");
    __syncthreads();
    if (threadIdx.x == 0) {
        unsigned* bar = b.bar;
        __builtin_amdgcn_s_waitcnt(0);
        unsigned nloc = b.st[0], nx = b.st[1];
        if (nloc == 0u) { xcd_barrier_complete(bar, b.x, nloc, nx); b.st[0] = nloc; b.st[1] = nx; }
        const unsigned old = xb_add(&bar[XB_XSUB(b.x)], 1u);
        const unsigned gen = old / nloc;
        if (old + 1u == (gen + 1u) * nloc) {
            __builtin_amdgcn_fence(__ATOMIC_RELEASE, "agent");
            asm volatile("s_waitcnt vmcnt(0)" ::: "memory");
            const unsigned og = xb_add(&bar[XB_TOP], 1u);
            const unsigned tg = og / nx;
            if (og + 1u == (tg + 1u) * nx) xb_add(&bar[XB_TOPGEN], 1u);
            else XB_SPIN(xb_ld(&bar[XB_TOPGEN]) == tg, bar);
            __builtin_amdgcn_fence(__ATOMIC_ACQUIRE, "agent");
            xb_add(&bar[XB_XGEN(b.x)], 1u);
            asm volatile("s_waitcnt vmcnt(0)" ::: "memory");
        } else {
            XB_SPIN(xb_ld(&bar[XB_XGEN(b.x)]) == gen, bar);
            __builtin_amdgcn_fence(__ATOMIC_ACQUIRE, "agent");
            asm volatile("s_waitcnt vmcnt(0)" ::: "memory");
        }
    }
    __syncthreads();
}

struct Unit { const bf16_t* Bt; int pm, pn, e, base, cnt; };
struct GemmDesc { const bf16_t* A; int lda, ldb, K; };

struct DenseSched {
    const bf16_t* Bt; int ldb, nM, nN, G, c;
    __device__ __forceinline__ bool next(int i, Unit& u) const {
        const int Lx = i * G + c; if (Lx >= nM * nN) return false;
        const int nig = 8 * nN, gid = Lx / nig, fm = gid * 8, gsz = (nM - fm) < 8 ? (nM - fm) : 8, w = Lx % nig;
        u.pm = fm + (w % gsz); u.pn = w / gsz; u.e = 0; u.base = u.pm * 256; u.cnt = 256;
        u.Bt = Bt + (size_t)u.pn * 256 * ldb; return true;
    }
    __device__ __forceinline__ int arow(const Unit& u, int r) const { return u.base + r; }
    __device__ __forceinline__ int orow(const Unit& u, int r) const { return u.base + r; }
};
struct MoeSched {
    const bf16_t* W; size_t w_estride; int ldb; const int* lists; const int* cnt; const LAS int* tp; int nsub, G, c; bool up;
    __device__ __forceinline__ bool next(int i, Unit& u) const {
        const int Lx = i * G + c, ntile = tp[65]; if (Lx >= ntile * nsub) return false;
        int e = 0;
#pragma unroll 1
        for (int s = 32; s >= 1; s >>= 1) if (e + s <= 64 && tp[e + s] * nsub <= Lx) e += s;
        if (e < 64 && tp[e + 1] * nsub <= Lx) e += 1;
        const int nt_e = tp[e + 1] - tp[e], w = Lx - tp[e] * nsub, sub = w / nt_e, ti = w % nt_e;
        u.e = e; u.pn = sub; u.pm = ti; u.base = ti * 256; u.cnt = (e < 64) ? cnt[e] : T;
        u.Bt = W + (size_t)e * w_estride + (size_t)sub * 256 * ldb; return true;
    }
    __device__ __forceinline__ int asg(const Unit& u, int r) const {
        const int pos = u.base + r;
        if (u.e == 64) return 8 * T + pos;
        return pos < u.cnt ? lists[(size_t)u.e * T + pos] : A_TOT;
    }
    __device__ __forceinline__ int arow(const Unit& u, int r) const {
        const int a = asg(u, r);
        if (!up) return a;
        return a < 8 * T ? (a >> 3) : (a < A_TOT ? a - 8 * T : 0);
    }
    __device__ __forceinline__ int orow(const Unit& u, int r) const { return asg(u, r); }
};
__device__ __forceinline__ void moe_build_tiles(LAS int* tp, const int* cnt) {
    if (threadIdx.x == 0) { int s = 0; for (int e = 0; e < 64; ++e) { tp[e] = s; s += (cnt[e] + 255) >> 8; } tp[64] = s; tp[65] = s + T / 256; }
    __syncthreads();
}

template <bool PERM, class Sch, class Epi>
__device__ __forceinline__ void gemm_naive(LAS unsigned char* lds, int tid, const GemmDesc g, const Sch& Sc, const Epi& E) {
    const int wid = tid >> 6, lane = tid & 63, wr = wid >> 2, wc = wid & 3, fr = lane & 15, fq = lane >> 4;
    constexpr int LP = 260;
    LAS float* As = (LAS float*)lds; LAS float* Bs = As + 32 * LP;
    const int sr = tid >> 1, kh = tid & 1;
    Unit u;
    for (int i = 0; Sc.next(i, u); ++i) {
        f32x4 acc[2][2][4][2];
#pragma unroll
        for (int a = 0; a < 2; ++a)
#pragma unroll
            for (int b = 0; b < 2; ++b)
#pragma unroll
                for (int m = 0; m < 4; ++m)
#pragma unroll
                    for (int n = 0; n < 2; ++n) acc[a][b][m][n] = (f32x4){0.f, 0.f, 0.f, 0.f};
        const bf16_t* ap = g.A + (size_t)Sc.arow(u, sr) * g.lda + kh * 16;
        const bf16_t* bp = u.Bt + (size_t)sr * g.ldb + kh * 16;
        for (int k0 = 0; k0 < g.K; k0 += 32) {
            const u32x4 a0 = *(const u32x4*)(ap + k0), a1 = *(const u32x4*)(ap + k0 + 8);
            const u32x4 b0 = *(const u32x4*)(bp + k0), b1 = *(const u32x4*)(bp + k0 + 8);
            __syncthreads();
#pragma unroll
            for (int j = 0; j < 4; ++j) {
                As[(kh * 16 + 2 * j) * LP + sr] = bflo(a0[j]); As[(kh * 16 + 2 * j + 1) * LP + sr] = bfhi(a0[j]);
                As[(kh * 16 + 8 + 2 * j) * LP + sr] = bflo(a1[j]); As[(kh * 16 + 9 + 2 * j) * LP + sr] = bfhi(a1[j]);
                Bs[(kh * 16 + 2 * j) * LP + sr] = bflo(b0[j]); Bs[(kh * 16 + 2 * j + 1) * LP + sr] = bfhi(b0[j]);
                Bs[(kh * 16 + 8 + 2 * j) * LP + sr] = bflo(b1[j]); Bs[(kh * 16 + 9 + 2 * j) * LP + sr] = bfhi(b1[j]);
            }
            __syncthreads();
#pragma unroll 4
            for (int kk = 0; kk < 32; ++kk) {
                float av[2][4]; f32x4 bv[2][2];
#pragma unroll
                for (int ai = 0; ai < 2; ++ai)
#pragma unroll
                    for (int m = 0; m < 4; ++m) av[ai][m] = As[kk * LP + 128 * ai + 64 * wr + 16 * m + fr];
#pragma unroll
                for (int bj = 0; bj < 2; ++bj)
#pragma unroll
                    for (int n = 0; n < 2; ++n) bv[bj][n] = *(const LAS f32x4*)&Bs[kk * LP + 128 * bj + 32 * wc + (PERM ? 8 * fq + 4 * n : 16 * n + 4 * fq)];
#pragma unroll
                for (int ai = 0; ai < 2; ++ai)
#pragma unroll
                    for (int bj = 0; bj < 2; ++bj)
#pragma unroll
                        for (int m = 0; m < 4; ++m)
#pragma unroll
                            for (int n = 0; n < 2; ++n) acc[ai][bj][m][n] += bv[bj][n] * av[ai][m];
            }
        }
        E(acc, u, Sc, wr, wc, fr, fq);
    }
    __syncthreads();
}

#define EPI_ROWS(ai, m) (128 * (ai) + 64 * wr + 16 * (m) + fr)
struct EpiP {
    static constexpr bool PERM = true;
    bf16_t* P;
    template <class Sch> __device__ __forceinline__ void operator()(const f32x4 (&acc)[2][2][4][2], const Unit& u, const Sch& Sc, int wr, int wc, int fr, int fq) const {
#pragma unroll
        for (int ai = 0; ai < 2; ++ai)
#pragma unroll
            for (int m = 0; m < 4; ++m) { bf16_t* rp = P + (size_t)Sc.orow(u, EPI_ROWS(ai, m)) * 1024 + u.pn * 256 + 32 * wc + 8 * fq;
#pragma unroll
                for (int bj = 0; bj < 2; ++bj) store8_bf16(rp + 128 * bj, acc[ai][bj][m][0], acc[ai][bj][m][1]); }
    }
};
struct EpiQ {
    static constexpr bool PERM = true;
    bf16_t* Q; const float* rsq; const f32x2* cs;
    template <class Sch> __device__ __forceinline__ void operator()(const f32x4 (&acc)[2][2][4][2], const Unit& u, const Sch& Sc, int wr, int wc, int fr, int fq) const {
#pragma unroll
        for (int ai = 0; ai < 2; ++ai)
#pragma unroll
            for (int m = 0; m < 4; ++m) {
                const int row = Sc.orow(u, EPI_ROWS(ai, m)); const float rs = rsq[row];
                if (u.pn < 3) {
#pragma unroll
                    for (int bj = 0; bj < 2; ++bj) store8_bf16(Q + (size_t)row * 1152 + (2 * u.pn + bj) * 192 + 32 * wc + 8 * fq, acc[ai][bj][m][0] * rs, acc[ai][bj][m][1] * rs);
                } else {
                    const int head = (u.pn == 3) ? wc : 4 + wc;
                    if (head < NH) {
                        const f32x2* cp = cs + (size_t)row * 32 + 8 * fq;
                        f32x4 lo[2], hi[2];
#pragma unroll
                        for (int n = 0; n < 2; ++n)
#pragma unroll
                            for (int j = 0; j < 4; ++j) { const f32x2 c = cp[4 * n + j]; const float x1 = acc[ai][0][m][n][j], x2 = acc[ai][1][m][n][j];
                                lo[n][j] = (x1 * c.x - x2 * c.y) * rs; hi[n][j] = (x2 * c.x + x1 * c.y) * rs; }
                        bf16_t* qp = Q + (size_t)row * 1152 + head * 192 + 128 + 8 * fq;
                        store8_bf16(qp, lo[0], lo[1]); store8_bf16(qp + 32, hi[0], hi[1]);
                    }
                }
            }
    }
};
struct EpiKV {
    static constexpr bool PERM = true;
    bf16_t* Kf; bf16_t* V; const float* rskv;
    template <class Sch> __device__ __forceinline__ void operator()(const f32x4 (&acc)[2][2][4][2], const Unit& u, const Sch& Sc, int wr, int wc, int fr, int fq) const {
#pragma unroll
        for (int ai = 0; ai < 2; ++ai)
#pragma unroll
            for (int m = 0; m < 4; ++m) {
                const int row = Sc.orow(u, EPI_ROWS(ai, m)); const float rs = rskv[row];
                store8_bf16(Kf + (size_t)row * 1152 + u.pn * 192 + 32 * wc + 8 * fq, acc[ai][0][m][0] * rs, acc[ai][0][m][1] * rs);
                store8_bf16(V + (size_t)row * 768 + u.pn * 128 + 32 * wc + 8 * fq, acc[ai][1][m][0] * rs, acc[ai][1][m][1] * rs);
            }
    }
};
struct EpiOut {
    static constexpr bool PERM = false;
    const float* xin; float* y; const float* g1;
    template <class Sch> __device__ __forceinline__ void operator()(const f32x4 (&acc)[2][2][4][2], const Unit& u, const Sch& Sc, int wr, int wc, int fr, int fq) const {
        const int b = (u.pm * 256) / S; const int col0 = u.pn * 256 + 32 * wc + 4 * fq;
        f32x4 gv[2][2];
#pragma unroll
        for (int bj = 0; bj < 2; ++bj)
#pragma unroll
            for (int n = 0; n < 2; ++n) gv[bj][n] = *(const f32x4*)(g1 + (size_t)b * 6144 + col0 + 128 * bj + 16 * n);
#pragma unroll
        for (int ai = 0; ai < 2; ++ai)
#pragma unroll
            for (int m = 0; m < 4; ++m) { const size_t off = (size_t)Sc.orow(u, EPI_ROWS(ai, m)) * 1024 + col0;
#pragma unroll
                for (int bj = 0; bj < 2; ++bj)
#pragma unroll
                    for (int n = 0; n < 2; ++n) { const f32x4 xv = *(const f32x4*)(xin + off + 128 * bj + 16 * n);
                        *(f32x4*)(y + off + 128 * bj + 16 * n) = xv * ALPHA + gv[bj][n] * acc[ai][bj][m][n]; } }
    }
};
struct EpiRouter {
    static constexpr bool PERM = false;
    float* logits;
    template <class Sch> __device__ __forceinline__ void operator()(const f32x4 (&acc)[2][2][4][2], const Unit& u, const Sch& Sc, int wr, int wc, int fr, int fq) const {
        if (wc < 2) {
#pragma unroll
            for (int ai = 0; ai < 2; ++ai)
#pragma unroll
                for (int m = 0; m < 4; ++m) { float* rp = logits + (size_t)Sc.orow(u, EPI_ROWS(ai, m)) * 64 + 32 * wc + 4 * fq;
#pragma unroll
                    for (int n = 0; n < 2; ++n) *(f32x4*)(rp + 16 * n) = acc[ai][0][m][n]; }
        }
    }
};
struct EpiSwiglu {
    static constexpr bool PERM = true;
    bf16_t* act;
    template <class Sch> __device__ __forceinline__ void operator()(const f32x4 (&acc)[2][2][4][2], const Unit& u, const Sch& Sc, int wr, int wc, int fr, int fq) const {
#pragma unroll
        for (int ai = 0; ai < 2; ++ai)
#pragma unroll
            for (int m = 0; m < 4; ++m) { f32x4 o[2];
#pragma unroll
                for (int n = 0; n < 2; ++n)
#pragma unroll
                    for (int j = 0; j < 4; ++j) { const float gt = acc[ai][0][m][n][j], up = acc[ai][1][m][n][j]; o[n][j] = gt / (1.f + __expf(-gt)) * up; }
                store8_bf16(act + (size_t)Sc.orow(u, EPI_ROWS(ai, m)) * 256 + u.pn * 128 + 32 * wc + 8 * fq, o[0], o[1]); }
    }
};
struct EpiDown {
    static constexpr bool PERM = true;
    bf16_t* Y;
    template <class Sch> __device__ __forceinline__ void operator()(const f32x4 (&acc)[2][2][4][2], const Unit& u, const Sch& Sc, int wr, int wc, int fr, int fq) const {
#pragma unroll
        for (int ai = 0; ai < 2; ++ai)
#pragma unroll
            for (int m = 0; m < 4; ++m) { bf16_t* rp = Y + (size_t)Sc.orow(u, EPI_ROWS(ai, m)) * 1024 + u.pn * 256 + 32 * wc + 8 * fq;
#pragma unroll
                for (int bj = 0; bj < 2; ++bj) store8_bf16(rp + 128 * bj, acc[ai][bj][m][0], acc[ai][bj][m][1]); }
    }
};

__device__ __forceinline__ void xpose_item(const float* src, int ld, bf16_t* dst, int Kdst, const float* kscale  , float mul, LAS float* scr, int lane) {
#pragma unroll 8
    for (int i = 0; i < 32; ++i) { const int kk = 2 * i + (lane >> 5); float v = src[(size_t)kk * ld + (lane & 31)]; if (kscale) v *= kscale[kk]; scr[kk * 33 + (lane & 31)] = v * mul; }
    asm volatile("s_waitcnt lgkmcnt(0)" ::: "memory");
    const int c = lane & 7;
#pragma unroll
    for (int j = 0; j < 4; ++j) { const int n = (lane >> 3) + 8 * j; const LAS float* s = scr + (8 * c) * 33 + n;
        u32x4 o; o.x = cvt_pk_bf16(s[0 * 33], s[1 * 33]); o.y = cvt_pk_bf16(s[2 * 33], s[3 * 33]); o.z = cvt_pk_bf16(s[4 * 33], s[5 * 33]); o.w = cvt_pk_bf16(s[6 * 33], s[7 * 33]);
        *(u32x4*)(dst + (size_t)n * Kdst + 8 * c) = o; }
    asm volatile("s_waitcnt lgkmcnt(0)" ::: "memory");
}
__device__ __forceinline__ void zero_rows(bf16_t* dst, size_t nelem, int gw, int ngw, int lane) {
    for (size_t i = ((size_t)gw * 64 + lane) * 8; i < nelem; i += (size_t)ngw * 64 * 8) *(u32x4*)(dst + i) = (u32x4){0u, 0u, 0u, 0u};
}
__device__ __forceinline__ int uq_srccol(int g) {
    const int n = 32 * g;
    if (n < 768) return (n / 128) * 192 + (n % 128);
    if (n < 1024) { const int q = n - 768, half = q / 128, hh = (q % 128) / 32; return hh * 192 + 128 + half * 32; }
    { const int q = n - 1024, half = q / 128, w = q % 128; if (w >= 64) return -1; return (4 + w / 32) * 192 + 128 + half * 32; }
}

struct Ctx { LAS unsigned char* lds; int tid, lane, wid, gw, ngw, G, bid; };

__device__ __forceinline__ void ph_prologue(const Params& p, const Ctx& c) {
    unsigned char* ws = p.ws;
    float* mod = (float*)(ws + WS_MOD);
    {
        LAS float* cond = (LAS float*)c.lds;
        LAS float* red = cond + 16 * 1024;
        for (int i = c.tid; i < 16 * 1024; i += NTHREADS) { const float v = p.c[i]; cond[i] = v / (1.f + __expf(-v)); }
        __syncthreads();
        const int nc = c.tid & 127, kq = c.tid >> 7;
        for (int u = c.bid; u < NL * 48; u += c.G) {
            const int l = u / 48, n0 = (u % 48) * 128;
            float acc[16];
#pragma unroll
            for (int b = 0; b < 16; ++b) acc[b] = 0.f;
            const float* wp = p.w_ada + ((size_t)l * 1024 + kq * 256) * 6144 + n0 + nc;
#pragma unroll 4
            for (int k = 0; k < 256; ++k) { const float w = wp[(size_t)k * 6144];
#pragma unroll
                for (int b = 0; b < 16; ++b) acc[b] += cond[b * 1024 + kq * 256 + k] * w; }
#pragma unroll
            for (int b = 0; b < 16; ++b) red[(kq * 16 + b) * 128 + nc] = acc[b];
            __syncthreads();
            for (int o = c.tid; o < 2048; o += NTHREADS) { const int b = o >> 7, n = o & 127;
                mod[((size_t)l * 16 + b) * 6144 + n0 + n] = red[(0 * 16 + b) * 128 + n] + red[(1 * 16 + b) * 128 + n] + red[(2 * 16 + b) * 128 + n] + red[(3 * 16 + b) * 128 + n] + p.b_ada[l * 6144 + n0 + n]; }
            __syncthreads();
        }
    }
    {
        f32x2* cs = (f32x2*)(ws + WS_CS);
        for (int i = c.bid * NTHREADS + c.tid; i < T * 32; i += c.G * NTHREADS) {
            const int t = i >> 5, k = i & 31; const float inv = powf(10000.f, -(float)k / 32.f); const float ang = (float)p.pos[t] * inv;
            float sn, cn; sincosf(ang, &sn, &cn); cs[i] = (f32x2){cn, sn};
        }
    }
    {
        LAS float* scr = (LAS float*)(c.lds + c.wid * 16384);
        bf16_t* WinT = (bf16_t*)(ws + WS_WIN); bf16_t* WuqT = (bf16_t*)(ws + WS_WUQ); bf16_t* WukvT = (bf16_t*)(ws + WS_WUKV);
        bf16_t* WoutT = (bf16_t*)(ws + WS_WOUT); bf16_t* WrT = (bf16_t*)(ws + WS_WR);
        constexpr int I_IN = 30 * 16, I_UQ = 40 * 6, I_UKV = 48 * 4, I_OUT = 32 * 16, I_R = 2 * 16, I_L = I_IN + I_UQ + I_UKV + I_OUT + I_R;
        for (int it = c.gw; it < NL * I_L; it += c.ngw) {
            const int l = it / I_L; int r = it % I_L;
            if (r < I_IN) { const int g = r / 16, kb = r % 16; xpose_item(p.w_in + ((size_t)l * 1024 + 64 * kb) * INW + 32 * g, INW, WinT + ((size_t)l * 1024 + 32 * g) * 1024 + 64 * kb, 1024, nullptr, 1.f, scr, c.lane); continue; } r -= I_IN;
            if (r < I_UQ) { const int g = r / 6, kb = r % 6, sc = uq_srccol(g); bf16_t* dst = WuqT + ((size_t)l * 1280 + 32 * g) * 384 + 64 * kb;
                if (sc >= 0) xpose_item(p.w_uq + ((size_t)l * 384 + 64 * kb) * 1152 + sc, 1152, dst, 384, p.qg + l * 384 + 64 * kb, QSCALE, scr, c.lane);
                else { const int n = c.lane >> 1, h8 = (c.lane & 1) * 32; for (int q = 0; q < 4; ++q) *(u32x4*)(dst + (size_t)n * 384 + h8 + 8 * q) = (u32x4){0u, 0u, 0u, 0u}; }
                continue; } r -= I_UQ;
            if (r < I_UKV) { const int g = r / 4, kb = r % 4; xpose_item(p.w_ukv + ((size_t)l * 256 + 64 * kb) * 1536 + 32 * g, 1536, WukvT + ((size_t)l * 1536 + 32 * g) * 256 + 64 * kb, 256, p.kvg + l * 256 + 64 * kb, 1.f, scr, c.lane); continue; } r -= I_UKV;
            if (r < I_OUT) { const int g = r / 16, kb = r % 16; xpose_item(p.w_out + ((size_t)l * 1024 + 64 * kb) * 1024 + 32 * g, 1024, WoutT + ((size_t)l * 1024 + 32 * g) * 1024 + 64 * kb, 1024, nullptr, 1.f, scr, c.lane); continue; } r -= I_OUT;
            { const int g = r / 16, kb = r % 16; xpose_item(p.w_router + ((size_t)l * 1024 + 64 * kb) * 64 + 32 * g, 64, WrT + ((size_t)l * 256 + 32 * g) * 1024 + 64 * kb, 1024, nullptr, 1.f, scr, c.lane); }
        }
        for (int l = 0; l < NL; ++l) {
            zero_rows(WinT + ((size_t)l * 1024 + 960) * 1024, (size_t)64 * 1024, c.gw, c.ngw, c.lane);
            zero_rows(WrT + ((size_t)l * 256 + 64) * 1024, (size_t)192 * 1024, c.gw, c.ngw, c.lane);
        }
    }
}

__device__ __forceinline__ void write_mod_row(const f32x4 (&v)[4], const float* sh, const float* sc, bf16_t* hrow, int lane) {
#pragma unroll
    for (int j = 0; j < 4; ++j) { const f32x4 s1 = *(const f32x4*)(sc + 4 * lane + 256 * j), s0 = *(const f32x4*)(sh + 4 * lane + 256 * j);
        const f32x4 o = v[j] * (s1 + 1.f) + s0; u32x2 w; w.x = cvt_pk_bf16(o[0], o[1]); w.y = cvt_pk_bf16(o[2], o[3]);
        *(u32x2*)(hrow + 4 * lane + 256 * j) = w; }
}

__device__ __forceinline__ void ph_prep(const Params& p, const Ctx& c, int l) {
    unsigned char* ws = p.ws;
    LAS float* scr = (LAS float*)(c.lds + c.wid * 16384);
    bf16_t* Wgu = (bf16_t*)(ws + WS_WGU); bf16_t* Wd = (bf16_t*)(ws + WS_WD);
    constexpr int I_GU = 16 * 16, I_D = 32 * 4, I_E = I_GU + I_D;
    for (int it = c.gw; it < 65 * I_E; it += c.ngw) {
        const int e = it / I_E; int r = it % I_E;
        if (r < I_GU) { const int g = r / 16, kb = r % 16, r0 = 32 * g, cb = r0 >> 8, half = (r0 >> 7) & 1, c0 = cb * 128 + (r0 & 127);
            const float* src = (e < 64) ? ((half ? p.weu : p.weg) + ((size_t)(l * 64 + e) * 1024) * 256) : ((half ? p.wsu : p.wsg) + (size_t)l * 1024 * 256);
            xpose_item(src + (size_t)(64 * kb) * 256 + c0, 256, Wgu + ((size_t)e * 512 + r0) * 1024 + 64 * kb, 1024, nullptr, 1.f, scr, c.lane);
        } else { r -= I_GU; const int g = r / 4, kb = r % 4;
            const float* src = (e < 64) ? (p.wed + ((size_t)(l * 64 + e) * 256) * 1024) : (p.wsd + (size_t)l * 256 * 1024);
            xpose_item(src + (size_t)(64 * kb) * 1024 + 32 * g, 1024, Wd + ((size_t)e * 1024 + 32 * g) * 256 + 64 * kb, 256, nullptr, 1.f, scr, c.lane);
        }
    }
    if (l == 0) {
        const float* mod = (const float*)(ws + WS_MOD); bf16_t* H = (bf16_t*)(ws + WS_H);
        for (int t = c.gw; t < T; t += c.ngw) { const int b = t / S; f32x4 v[4];
#pragma unroll
            for (int j = 0; j < 4; ++j) v[j] = *(const f32x4*)(p.x + (size_t)t * 1024 + 4 * c.lane + 256 * j);
            write_mod_row(v, mod + (size_t)b * 6144 + 0, mod + (size_t)b * 6144 + 1024, H + (size_t)t * 1024, c.lane); }
    }
}

__device__ __forceinline__ void ph_post_in(const Params& p, const Ctx& c, int l) {
    unsigned char* ws = p.ws;
    const bf16_t* P = (const bf16_t*)(ws + WS_P); bf16_t* Kf = (bf16_t*)(ws + WS_KF); bf16_t* MIX = (bf16_t*)(ws + WS_MIX);
    float* rsq = (float*)(ws + WS_RSQ); float* rskv = (float*)(ws + WS_RSKV); const f32x2* cs = (const f32x2*)(ws + WS_CS);
    LAS float* wp = (LAS float*)c.lds;
    for (int i = c.tid; i < 4 * 64 * 64; i += NTHREADS) wp[i] = p.w_pool[(size_t)l * 16384 + i];
    __syncthreads();
    const int lane = c.lane;
    for (int t = c.gw; t < T; t += c.ngw) {
        const bf16_t* row = P + (size_t)t * 1024;
        { const unsigned* q32 = (const unsigned*)(row + 256) + lane * 3; float s = 0.f;
#pragma unroll
            for (int j = 0; j < 3; ++j) { const unsigned w = q32[j]; const float a = bflo(w), b = bfhi(w); s += a * a + b * b; }
            s = wave_sum(s); if (lane == 0) rsq[t] = 1.0f / sqrtf(s * (1.f / 384.f) + RMS_EPS); }
        { const u32x2 w = *((const u32x2*)(row + 640) + lane); const float a = bflo(w.x), b = bfhi(w.x), c2 = bflo(w.y), d2 = bfhi(w.y);
            float s = a * a + b * b + c2 * c2 + d2 * d2; s = wave_sum(s); if (lane == 0) rskv[t] = 1.0f / sqrtf(s * (1.f / 256.f) + RMS_EPS); }
        if (lane < 32) { const float x1 = bf2f(row[896 + lane]), x2 = bf2f(row[928 + lane]); const f32x2 cc = cs[(size_t)t * 32 + lane];
            const unsigned o = cvt_pk_bf16(x1 * cc.x - x2 * cc.y, x2 * cc.x + x1 * cc.y);
#pragma unroll
            for (int h = 0; h < NH; ++h) { bf16_t* kp = Kf + (size_t)t * 1152 + h * 192 + 128; kp[lane] = (bf16_t)(o & 0xffffu); kp[32 + lane] = (bf16_t)(o >> 16); } }
        const int s = t % S;
        float tm[4];
#pragma unroll
        for (int g = 0; g < 4; ++g) { const int w = 2 << g, cnt = (s + 1 < w) ? s + 1 : w; float sum = 0.f;
            for (int j = 0; j < cnt; ++j) sum += bf2f(P[(size_t)(t - j) * 1024 + 64 * g + lane]);
            tm[g] = sum / (float)cnt - bf2f(row[64 * g + lane]); }
#pragma unroll
        for (int g = 0; g < 4; ++g) { float o = 0.f;
            for (int cc = 0; cc < 64; ++cc) o += __int_as_float(__builtin_amdgcn_readlane(__float_as_int(tm[g]), cc)) * wp[(g * 64 + cc) * 64 + lane];
            o *= p.pool_scale[l * 256 + 64 * g + lane];
            MIX[(size_t)t * 1024 + 64 * g + lane] = (bf16_t)(cvt_pk_bf16(o, 0.f) & 0xffffu); }
    }
}

__device__ __forceinline__ void ph_attn_naive(const Params& p, const Ctx& c) {
    unsigned char* ws = p.ws;
    const bf16_t* Q = (const bf16_t*)(ws + WS_Q); const bf16_t* Kf = (const bf16_t*)(ws + WS_KF); const bf16_t* V = (const bf16_t*)(ws + WS_V); bf16_t* MIX = (bf16_t*)(ws + WS_MIX);
    LAS float* qs = (LAS float*)(c.lds + c.wid * 8192);
    const int lane = c.lane;
    for (int item = c.bid; item < 96 * 32; item += c.G) {
        const int bh = item % 96, qb = 31 - item / 96, b = bh / NH, h = bh % NH;
        const int q0 = qb * 64 + c.wid * 8;
        for (int i = lane; i < 8 * 192; i += 64) { const int r = i / 192, d = i % 192; qs[i] = bf2f(Q[(size_t)(b * S + q0 + r) * 1152 + h * 192 + d]); }
        asm volatile("s_waitcnt lgkmcnt(0)" ::: "memory");
        float m[8], lsum[8], o0[8], o1[8];
#pragma unroll
        for (int r = 0; r < 8; ++r) { m[r] = -1e30f; lsum[r] = 0.f; o0[r] = 0.f; o1[r] = 0.f; }
        const int last = q0 + 7, nch = last / 64 + 1;
        for (int ch = 0; ch < nch; ++ch) {
            const int key = ch * 64 + lane; float sc[8];
#pragma unroll
            for (int r = 0; r < 8; ++r) sc[r] = 0.f;
            if (key <= last) {
                const bf16_t* kp = Kf + (size_t)(b * S + key) * 1152 + h * 192;
                for (int cc = 0; cc < 24; ++cc) { const u32x4 kw = *(const u32x4*)(kp + 8 * cc); float kf[8];
#pragma unroll
                    for (int j = 0; j < 4; ++j) { kf[2 * j] = bflo(kw[j]); kf[2 * j + 1] = bfhi(kw[j]); }
#pragma unroll
                    for (int r = 0; r < 8; ++r) { const f32x4 qa = *(const LAS f32x4*)&qs[r * 192 + 8 * cc], qb2 = *(const LAS f32x4*)&qs[r * 192 + 8 * cc + 4];
                        sc[r] += qa[0] * kf[0] + qa[1] * kf[1] + qa[2] * kf[2] + qa[3] * kf[3] + qb2[0] * kf[4] + qb2[1] * kf[5] + qb2[2] * kf[6] + qb2[3] * kf[7]; } }
            }
            float pr[8];
#pragma unroll
            for (int r = 0; r < 8; ++r) { const float sv = (key <= q0 + r) ? sc[r] : -__builtin_inff(); const float mx = wave_max(sv), mn = fmaxf(m[r], mx);
                const float al = __builtin_amdgcn_exp2f(m[r] - mn); const float pv = __builtin_amdgcn_exp2f(sv - mn);
                lsum[r] = lsum[r] * al + wave_sum(pv); o0[r] *= al; o1[r] *= al; m[r] = mn; pr[r] = pv; }
            const int kmax = (last - ch * 64 < 63) ? last - ch * 64 : 63;
            const bf16_t* vp = V + (size_t)(b * S + ch * 64) * 768 + h * 128 + 2 * lane;
            for (int kk = 0; kk <= kmax; ++kk) { const unsigned vw = *(const unsigned*)(vp + (size_t)kk * 768); const float v0 = bflo(vw), v1 = bfhi(vw);
#pragma unroll
                for (int r = 0; r < 8; ++r) { const float pk = __int_as_float(__builtin_amdgcn_readlane(__float_as_int(pr[r]), kk)); o0[r] += pk * v0; o1[r] += pk * v1; } }
        }
#pragma unroll
        for (int r = 0; r < 8; ++r) { const float il = 1.f / lsum[r];
            *(unsigned*)(MIX + (size_t)(b * S + q0 + r) * 1024 + 256 + h * 128 + 2 * lane) = cvt_pk_bf16(o0[r] * il, o1[r] * il); }
    }
}

__device__ __forceinline__ void ln_row(f32x4 (&v)[4], const float* g, const float* bta, int lane) {
    float s = 0.f;
#pragma unroll
    for (int j = 0; j < 4; ++j) s += (v[j][0] + v[j][1]) + (v[j][2] + v[j][3]);
    const float mean = wave_sum(s) * (1.f / D); float s2 = 0.f;
#pragma unroll
    for (int j = 0; j < 4; ++j) { v[j] = v[j] - mean; s2 += (v[j][0] * v[j][0] + v[j][1] * v[j][1]) + (v[j][2] * v[j][2] + v[j][3] * v[j][3]); }
    const float rstd = 1.0f / sqrtf(wave_sum(s2) * (1.f / D) + LN_EPS);
#pragma unroll
    for (int j = 0; j < 4; ++j) { const f32x4 gg = *(const f32x4*)(g + 4 * lane + 256 * j), bb = *(const f32x4*)(bta + 4 * lane + 256 * j); v[j] = v[j] * rstd * gg + bb; }
}

__device__ __forceinline__ void ph_ln1(const Params& p, const Ctx& c, int l) {
    const float* mod = (const float*)(p.ws + WS_MOD) + (size_t)l * 16 * 6144; bf16_t* H = (bf16_t*)(p.ws + WS_H);
    for (int t = c.gw; t < T; t += c.ngw) { const int b = t / S; f32x4 v[4]; float* xr = p.out + (size_t)t * 1024;
#pragma unroll
        for (int j = 0; j < 4; ++j) v[j] = *(const f32x4*)(xr + 4 * c.lane + 256 * j);
        ln_row(v, p.ln1g + l * 1024, p.ln1b + l * 1024, c.lane);
#pragma unroll
        for (int j = 0; j < 4; ++j) *(f32x4*)(xr + 4 * c.lane + 256 * j) = v[j];
        write_mod_row(v, mod + (size_t)b * 6144 + 3 * 1024, mod + (size_t)b * 6144 + 4 * 1024, H + (size_t)t * 1024, c.lane); }
}

__device__ __forceinline__ void ph_route(const Params& p, const Ctx& c, int l) {
    unsigned char* ws = p.ws;
    const float* logits = (const float*)(ws + WS_LOG); float* tg = (float*)(ws + WS_TG); int* lists = (int*)(ws + WS_LIST);
    unsigned* cnt = (unsigned*)(ws + WS_CTL) + CW_CNT + l * 64;
    LAS float* sc = (LAS float*)c.lds;
    LAS unsigned* lcnt = (LAS unsigned*)(c.lds + LDS_MISC + 1024); LAS unsigned* gbase = lcnt + 64;
    const int tid = c.tid;
    for (int t0 = c.bid * NTHREADS; t0 < T; t0 += c.G * NTHREADS) {
        const int t = t0 + tid;
        if (tid < 64) lcnt[tid] = 0u;
        const float* lr = logits + (size_t)t * 64;
#pragma unroll
        for (int q = 0; q < 16; ++q) { const f32x4 v = *(const f32x4*)(lr + 4 * q);
#pragma unroll
            for (int j = 0; j < 4; ++j) { const int e = 4 * q + j; sc[e * NTHREADS + tid] = 1.f / (1.f + __expf(-v[j])) + p.rbias[l * 64 + e]; } }
        float gs[8];
#pragma unroll
        for (int g = 0; g < 8; ++g) { float a = -__builtin_inff(), b2 = -__builtin_inff();
#pragma unroll
            for (int j = 0; j < 8; ++j) { const float v = sc[(8 * g + j) * NTHREADS + tid]; if (v > a) { b2 = a; a = v; } else if (v > b2) b2 = v; }
            gs[g] = a + b2; }
        unsigned gmask = 0u;
#pragma unroll
        for (int r = 0; r < 4; ++r) { float best = -__builtin_inff(); int bi = 0;
#pragma unroll
            for (int g = 0; g < 8; ++g) { const bool ok = !((gmask >> g) & 1u) && gs[g] > best; best = ok ? gs[g] : best; bi = ok ? g : bi; }
            gmask |= 1u << bi; }
        unsigned long long taken = 0ull; int ek[8]; float wk[8]; float wsum = 0.f;
#pragma unroll
        for (int k = 0; k < 8; ++k) { float best = -__builtin_inff(); int bi = 0;
            for (int e = 0; e < 64; ++e) { const bool ok = ((gmask >> (e >> 3)) & 1u) && !((taken >> e) & 1ull); const float v = sc[e * NTHREADS + tid]; if (ok && v > best) { best = v; bi = e; } }
            taken |= 1ull << bi; ek[k] = bi; const float w = 1.f / (1.f + __expf(-lr[bi])); wk[k] = w; wsum += w; }
        __syncthreads();
        unsigned rk[8];
#pragma unroll
        for (int k = 0; k < 8; ++k) rk[k] = atomicAdd((unsigned*)&lcnt[ek[k]], 1u);
        __syncthreads();
        if (tid < 64) gbase[tid] = atomicAdd(&cnt[tid], lcnt[tid]);
        __syncthreads();
        const float inv = 2.5f / wsum;
#pragma unroll
        for (int k = 0; k < 8; ++k) { tg[(size_t)t * 8 + k] = wk[k] * inv; lists[(size_t)ek[k] * T + gbase[ek[k]] + rk[k]] = t * 8 + k; }
        __syncthreads();
    }
}

__device__ __forceinline__ void ph_combine(const Params& p, const Ctx& c, int l) {
    unsigned char* ws = p.ws;
    const float* mod = (const float*)(ws + WS_MOD) + (size_t)l * 16 * 6144; const float* modn = mod + 16 * 6144; bf16_t* H = (bf16_t*)(ws + WS_H);
    const bf16_t* Y = (const bf16_t*)(ws + WS_Y); const float* tg = (const float*)(ws + WS_TG);
    for (int t = c.gw; t < T; t += c.ngw) { const int b = t / S; f32x4 f[4]; float* xr = p.out + (size_t)t * 1024;
        { const bf16_t* yr = Y + (size_t)(8 * T + t) * 1024;
#pragma unroll
            for (int j = 0; j < 4; ++j) { const u32x2 w = *(const u32x2*)(yr + 4 * c.lane + 256 * j); f[j] = (f32x4){bflo(w.x), bfhi(w.x), bflo(w.y), bfhi(w.y)}; } }
        f32x4 r4[4];
#pragma unroll
        for (int j = 0; j < 4; ++j) r4[j] = (f32x4){0.f, 0.f, 0.f, 0.f};
#pragma unroll
        for (int k = 0; k < 8; ++k) { const float gk = tg[(size_t)t * 8 + k]; const bf16_t* yr = Y + (size_t)(t * 8 + k) * 1024;
#pragma unroll
            for (int j = 0; j < 4; ++j) { const u32x2 w = *(const u32x2*)(yr + 4 * c.lane + 256 * j); r4[j] += (f32x4){bflo(w.x), bfhi(w.x), bflo(w.y), bfhi(w.y)} * gk; } }
        f32x4 v[4];
#pragma unroll
        for (int j = 0; j < 4; ++j) { const f32x4 g2 = *(const f32x4*)(mod + (size_t)b * 6144 + 5 * 1024 + 4 * c.lane + 256 * j); v[j] = *(const f32x4*)(xr + 4 * c.lane + 256 * j) * ALPHA + g2 * (f[j] + r4[j]); }
        ln_row(v, p.ln2g + l * 1024, p.ln2b + l * 1024, c.lane);
#pragma unroll
        for (int j = 0; j < 4; ++j) *(f32x4*)(xr + 4 * c.lane + 256 * j) = v[j];
        if (l + 1 < NL) write_mod_row(v, modn + (size_t)b * 6144 + 0, modn + (size_t)b * 6144 + 1024, H + (size_t)t * 1024, c.lane); }
}

#define GEMM_BODY gemm_naive

__global__ void __launch_bounds__(NTHREADS, 2) mk_fwd(Params p, int seg_lo, int seg_hi) {
    extern __shared__ __attribute__((aligned(16))) unsigned char lds_raw[];
    Ctx c0; c0.lds = (LAS unsigned char*)lds_raw; c0.tid = threadIdx.x; c0.lane = c0.tid & 63; c0.wid = __builtin_amdgcn_readfirstlane(c0.tid >> 6);
    c0.G = gridDim.x; c0.bid = blockIdx.x; c0.gw = c0.bid * NWAVES + c0.wid; c0.ngw = c0.G * NWAVES;
    volatile LAS unsigned* misc = (volatile LAS unsigned*)(c0.lds + LDS_MISC);
    if (c0.tid < 64) misc[c0.tid] = 0u;
    __syncthreads();
    XcdBarrier bar = xcd_barrier_post((unsigned*)(p.ws + WS_CTL) + CW_BAR, misc);
    LAS int* tp = (LAS int*)(c0.lds + LDS_MISC + 256);
#define IN(k) (seg_lo <= (k) && (k) < seg_hi)
#define SEAM(k) do { if (IN((k) + 1)) xcd_barrier(bar); } while (0)

    if (IN(0)) { PHASE_Q ph_prologue(q, c); SEAM(0); }
    for (int l = 0; l < NL; ++l) {
        const int sb = 1 + l * PH_PER_LAYER;
        if (IN(sb + 0)) { PHASE_Q ph_prep(q, c, l); SEAM(sb + 0); }
        if (IN(sb + 1)) {
            PHASE_Q
            GemmDesc g{(const bf16_t*)(ws + WS_H), 1024, 1024, 1024};
            DenseSched sc{(const bf16_t*)(ws + WS_WIN) + (size_t)l * 1024 * 1024, 1024, T / 256, 4, c.G, c.bid};
            EpiP e{(bf16_t*)(ws + WS_P)};
            GEMM_BODY<EpiP::PERM>(c.lds, c.tid, g, sc, e); SEAM(sb + 1); }
        if (IN(sb + 2)) { PHASE_Q ph_post_in(q, c, l); SEAM(sb + 2); }
        if (IN(sb + 3)) {
            PHASE_Q
            { GemmDesc g{(const bf16_t*)(ws + WS_P) + 256, 1024, 384, 384};
              DenseSched sc{(const bf16_t*)(ws + WS_WUQ) + (size_t)l * 1280 * 384, 384, T / 256, 5, c.G, c.bid};
              EpiQ e{(bf16_t*)(ws + WS_Q), (const float*)(ws + WS_RSQ), (const f32x2*)(ws + WS_CS)};
              GEMM_BODY<EpiQ::PERM>(c.lds, c.tid, g, sc, e); }
            { GemmDesc g{(const bf16_t*)(ws + WS_P) + 640, 1024, 256, 256};
              DenseSched sc{(const bf16_t*)(ws + WS_WUKV) + (size_t)l * 1536 * 256, 256, T / 256, 6, c.G, c.G - 1 - c.bid};
              EpiKV e{(bf16_t*)(ws + WS_KF), (bf16_t*)(ws + WS_V), (const float*)(ws + WS_RSKV)};
              GEMM_BODY<EpiKV::PERM>(c.lds, c.tid, g, sc, e); }
            SEAM(sb + 3); }
        if (IN(sb + 4)) { PHASE_Q ph_attn_naive(q, c); SEAM(sb + 4); }
        if (IN(sb + 5)) {
            PHASE_Q const float* mod = (const float*)(ws + WS_MOD) + (size_t)l * 16 * 6144;
            GemmDesc g{(const bf16_t*)(ws + WS_MIX), 1024, 1024, 1024};
            DenseSched sc{(const bf16_t*)(ws + WS_WOUT) + (size_t)l * 1024 * 1024, 1024, T / 256, 4, c.G, c.bid};
            EpiOut e{l == 0 ? q.x : q.out, q.out, mod + 2 * 1024};
            GEMM_BODY<EpiOut::PERM>(c.lds, c.tid, g, sc, e); SEAM(sb + 5); }
        if (IN(sb + 6)) { PHASE_Q ph_ln1(q, c, l); SEAM(sb + 6); }
        if (IN(sb + 7)) {
            PHASE_Q
            GemmDesc g{(const bf16_t*)(ws + WS_H), 1024, 1024, 1024};
            DenseSched sc{(const bf16_t*)(ws + WS_WR) + (size_t)l * 256 * 1024, 1024, T / 256, 1, c.G, c.bid};
            EpiRouter e{(float*)(ws + WS_LOG)};
            GEMM_BODY<EpiRouter::PERM>(c.lds, c.tid, g, sc, e); SEAM(sb + 7); }
        if (IN(sb + 8)) { PHASE_Q ph_route(q, c, l); SEAM(sb + 8); }
        if (IN(sb + 9)) {
            PHASE_Q
            moe_build_tiles(tp, (const int*)((unsigned*)(ws + WS_CTL) + CW_CNT + l * 64));
            GemmDesc g{(const bf16_t*)(ws + WS_H), 1024, 1024, 1024};
            MoeSched sc{(const bf16_t*)(ws + WS_WGU), (size_t)512 * 1024, 1024, (const int*)(ws + WS_LIST), (const int*)((unsigned*)(ws + WS_CTL) + CW_CNT + l * 64), tp, 2, c.G, c.bid, true};
            EpiSwiglu e{(bf16_t*)(ws + WS_ACT)};
            GEMM_BODY<EpiSwiglu::PERM>(c.lds, c.tid, g, sc, e); SEAM(sb + 9); }
        if (IN(sb + 10)) {
            PHASE_Q
            moe_build_tiles(tp, (const int*)((unsigned*)(ws + WS_CTL) + CW_CNT + l * 64));
            GemmDesc g{(const bf16_t*)(ws + WS_ACT), 256, 256, 256};
            MoeSched sc{(const bf16_t*)(ws + WS_WD), (size_t)1024 * 256, 256, (const int*)(ws + WS_LIST), (const int*)((unsigned*)(ws + WS_CTL) + CW_CNT + l * 64), tp, 4, c.G, c.bid, false};
            EpiDown e{(bf16_t*)(ws + WS_Y)};
            GEMM_BODY<EpiDown::PERM>(c.lds, c.tid, g, sc, e); SEAM(sb + 10); }
        if (IN(sb + 11)) { PHASE_Q ph_combine(q, c, l); SEAM(sb + 11); }
    }
#undef IN
#undef SEAM
}

#ifndef MK_ONE_LAUNCH
#define MK_ONE_LAUNCH 1
#endif
extern "C" void kernel_launch(void* const* d_in, const int* in_sizes, int n_in, void* d_out, int out_size, void* d_ws, size_t ws_size, hipStream_t stream) {
    static int grid = 0;
    if (grid == 0) {
        if (n_in != 25 || out_size != T * D || ws_size < WS_END) { fprintf(stderr, "kernel_launch: unexpected shapes (n_in %d out %d ws %zu need %zu)\n", n_in, out_size, ws_size, (size_t)WS_END); grid = -1; return; }
        int dev = 0, cus = 0, per_cu = 0;
        if (hipGetDevice(&dev) != hipSuccess || hipDeviceGetAttribute(&cus, hipDeviceAttributeMultiprocessorCount, dev) != hipSuccess) { grid = -1; return; }
        if (hipFuncSetAttribute((const void*)mk_fwd, hipFuncAttributeMaxDynamicSharedMemorySize, LDS_BYTES) != hipSuccess) { fprintf(stderr, "kernel_launch: hipFuncSetAttribute failed\n"); grid = -1; return; }
        if (hipOccupancyMaxActiveBlocksPerMultiprocessor(&per_cu, (const void*)mk_fwd, NTHREADS, LDS_BYTES) != hipSuccess || per_cu < 1) { fprintf(stderr, "kernel_launch: occupancy query says %d\n", per_cu); }
        (void)hipGetLastError();
        grid = cus;
    }
    if (grid < 0) return;
    (void)hipMemsetAsync((char*)d_ws + WS_CTL, 0, CTL_BYTES, stream);
    Params p{};
    p.x = (const float*)d_in[0]; p.c = (const float*)d_in[1]; p.pos = (const int*)d_in[2];
    p.w_ada = (const float*)d_in[3]; p.b_ada = (const float*)d_in[4]; p.w_in = (const float*)d_in[5]; p.qg = (const float*)d_in[6]; p.kvg = (const float*)d_in[7];
    p.w_uq = (const float*)d_in[8]; p.w_ukv = (const float*)d_in[9]; p.w_pool = (const float*)d_in[10]; p.pool_scale = (const float*)d_in[11]; p.w_out = (const float*)d_in[12];
    p.ln1g = (const float*)d_in[13]; p.ln1b = (const float*)d_in[14]; p.w_router = (const float*)d_in[15]; p.rbias = (const float*)d_in[16];
    p.weg = (const float*)d_in[17]; p.weu = (const float*)d_in[18]; p.wed = (const float*)d_in[19]; p.wsg = (const float*)d_in[20]; p.wsu = (const float*)d_in[21]; p.wsd = (const float*)d_in[22];
    p.ln2g = (const float*)d_in[23]; p.ln2b = (const float*)d_in[24];
    p.out = (float*)d_out; p.ws = (unsigned char*)d_ws;
#if MK_ONE_LAUNCH
    hipLaunchKernelGGL(mk_fwd, dim3(grid), dim3(NTHREADS), LDS_BYTES, stream, p, 0, NSEG);
#else
    for (int s = 0; s < NSEG; ++s) hipLaunchKernelGGL(mk_fwd, dim3(grid), dim3(NTHREADS), LDS_BYTES, stream, p, s, s + 1);
#endif
}
```

```cpp
#include <hip/hip_runtime.h>
#include <stdint.h>
#include <cstdio>

#define LAS __attribute__((address_space(3)))
#define GAS __attribute__((address_space(1)))
typedef unsigned short bf16_t;
typedef short bf16x8 __attribute__((ext_vector_type(8)));
typedef float f32x4 __attribute__((ext_vector_type(4)));
typedef float f32x2 __attribute__((ext_vector_type(2)));
typedef unsigned u32x4 __attribute__((ext_vector_type(4)));
typedef unsigned u32x2 __attribute__((ext_vector_type(2)));

constexpr int D = 1024, NB = 16, S = 2048, T = NB * S, NL = 4;
constexpr int NE = 64, TOPK = 8, FE = 256, NH = 6;
constexpr int INW = 960;
constexpr int A_TOT = T * 9;
constexpr float ALPHA = 1.6817928305074290f;
constexpr float LN_EPS = 1e-5f, RMS_EPS = 1e-6f;
constexpr float QSCALE = 0.07216878364870322f * 1.4426950408889634f;
constexpr int NTHREADS = 512, NWAVES = 8;
constexpr int LDS_BYTES = 163840, LDS_MISC = 131072;
constexpr int PH_PER_LAYER = 12, NSEG = 1 + NL * PH_PER_LAYER;

constexpr size_t al256(size_t x) { return (x + 255) & ~(size_t)255; }
constexpr size_t WS_CTL = 0, CTL_BYTES = 1u << 20;
constexpr size_t CW_BAR = 4096;
constexpr size_t CW_CNT = 16384;
constexpr size_t WS_MOD = WS_CTL + CTL_BYTES;
constexpr size_t WS_CS = al256(WS_MOD + (size_t)NL * 16 * 6144 * 4);
constexpr size_t WS_RSQ = al256(WS_CS + (size_t)T * 32 * 8);
constexpr size_t WS_RSKV = al256(WS_RSQ + (size_t)T * 4);
constexpr size_t WS_WIN = al256(WS_RSKV + (size_t)T * 4);
constexpr size_t WS_WUQ = al256(WS_WIN + (size_t)NL * 1024 * 1024 * 2);
constexpr size_t WS_WUKV = al256(WS_WUQ + (size_t)NL * 1280 * 384 * 2);
constexpr size_t WS_WOUT = al256(WS_WUKV + (size_t)NL * 1536 * 256 * 2);
constexpr size_t WS_WR = al256(WS_WOUT + (size_t)NL * 1024 * 1024 * 2);
constexpr size_t WS_WGU = al256(WS_WR + (size_t)NL * 256 * 1024 * 2);
constexpr size_t WS_WD = al256(WS_WGU + (size_t)65 * 512 * 1024 * 2);
constexpr size_t WS_H = al256(WS_WD + (size_t)65 * 1024 * 256 * 2);
constexpr size_t WS_R = al256(WS_H + (size_t)T * 1024 * 2);
constexpr size_t WS_P = WS_R;
constexpr size_t WS_Q = al256(WS_P + (size_t)T * 1024 * 2);
constexpr size_t WS_KF = al256(WS_Q + (size_t)T * 1152 * 2);
constexpr size_t WS_V = al256(WS_KF + (size_t)T * 1152 * 2);
constexpr size_t WS_MIX = al256(WS_V + (size_t)T * 768 * 2);
constexpr size_t WS_MIX_END = al256(WS_MIX + (size_t)T * 1024 * 2);
constexpr size_t WS_ACT = WS_R;
constexpr size_t WS_LOG = al256(WS_ACT + (size_t)(A_TOT + 1) * 256 * 2);
constexpr size_t WS_TG = al256(WS_LOG + (size_t)T * 64 * 4);
constexpr size_t WS_LIST = al256(WS_TG + (size_t)T * 8 * 4);
constexpr size_t WS_Y = al256(WS_LIST + (size_t)65 * T * 4);
constexpr size_t WS_END = al256(WS_Y + (size_t)(A_TOT + 1) * 1024 * 2);
static_assert(WS_MIX_END <= WS_END && WS_END < 1000000000ull, "workspace map");

struct Params {
    const float *x, *c; const int* pos;
    const float *w_ada, *b_ada, *w_in, *qg, *kvg, *w_uq, *w_ukv, *w_pool, *pool_scale, *w_out, *ln1g, *ln1b, *w_router, *rbias;
    const float *weg, *weu, *wed, *wsg, *wsu, *wsd, *ln2g, *ln2b;
    float* out; unsigned char* ws;
};

__device__ __forceinline__ unsigned cvt_pk_bf16(float lo, float hi) { unsigned r; asm volatile("v_cvt_pk_bf16_f32 %0, %1, %2" : "=v"(r) : "v"(lo), "v"(hi)); return r; }
__device__ __forceinline__ float bf2f(bf16_t b) { return __uint_as_float(((unsigned)b) << 16); }
__device__ __forceinline__ float bflo(unsigned w) { return __uint_as_float(w << 16); }
__device__ __forceinline__ float bfhi(unsigned w) { return __uint_as_float(w & 0xffff0000u); }
#define SWZ_XOR(v, x) __int_as_float(__builtin_amdgcn_ds_swizzle(__float_as_int(v), ((x) << 10) | 0x1F))
__device__ __forceinline__ float wave_sum(float v) {
    v += SWZ_XOR(v, 1); v += SWZ_XOR(v, 2); v += SWZ_XOR(v, 4); v += SWZ_XOR(v, 8); v += SWZ_XOR(v, 16);
    const auto rr = __builtin_amdgcn_permlane32_swap(__float_as_uint(v), __float_as_uint(v), false, false);
    return __uint_as_float(rr[0]) + __uint_as_float(rr[1]);
}
__device__ __forceinline__ float wave_max(float v) {
    v = fmaxf(v, SWZ_XOR(v, 1)); v = fmaxf(v, SWZ_XOR(v, 2)); v = fmaxf(v, SWZ_XOR(v, 4)); v = fmaxf(v, SWZ_XOR(v, 8)); v = fmaxf(v, SWZ_XOR(v, 16));
    const auto rr = __builtin_amdgcn_permlane32_swap(__float_as_uint(v), __float_as_uint(v), false, false);
    return fmaxf(__uint_as_float(rr[0]), __uint_as_float(rr[1]));
}
__device__ __forceinline__ void store8_bf16(bf16_t* p, f32x4 a, f32x4 b) {
    u32x4 w; w.x = cvt_pk_bf16(a[0], a[1]); w.y = cvt_pk_bf16(a[2], a[3]); w.z = cvt_pk_bf16(b[0], b[1]); w.w = cvt_pk_bf16(b[2], b[3]);
    *(u32x4*)p = w;
}

__device__ __forceinline__ int fresh_lane() { int l; asm volatile("v_mbcnt_lo_u32_b32 %0, -1, 0\n\tv_mbcnt_hi_u32_b32 %0, -1, %0" : "=v"(l)); return l; }
template <class Tp> __device__ __forceinline__ Tp* launder(Tp* p) { asm volatile("" : "+s"(p)); return p; }
typedef __attribute__((address_space(4))) const Params CParams;
#if defined(__HIP_DEVICE_COMPILE__)
#define LOAD_Q CParams* kp_ = (CParams*)__builtin_amdgcn_kernarg_segment_ptr(); asm volatile("" : "+s"(kp_)); const Params q = *kp_;
#else
#define LOAD_Q const Params q = p;
#endif
#define PHASE_Q LOAD_Q unsigned char* ws = q.ws; (void)ws; \
    Ctx c = c0; asm volatile("" : "+s"(c.gw), "+s"(c.wid), "+s"(c.bid), "+s"(c.G), "+s"(c.ngw)); \
    c.lane = fresh_lane(); c.tid = c.wid * 64 + c.lane;

#define XB_TMO      128
#define XB_XCNT(j)  (256  + 64 * (j))
#define XB_XSUB(j)  (1280 + 64 * (j))
#define XB_XGEN(j)  (2304 + 64 * (j))
#define XB_TOP      3328
#define XB_TOPGEN   3392
#define XCD_BAR_WORDS 3456
#define XB_SPIN_CAP (1u << 20)
__device__ __forceinline__ unsigned xb_ld(unsigned* p)              { return __hip_atomic_load(p, __ATOMIC_RELAXED, __HIP_MEMORY_SCOPE_AGENT); }
__device__ __forceinline__ unsigned xb_add(unsigned* p, unsigned v) { return __hip_atomic_fetch_add(p, v, __ATOMIC_RELAXED, __HIP_MEMORY_SCOPE_AGENT); }
__device__ __forceinline__ unsigned xb_xcc_id() { return (unsigned)__builtin_amdgcn_s_getreg((3 << 11) | 20) & 0xFu; }
#define XB_SPIN(cond, bar) do { unsigned _sp = 0; while (cond) { __builtin_amdgcn_s_sleep(1); \
    if ((++_sp & 255u) == 0u) { if (xb_ld(&(bar)[XB_TMO])) break; if (_sp > XB_SPIN_CAP) { atomicAdd(&(bar)[XB_TMO], 1u); break; } } } } while (0)
struct XcdBarrier { unsigned* bar; unsigned x; volatile LAS unsigned* st; };
__device__ __forceinline__ XcdBarrier xcd_barrier_post(unsigned* bar, volatile LAS unsigned* st) {
    XcdBarrier b; b.bar = bar; b.x = xb_xcc_id(); b.st = st;
    if (threadIdx.x == 0) (void)xb_add(&bar[XB_XCNT(b.x)], 1u);
    return b;
}
__device__ __forceinline__ void xcd_barrier_complete(unsigned* bar, unsigned x, unsigned& nloc, unsigned& nx) {
    const unsigned G = gridDim.x * gridDim.y * gridDim.z;
    unsigned sum, cnt, mine, sp = 0u;
    for (;;) {
        sum = 0u; cnt = 0u; mine = 0u;
#pragma unroll
        for (unsigned j = 0; j < 16; ++j) { const unsigned c = xb_ld(&bar[XB_XCNT(j)]); sum += c; cnt += (c > 0u) ? 1u : 0u; mine = (j == x) ? c : mine; }
        if (sum == G) break;
        __builtin_amdgcn_s_sleep(1);
        if ((++sp & 255u) == 0u) { if (xb_ld(&bar[XB_TMO])) break; if (sp > XB_SPIN_CAP) { atomicAdd(&bar[XB_TMO], 1u); break; } }
    }
    nloc = mine > 0u ? mine : 1u; nx = cnt > 0u ? cnt : 1u;
}
__device__ __forceinline__ void xcd_barrier(const XcdBarrier& b) {
    asm volatile("s_waitcnt vmcnt(0)" ::: "memory");
    __syncthreads();
    if (threadIdx.x == 0) {
        unsigned* bar = b.bar;
        __builtin_amdgcn_s_waitcnt(0);
        unsigned nloc = b.st[0], nx = b.st[1];
        if (nloc == 0u) { xcd_barrier_complete(bar, b.x, nloc, nx); b.st[0] = nloc; b.st[1] = nx; }
        const unsigned old = xb_add(&bar[XB_XSUB(b.x)], 1u);
        const unsigned gen = old / nloc;
        if (old + 1u == (gen + 1u) * nloc) {
            __builtin_amdgcn_fence(__ATOMIC_RELEASE, "agent");
            asm volatile("s_waitcnt vmcnt(0)" ::: "memory");
            const unsigned og = xb_add(&bar[XB_TOP], 1u);
            const unsigned tg = og / nx;
            if (og + 1u == (tg + 1u) * nx) xb_add(&bar[XB_TOPGEN], 1u);
            else XB_SPIN(xb_ld(&bar[XB_TOPGEN]) == tg, bar);
            __builtin_amdgcn_fence(__ATOMIC_ACQUIRE, "agent");
            xb_add(&bar[XB_XGEN(b.x)], 1u);
            asm volatile("s_waitcnt vmcnt(0)" ::: "memory");
        } else {
            XB_SPIN(xb_ld(&bar[XB_XGEN(b.x)]) == gen, bar);
            __builtin_amdgcn_fence(__ATOMIC_ACQUIRE, "agent");
            asm volatile("s_waitcnt vmcnt(0)" ::: "memory");
        }
    }
    __syncthreads();
}

struct Unit { const GAS bf16_t* Bt; int pm, pn, e, base, cnt; };
struct GemmDesc { const GAS bf16_t* A; int lda, ldb, K; };
__device__ __forceinline__ int uni(int v) { return __builtin_amdgcn_readfirstlane(v); }

struct DenseSched {
    static constexpr bool GATHER = false;
    const GAS bf16_t* Bt; int ldb, nM, nN, G, c;
    __device__ __forceinline__ bool next(int i, Unit& u) const {
        const int Lx = uni(i * G + c); if (Lx >= nM * nN) return false;
        const int nig = 8 * nN, gid = Lx / nig, fm = gid * 8, gsz = (nM - fm) < 8 ? (nM - fm) : 8, w = Lx % nig;
        u.pm = fm + (w % gsz); u.pn = w / gsz; u.e = 0; u.base = u.pm * 256; u.cnt = 256;
        u.Bt = Bt + (size_t)u.pn * 256 * ldb; return true;
    }
    __device__ __forceinline__ int arow(const Unit& u, int r) const { return u.base + r; }
    __device__ __forceinline__ int orow(const Unit& u, int r) const { return u.base + r; }
};
struct MoeSched {
    static constexpr bool GATHER = true;
    const GAS bf16_t* W; size_t w_estride; int ldb; const GAS int* lists; const GAS int* cnt; const LAS int* tp; int nsub, G, c; bool up;
    __device__ __forceinline__ bool next(int i, Unit& u) const {
        const int Lx = uni(i * G + c), ntile = uni(tp[65]); if (Lx >= ntile * nsub) return false;
        int e = 0;
#pragma unroll 1
        for (int s = 32; s >= 1; s >>= 1) if (e + s <= 64 && uni(tp[e + s]) * nsub <= Lx) e += s;
        if (e < 64 && uni(tp[e + 1]) * nsub <= Lx) e += 1;
        const int tpe = uni(tp[e]), nt_e = uni(tp[e + 1]) - tpe, w = Lx - tpe * nsub, sub = w / nt_e, ti = w % nt_e;
        u.e = e; u.pn = sub; u.pm = ti; u.base = ti * 256; u.cnt = (e < 64) ? uni(cnt[e]) : T;
        u.Bt = W + (size_t)e * w_estride + (size_t)sub * 256 * ldb; return true;
    }
    __device__ __forceinline__ int asg(const Unit& u, int r) const {
        const int pos = u.base + r, pc = pos < u.cnt ? pos : u.cnt - 1;
        const int a = lists[(size_t)u.e * T + pc];
        return pos < u.cnt ? a : A_TOT;
    }
    __device__ __forceinline__ int arow(const Unit& u, int r) const {
        const int a = asg(u, r);
        if (!up) return a;
        const int sh = a - 8 * T;
        return a < 8 * T ? (a >> 3) : (sh < T ? sh : T - 1);
    }
    __device__ __forceinline__ int orow(const Unit& u, int r) const { return asg(u, r); }
};
__device__ __forceinline__ void moe_build_tiles(LAS int* tp, const int* cnt) {
    if (threadIdx.x == 0) { int s = 0; for (int e = 0; e < 64; ++e) { tp[e] = s; s += (cnt[e] + 255) >> 8; } tp[64] = s; tp[65] = s + T / 256; }
    __syncthreads();
}

template <bool PERM, class Sch, class Epi>
__device__ __forceinline__ void gemm_naive(LAS unsigned char* lds, int wid_in, const GemmDesc g, const Sch& Sc, const Epi& E) {
    const int tid = wid_in * 64 + fresh_lane(), wid = tid >> 6, lane = tid & 63, wr = wid >> 2, wc = wid & 3, fr = lane & 15, fq = lane >> 4;
    constexpr int LP = 260;
    LAS float* As = (LAS float*)lds; LAS float* Bs = As + 32 * LP;
    const int sr = tid >> 1, kh = tid & 1;
    Unit u;
    for (int i = 0; Sc.next(i, u); ++i) {
        f32x4 acc[2][2][4][2];
#pragma unroll
        for (int a = 0; a < 2; ++a)
#pragma unroll
            for (int b = 0; b < 2; ++b)
#pragma unroll
                for (int m = 0; m < 4; ++m)
#pragma unroll
                    for (int n = 0; n < 2; ++n) acc[a][b][m][n] = (f32x4){0.f, 0.f, 0.f, 0.f};
        const GAS bf16_t* ap = g.A + (size_t)Sc.arow(u, sr) * g.lda + kh * 16;
        const GAS bf16_t* bp = u.Bt + (size_t)sr * g.ldb + kh * 16;
        for (int k0 = 0; k0 < g.K; k0 += 32) {
            const u32x4 a0 = *(const GAS u32x4*)(ap + k0), a1 = *(const GAS u32x4*)(ap + k0 + 8);
            const u32x4 b0 = *(const GAS u32x4*)(bp + k0), b1 = *(const GAS u32x4*)(bp + k0 + 8);
            __syncthreads();
#pragma unroll
            for (int j = 0; j < 4; ++j) {
                As[(kh * 16 + 2 * j) * LP + sr] = bflo(a0[j]); As[(kh * 16 + 2 * j + 1) * LP + sr] = bfhi(a0[j]);
                As[(kh * 16 + 8 + 2 * j) * LP + sr] = bflo(a1[j]); As[(kh * 16 + 9 + 2 * j) * LP + sr] = bfhi(a1[j]);
                Bs[(kh * 16 + 2 * j) * LP + sr] = bflo(b0[j]); Bs[(kh * 16 + 2 * j + 1) * LP + sr] = bfhi(b0[j]);
                Bs[(kh * 16 + 8 + 2 * j) * LP + sr] = bflo(b1[j]); Bs[(kh * 16 + 9 + 2 * j) * LP + sr] = bfhi(b1[j]);
            }
            __syncthreads();
#pragma unroll 4
            for (int kk = 0; kk < 32; ++kk) {
                float av[2][4]; f32x4 bv[2][2];
#pragma unroll
                for (int ai = 0; ai < 2; ++ai)
#pragma unroll
                    for (int m = 0; m < 4; ++m) av[ai][m] = As[kk * LP + 128 * ai + 64 * wr + 16 * m + fr];
#pragma unroll
                for (int bj = 0; bj < 2; ++bj)
#pragma unroll
                    for (int n = 0; n < 2; ++n) bv[bj][n] = *(const LAS f32x4*)&Bs[kk * LP + 128 * bj + 32 * wc + (PERM ? 8 * fq + 4 * n : 16 * n + 4 * fq)];
#pragma unroll
                for (int ai = 0; ai < 2; ++ai)
#pragma unroll
                    for (int bj = 0; bj < 2; ++bj)
#pragma unroll
                        for (int m = 0; m < 4; ++m)
#pragma unroll
                            for (int n = 0; n < 2; ++n) acc[ai][bj][m][n] += bv[bj][n] * av[ai][m];
            }
        }
        E(acc, u, Sc, wr, wc, fr, fq);
    }
    __syncthreads();
}

constexpr int HTB = 128 * 64 * 2;
__device__ __forceinline__ int lds_byte(int r, int c) { const int st = (r >> 4) * 2 + (c >> 5), rr = r & 15, cc = c & 31, ob = rr * 64 + cc * 2; return st * 1024 + (ob ^ (((ob >> 9) & 1) << 5)); }
__device__ __forceinline__ void stage_rc(int b, int& R, int& C) { const int st = b / 1024, sb = b % 1024, swz = sb ^ (((sb >> 9) & 1) << 5); R = (st >> 1) * 16 + swz / 64; C = (st & 1) * 32 + (swz % 64) / 2; }
__device__ __forceinline__ int perm32(int rho) { const int n = rho >> 4, i = rho & 15; return 8 * (i >> 2) + 4 * n + (i & 3); }
template <class Sch> __device__ __forceinline__ void calc_voff(const Sch& Sc, const Unit& u, int tid, int lda, unsigned (&vo)[2][2]) {
#pragma unroll
    for (int i = 0; i < 2; ++i) { int R, C; stage_rc(tid * 16 + i * 8192, R, C);
#pragma unroll
        for (int h = 0; h < 2; ++h) vo[h][i] = (unsigned)(Sc.arow(u, h * 128 + R) * lda + C) * 2u; }
}
template <bool PERM, class Sch, class Epi>
__device__ __forceinline__ void gemm_mfma(LAS unsigned char* lds, int wid_in, const GemmDesc g, const Sch& Sc, const Epi& E) {
    constexpr bool GA = Sch::GATHER;
    const int wid = __builtin_amdgcn_readfirstlane(wid_in), lane = fresh_lane(), tid = wid * 64 + lane, wr = wid >> 2, wc = wid & 3, fr = lane & 15, fq = lane >> 4;
    const int nt = g.K / 64;
    unsigned voffB[2], va[2];
#pragma unroll
    for (int i = 0; i < 2; ++i) { int R, C; stage_rc(tid * 16 + i * 8192, R, C); const int Rb = PERM ? ((R & ~31) + perm32(R & 31)) : R; voffB[i] = (unsigned)(Rb * g.ldb + C) * 2u; va[i] = (unsigned)(R * g.lda + C) * 2u; }
    const unsigned hstepB = (unsigned)(128 * g.ldb * 2), hstepA = (unsigned)(128 * g.lda * 2);
    const unsigned ldsw = (unsigned)wid * 1024u;
    const int aoff = lds_byte(wr * 64 + fr, fq * 8), boff = lds_byte(wc * 32 + fr, fq * 8);
    const GAS char* gA = (const GAS char*)g.A;
    LAS u32x4* nslot = (LAS u32x4*)(lds + LDS_MISC + 4096) + tid;
#define G_SA(b, h) (((b) * 2 + (h)) * HTB)
#define G_SB(b, h) ((4 + (b) * 2 + (h)) * HTB)
#define G_STAGE_A(bufoff, h, kb) do { const GAS char* _sb = GA ? (gA + (size_t)(kb)) : (uA + (size_t)(((h) ? hstepA : 0u) + (kb)));     \
        _Pragma("unroll") for (int _i = 0; _i < 2; ++_i) { \
        const GAS char* _p = _sb + (GA ? cvo[h][_i] : va[_i]); \
        __builtin_amdgcn_global_load_lds((const GAS unsigned*)_p, (LAS unsigned*)(lds + (bufoff) + ldsw + _i * 8192), 16, 0, 0); } } while (0)
#define G_STAGE_B(bufoff, bp) do { _Pragma("unroll") for (int _i = 0; _i < 2; ++_i) \
        __builtin_amdgcn_global_load_lds((const GAS unsigned*)((bp) + voffB[_i]), (LAS unsigned*)(lds + (bufoff) + ldsw + _i * 8192), 16, 0, 0); } while (0)
#define G_LDA(dst, b, h) do { _Pragma("unroll") for (int m = 0; m < 4; ++m) _Pragma("unroll") for (int k = 0; k < 2; ++k) dst[m][k] = *(const LAS bf16x8*)(lds + G_SA(b, h) + aoff + m * 2048 + k * 1024); } while (0)
#define G_LDB(dst, b, h) do { _Pragma("unroll") for (int n = 0; n < 2; ++n) _Pragma("unroll") for (int k = 0; k < 2; ++k) dst[n][k] = *(const LAS bf16x8*)(lds + G_SB(b, h) + boff + n * 2048 + k * 1024); } while (0)
#define G_MMA(ai, bj, At, Bt) do { __builtin_amdgcn_s_setprio(1); _Pragma("unroll") for (int m = 0; m < 4; ++m) _Pragma("unroll") for (int n = 0; n < 2; ++n) _Pragma("unroll") for (int k = 0; k < 2; ++k) \
        acc[ai][bj][m][n] = __builtin_amdgcn_mfma_f32_16x16x32_bf16(Bt[n][k], At[m][k], acc[ai][bj][m][n], 0, 0, 0); __builtin_amdgcn_s_setprio(0); } while (0)
#define G_WAIT_V(n) asm volatile("s_waitcnt vmcnt(" #n ")" ::: "memory")
#define G_WAIT_L(n) asm volatile("s_waitcnt lgkmcnt(" #n ")" ::: "memory")
#define G_BAR __builtin_amdgcn_s_barrier()
#define G_SCHED __builtin_amdgcn_sched_barrier(0)
    Unit cur, nxt; int ui = 0;
    if (!Sc.next(0, cur)) return;
    f32x4 acc[2][2][4][2];
#pragma unroll
    for (int a = 0; a < 2; ++a)
#pragma unroll
        for (int b = 0; b < 2; ++b)
#pragma unroll
            for (int m = 0; m < 4; ++m)
#pragma unroll
                for (int n = 0; n < 2; ++n) acc[a][b][m][n] = (f32x4){0.f, 0.f, 0.f, 0.f};
    bf16x8 At[4][2], B0[2][2], B1[2][2];
    unsigned cvo[2][2] = {{0u, 0u}, {0u, 0u}};
    const GAS char* uA = gA;
    bool has_next = Sc.next(1, nxt);
    if constexpr (GA) {
        calc_voff(Sc, cur, tid, g.lda, cvo);
        unsigned nv[2][2];
        if (has_next) calc_voff(Sc, nxt, tid, g.lda, nv);
        *nslot = has_next ? (u32x4){nv[0][0], nv[0][1], nv[1][0], nv[1][1]} : (u32x4){cvo[0][0], cvo[0][1], cvo[1][0], cvo[1][1]};
    } else {
        uA = gA + (size_t)Sc.arow(cur, 0) * g.lda * 2;
    }
    const GAS char* cB = (const GAS char*)cur.Bt;
    G_STAGE_B(G_SB(0, 0), cB); G_STAGE_A(G_SA(0, 0), 0, 0u); G_STAGE_B(G_SB(0, 1), cB + hstepB); G_STAGE_A(G_SA(0, 1), 1, 0u);
    if (wr == 1) G_BAR;
    G_WAIT_V(4); G_BAR;
    G_STAGE_B(G_SB(1, 0), cB + 128); G_STAGE_A(G_SA(1, 0), 0, 128u); G_STAGE_B(G_SB(1, 1), cB + hstepB + 128);
    G_WAIT_V(6); G_BAR;
    for (;;) {
        const GAS char* nB = has_next ? (const GAS char*)nxt.Bt : cB;
        const GAS char* nA = (!GA && has_next) ? gA + (size_t)Sc.arow(nxt, 0) * g.lda * 2 : uA;
        for (int t = 0; t < nt; t += 2) {
            const bool last = (t == nt - 2);
            const unsigned k1 = (unsigned)(t + 1) * 128u, k2 = last ? 0u : (unsigned)(t + 2) * 128u, k3 = k2 + 128u;
            const GAS char* b2 = last ? nB : cB + (size_t)(t + 2) * 128; const GAS char* b3 = b2 + 128;
            G_LDB(B0, 0, 0); G_SCHED; G_LDA(At, 0, 0); G_STAGE_A(G_SA(1, 1), 1, k1);
            if (last) {
                if constexpr (GA) { const u32x4 nv = *nslot; cvo[0][0] = nv[0]; cvo[0][1] = nv[1]; cvo[1][0] = nv[2]; cvo[1][1] = nv[3]; }
                else uA = nA;
            }
            G_WAIT_L(8); G_BAR; G_WAIT_L(0); G_MMA(0, 0, At, B0); G_BAR; G_SCHED;
            G_LDB(B1, 0, 1); G_STAGE_B(G_SB(0, 0), b2);
            G_BAR; G_WAIT_L(0); G_MMA(0, 1, At, B1); G_BAR;
            G_LDA(At, 0, 1); G_STAGE_A(G_SA(0, 0), 0, k2);
            G_BAR; G_WAIT_L(0); G_MMA(1, 0, At, B0); G_BAR; G_SCHED;
            G_STAGE_B(G_SB(0, 1), b2 + hstepB);
            G_WAIT_V(6); G_BAR; G_MMA(1, 1, At, B1); G_BAR;
            G_LDB(B0, 1, 0); G_SCHED; G_LDA(At, 1, 0); G_STAGE_A(G_SA(0, 1), 1, k2);
            G_WAIT_L(8); G_BAR; G_WAIT_L(0); G_MMA(0, 0, At, B0); G_BAR; G_SCHED;
            G_LDB(B1, 1, 1); G_STAGE_B(G_SB(1, 0), b3);
            G_BAR; G_WAIT_L(0); G_MMA(0, 1, At, B1); G_BAR;
            G_LDA(At, 1, 1); G_STAGE_A(G_SA(1, 0), 0, k3);
            G_BAR; G_WAIT_L(0); G_MMA(1, 0, At, B0); G_BAR; G_SCHED;
            G_STAGE_B(G_SB(1, 1), b3 + hstepB);
            G_WAIT_V(6); G_BAR; G_MMA(1, 1, At, B1); G_BAR;
        }
        { const int l2 = fresh_lane();
          E(acc, cur, Sc, wr, wc, l2 & 15, l2 >> 4); }
        if (!has_next) break;
        cur = nxt; cB = nB; ++ui;
        has_next = Sc.next(ui + 1, nxt);
        if constexpr (GA) {
            if (has_next) { const int tid2 = wid * 64 + fresh_lane(); unsigned nv[2][2]; calc_voff(Sc, nxt, tid2, g.lda, nv); *nslot = (u32x4){nv[0][0], nv[0][1], nv[1][0], nv[1][1]}; }
        }
#pragma unroll
        for (int a = 0; a < 2; ++a)
#pragma unroll
            for (int b = 0; b < 2; ++b)
#pragma unroll
                for (int m = 0; m < 4; ++m)
#pragma unroll
                    for (int n = 0; n < 2; ++n) acc[a][b][m][n] = (f32x4){0.f, 0.f, 0.f, 0.f};
    }
    G_WAIT_V(0);
    if (wr == 0) G_BAR;
    G_BAR;
#undef G_SA
#undef G_SB
#undef G_STAGE_A
#undef G_STAGE_B
#undef G_LDA
#undef G_LDB
#undef G_MMA
#undef G_WAIT_V
#undef G_WAIT_L
#undef G_BAR
#undef G_SCHED
}

#define EPI_ROWS(ai, m) (128 * (ai) + 64 * wr + 16 * (m) + fr)
struct EpiP {
    static constexpr bool PERM = true;
    bf16_t* P;
    template <class Sch> __device__ __forceinline__ void operator()(const f32x4 (&acc)[2][2][4][2], const Unit& u, const Sch& Sc, int wr, int wc, int fr, int fq) const {
#pragma unroll
        for (int ai = 0; ai < 2; ++ai)
#pragma unroll
            for (int m = 0; m < 4; ++m) { bf16_t* rp = P + (size_t)Sc.orow(u, EPI_ROWS(ai, m)) * 1024 + u.pn * 256 + 32 * wc + 8 * fq;
#pragma unroll
                for (int bj = 0; bj < 2; ++bj) store8_bf16(rp + 128 * bj, acc[ai][bj][m][0], acc[ai][bj][m][1]); asm volatile("" ::: "memory"); }
    }
};
struct EpiQ {
    static constexpr bool PERM = true;
    bf16_t* Q; const float* rsq; const f32x2* cs;
    template <class Sch> __device__ __forceinline__ void operator()(const f32x4 (&acc)[2][2][4][2], const Unit& u, const Sch& Sc, int wr, int wc, int fr, int fq) const {
#pragma unroll
        for (int ai = 0; ai < 2; ++ai)
#pragma unroll
            for (int m = 0; m < 4; ++m) {
                const int row = Sc.orow(u, EPI_ROWS(ai, m)); const float rs = rsq[row];
                if (u.pn < 3) {
#pragma unroll
                    for (int bj = 0; bj < 2; ++bj) store8_bf16(Q + (size_t)row * 1152 + (2 * u.pn + bj) * 192 + 32 * wc + 8 * fq, acc[ai][bj][m][0] * rs, acc[ai][bj][m][1] * rs);
                } else {
                    const int head = (u.pn == 3) ? wc : 4 + wc;
                    if (head < NH) {
                        const f32x2* cp = cs + (size_t)row * 32 + 8 * fq;
                        f32x4 lo[2], hi[2];
#pragma unroll
                        for (int n = 0; n < 2; ++n)
#pragma unroll
                            for (int j = 0; j < 4; ++j) { const f32x2 c = cp[4 * n + j]; const float x1 = acc[ai][0][m][n][j], x2 = acc[ai][1][m][n][j];
                                lo[n][j] = (x1 * c.x - x2 * c.y) * rs; hi[n][j] = (x2 * c.x + x1 * c.y) * rs; }
                        bf16_t* qp = Q + (size_t)row * 1152 + head * 192 + 128 + 8 * fq;
                        store8_bf16(qp, lo[0], lo[1]); store8_bf16(qp + 32, hi[0], hi[1]);
                    }
                }
            }
    }
};
struct EpiKV {
    static constexpr bool PERM = true;
    bf16_t* Kf; bf16_t* V; const float* rskv;
    template <class Sch> __device__ __forceinline__ void operator()(const f32x4 (&acc)[2][2][4][2], const Unit& u, const Sch& Sc, int wr, int wc, int fr, int fq) const {
#pragma unroll
        for (int ai = 0; ai < 2; ++ai)
#pragma unroll
            for (int m = 0; m < 4; ++m) {
                const int row = Sc.orow(u, EPI_ROWS(ai, m)); const float rs = rskv[row];
                store8_bf16(Kf + (size_t)row * 1152 + u.pn * 192 + 32 * wc + 8 * fq, acc[ai][0][m][0] * rs, acc[ai][0][m][1] * rs);
                store8_bf16(V + (size_t)row * 768 + u.pn * 128 + 32 * wc + 8 * fq, acc[ai][1][m][0] * rs, acc[ai][1][m][1] * rs);
            asm volatile("" ::: "memory"); }
    }
};
struct EpiOut {
    static constexpr bool PERM = false;
    const float* xin; float* y; const float* g1;
    template <class Sch> __device__ __forceinline__ void operator()(const f32x4 (&acc)[2][2][4][2], const Unit& u, const Sch& Sc, int wr, int wc, int fr, int fq) const {
        const int b = (u.pm * 256) / S; const int col0 = u.pn * 256 + 32 * wc + 4 * fq;
        f32x4 gv[2][2];
#pragma unroll
        for (int bj = 0; bj < 2; ++bj)
#pragma unroll
            for (int n = 0; n < 2; ++n) gv[bj][n] = *(const f32x4*)(g1 + (size_t)b * 6144 + col0 + 128 * bj + 16 * n);
#pragma unroll
        for (int ai = 0; ai < 2; ++ai)
#pragma unroll
            for (int m = 0; m < 4; ++m) { const size_t off = (size_t)Sc.orow(u, EPI_ROWS(ai, m)) * 1024 + col0;
#pragma unroll
                for (int bj = 0; bj < 2; ++bj)
#pragma unroll
                    for (int n = 0; n < 2; ++n) { const f32x4 xv = *(const f32x4*)(xin + off + 128 * bj + 16 * n);
                        *(f32x4*)(y + off + 128 * bj + 16 * n) = xv * ALPHA + gv[bj][n] * acc[ai][bj][m][n]; } asm volatile("" ::: "memory"); }
    }
};
struct EpiRouter {
    static constexpr bool PERM = false;
    float* logits;
    template <class Sch> __device__ __forceinline__ void operator()(const f32x4 (&acc)[2][2][4][2], const Unit& u, const Sch& Sc, int wr, int wc, int fr, int fq) const {
        if (wc < 2) {
#pragma unroll
            for (int ai = 0; ai < 2; ++ai)
#pragma unroll
                for (int m = 0; m < 4; ++m) { float* rp = logits + (size_t)Sc.orow(u, EPI_ROWS(ai, m)) * 64 + 32 * wc + 4 * fq;
#pragma unroll
                    for (int n = 0; n < 2; ++n) *(f32x4*)(rp + 16 * n) = acc[ai][0][m][n]; }
        }
    }
};
struct EpiSwiglu {
    static constexpr bool PERM = true;
    bf16_t* act;
    template <class Sch> __device__ __forceinline__ void operator()(const f32x4 (&acc)[2][2][4][2], const Unit& u, const Sch& Sc, int wr, int wc, int fr, int fq) const {
#pragma unroll
        for (int ai = 0; ai < 2; ++ai)
#pragma unroll
            for (int m = 0; m < 4; ++m) { f32x4 o[2];
#pragma unroll
                for (int n = 0; n < 2; ++n)
#pragma unroll
                    for (int j = 0; j < 4; ++j) { const float gt = acc[ai][0][m][n][j], up = acc[ai][1][m][n][j]; o[n][j] = gt / (1.f + __expf(-gt)) * up; }
                store8_bf16(act + (size_t)Sc.orow(u, EPI_ROWS(ai, m)) * 256 + u.pn * 128 + 32 * wc + 8 * fq, o[0], o[1]); asm volatile("" ::: "memory"); }
    }
};
struct EpiDown {
    static constexpr bool PERM = true;
    bf16_t* Y;
    template <class Sch> __device__ __forceinline__ void operator()(const f32x4 (&acc)[2][2][4][2], const Unit& u, const Sch& Sc, int wr, int wc, int fr, int fq) const {
#pragma unroll
        for (int ai = 0; ai < 2; ++ai)
#pragma unroll
            for (int m = 0; m < 4; ++m) { bf16_t* rp = Y + (size_t)Sc.orow(u, EPI_ROWS(ai, m)) * 1024 + u.pn * 256 + 32 * wc + 8 * fq;
#pragma unroll
                for (int bj = 0; bj < 2; ++bj) store8_bf16(rp + 128 * bj, acc[ai][bj][m][0], acc[ai][bj][m][1]); asm volatile("" ::: "memory"); }
    }
};

__device__ __forceinline__ void xpose_item(const float* src, int ld, bf16_t* dst, int Kdst, const float* kscale  , float mul, LAS float* scr, int lane) {
#pragma unroll 8
    for (int i = 0; i < 32; ++i) { const int kk = 2 * i + (lane >> 5); float v = src[(size_t)kk * ld + (lane & 31)]; if (kscale) v *= kscale[kk]; scr[kk * 33 + (lane & 31)] = v * mul; }
    asm volatile("s_waitcnt lgkmcnt(0)" ::: "memory");
    const int c = lane & 7;
#pragma unroll
    for (int j = 0; j < 4; ++j) { const int n = (lane >> 3) + 8 * j; const LAS float* s = scr + (8 * c) * 33 + n;
        u32x4 o; o.x = cvt_pk_bf16(s[0 * 33], s[1 * 33]); o.y = cvt_pk_bf16(s[2 * 33], s[3 * 33]); o.z = cvt_pk_bf16(s[4 * 33], s[5 * 33]); o.w = cvt_pk_bf16(s[6 * 33], s[7 * 33]);
        *(u32x4*)(dst + (size_t)n * Kdst + 8 * c) = o; }
    asm volatile("s_waitcnt lgkmcnt(0)" ::: "memory");
}
__device__ __forceinline__ void zero_rows(bf16_t* dst, size_t nelem, int gw, int ngw, int lane) {
    for (size_t i = ((size_t)gw * 64 + lane) * 8; i < nelem; i += (size_t)ngw * 64 * 8) *(u32x4*)(dst + i) = (u32x4){0u, 0u, 0u, 0u};
}
__device__ __forceinline__ int uq_srccol(int g) {
    const int n = 32 * g;
    if (n < 768) return (n / 128) * 192 + (n % 128);
    if (n < 1024) { const int q = n - 768, half = q / 128, hh = (q % 128) / 32; return hh * 192 + 128 + half * 32; }
    { const int q = n - 1024, half = q / 128, w = q % 128; if (w >= 64) return -1; return (4 + w / 32) * 192 + 128 + half * 32; }
}

struct Ctx { LAS unsigned char* lds; int tid, lane, wid, gw, ngw, G, bid; };

__device__ __forceinline__ void ph_prologue(const Params& p, const Ctx& c) {
    unsigned char* ws = p.ws;
    float* mod = (float*)(ws + WS_MOD);
    {
        LAS float* cond = (LAS float*)c.lds;
        LAS float* red = cond + 16 * 1024;
        for (int i = c.tid; i < 16 * 1024; i += NTHREADS) { const float v = p.c[i]; cond[i] = v / (1.f + __expf(-v)); }
        __syncthreads();
        const int nc = c.tid & 127, kq = c.tid >> 7;
        for (int u = c.bid; u < NL * 48; u += c.G) {
            const int l = u / 48, n0 = (u % 48) * 128;
            float acc[16];
#pragma unroll
            for (int b = 0; b < 16; ++b) acc[b] = 0.f;
            const float* wp = p.w_ada + ((size_t)l * 1024 + kq * 256) * 6144 + n0 + nc;
#pragma unroll 4
            for (int k = 0; k < 256; ++k) { const float w = wp[(size_t)k * 6144];
#pragma unroll
                for (int b = 0; b < 16; ++b) acc[b] += cond[b * 1024 + kq * 256 + k] * w; }
#pragma unroll
            for (int b = 0; b < 16; ++b) red[(kq * 16 + b) * 128 + nc] = acc[b];
            __syncthreads();
            for (int o = c.tid; o < 2048; o += NTHREADS) { const int b = o >> 7, n = o & 127;
                mod[((size_t)l * 16 + b) * 6144 + n0 + n] = red[(0 * 16 + b) * 128 + n] + red[(1 * 16 + b) * 128 + n] + red[(2 * 16 + b) * 128 + n] + red[(3 * 16 + b) * 128 + n] + p.b_ada[l * 6144 + n0 + n]; }
            __syncthreads();
        }
    }
    {
        f32x2* cs = (f32x2*)(ws + WS_CS);
        for (int i = c.bid * NTHREADS + c.tid; i < T * 32; i += c.G * NTHREADS) {
            const int t = i >> 5, k = i & 31; const float inv = powf(10000.f, -(float)k / 32.f); const float ang = (float)p.pos[t] * inv;
            float sn, cn; sincosf(ang, &sn, &cn); cs[i] = (f32x2){cn, sn};
        }
    }
    {
        LAS float* scr = (LAS float*)(c.lds + c.wid * 16384);
        bf16_t* WinT = (bf16_t*)(ws + WS_WIN); bf16_t* WuqT = (bf16_t*)(ws + WS_WUQ); bf16_t* WukvT = (bf16_t*)(ws + WS_WUKV);
        bf16_t* WoutT = (bf16_t*)(ws + WS_WOUT); bf16_t* WrT = (bf16_t*)(ws + WS_WR);
        constexpr int I_IN = 30 * 16, I_UQ = 40 * 6, I_UKV = 48 * 4, I_OUT = 32 * 16, I_R = 2 * 16, I_L = I_IN + I_UQ + I_UKV + I_OUT + I_R;
        for (int it = c.gw; it < NL * I_L; it += c.ngw) {
            const int l = it / I_L; int r = it % I_L;
            if (r < I_IN) { const int g = r / 16, kb = r % 16; xpose_item(p.w_in + ((size_t)l * 1024 + 64 * kb) * INW + 32 * g, INW, WinT + ((size_t)l * 1024 + 32 * g) * 1024 + 64 * kb, 1024, nullptr, 1.f, scr, c.lane); continue; } r -= I_IN;
            if (r < I_UQ) { const int g = r / 6, kb = r % 6, sc = uq_srccol(g); bf16_t* dst = WuqT + ((size_t)l * 1280 + 32 * g) * 384 + 64 * kb;
                if (sc >= 0) xpose_item(p.w_uq + ((size_t)l * 384 + 64 * kb) * 1152 + sc, 1152, dst, 384, p.qg + l * 384 + 64 * kb, QSCALE, scr, c.lane);
                else { const int n = c.lane >> 1, h8 = (c.lane & 1) * 32; for (int q = 0; q < 4; ++q) *(u32x4*)(dst + (size_t)n * 384 + h8 + 8 * q) = (u32x4){0u, 0u, 0u, 0u}; }
                continue; } r -= I_UQ;
            if (r < I_UKV) { const int g = r / 4, kb = r % 4; xpose_item(p.w_ukv + ((size_t)l * 256 + 64 * kb) * 1536 + 32 * g, 1536, WukvT + ((size_t)l * 1536 + 32 * g) * 256 + 64 * kb, 256, p.kvg + l * 256 + 64 * kb, 1.f, scr, c.lane); continue; } r -= I_UKV;
            if (r < I_OUT) { const int g = r / 16, kb = r % 16; xpose_item(p.w_out + ((size_t)l * 1024 + 64 * kb) * 1024 + 32 * g, 1024, WoutT + ((size_t)l * 1024 + 32 * g) * 1024 + 64 * kb, 1024, nullptr, 1.f, scr, c.lane); continue; } r -= I_OUT;
            { const int g = r / 16, kb = r % 16; xpose_item(p.w_router + ((size_t)l * 1024 + 64 * kb) * 64 + 32 * g, 64, WrT + ((size_t)l * 256 + 32 * g) * 1024 + 64 * kb, 1024, nullptr, 1.f, scr, c.lane); }
        }
        for (int l = 0; l < NL; ++l) {
            zero_rows(WinT + ((size_t)l * 1024 + 960) * 1024, (size_t)64 * 1024, c.gw, c.ngw, c.lane);
            zero_rows(WrT + ((size_t)l * 256 + 64) * 1024, (size_t)192 * 1024, c.gw, c.ngw, c.lane);
        }
    }
}

__device__ __forceinline__ void write_mod_row(const f32x4 (&v)[4], const float* sh, const float* sc, bf16_t* hrow, int lane) {
#pragma unroll
    for (int j = 0; j < 4; ++j) { const f32x4 s1 = *(const f32x4*)(sc + 4 * lane + 256 * j), s0 = *(const f32x4*)(sh + 4 * lane + 256 * j);
        const f32x4 o = v[j] * (s1 + 1.f) + s0; u32x2 w; w.x = cvt_pk_bf16(o[0], o[1]); w.y = cvt_pk_bf16(o[2], o[3]);
        *(u32x2*)(hrow + 4 * lane + 256 * j) = w; }
}

__device__ __forceinline__ void ph_prep(const Params& p, const Ctx& c, int l) {
    unsigned char* ws = p.ws;
    LAS float* scr = (LAS float*)(c.lds + c.wid * 16384);
    bf16_t* Wgu = (bf16_t*)(ws + WS_WGU); bf16_t* Wd = (bf16_t*)(ws + WS_WD);
    constexpr int I_GU = 16 * 16, I_D = 32 * 4, I_E = I_GU + I_D;
    for (int it = c.gw; it < 65 * I_E; it += c.ngw) {
        const int e = it / I_E; int r = it % I_E;
        if (r < I_GU) { const int g = r / 16, kb = r % 16, r0 = 32 * g, cb = r0 >> 8, half = (r0 >> 7) & 1, c0 = cb * 128 + (r0 & 127);
            const float* src = (e < 64) ? ((half ? p.weu : p.weg) + ((size_t)(l * 64 + e) * 1024) * 256) : ((half ? p.wsu : p.wsg) + (size_t)l * 1024 * 256);
            xpose_item(src + (size_t)(64 * kb) * 256 + c0, 256, Wgu + ((size_t)e * 512 + r0) * 1024 + 64 * kb, 1024, nullptr, 1.f, scr, c.lane);
        } else { r -= I_GU; const int g = r / 4, kb = r % 4;
            const float* src = (e < 64) ? (p.wed + ((size_t)(l * 64 + e) * 256) * 1024) : (p.wsd + (size_t)l * 256 * 1024);
            xpose_item(src + (size_t)(64 * kb) * 1024 + 32 * g, 1024, Wd + ((size_t)e * 1024 + 32 * g) * 256 + 64 * kb, 256, nullptr, 1.f, scr, c.lane);
        }
    }
    if (l == 0) {
        const float* mod = (const float*)(ws + WS_MOD); bf16_t* H = (bf16_t*)(ws + WS_H);
        for (int t = c.gw; t < T; t += c.ngw) { const int b = t / S; f32x4 v[4];
#pragma unroll
            for (int j = 0; j < 4; ++j) v[j] = *(const f32x4*)(p.x + (size_t)t * 1024 + 4 * c.lane + 256 * j);
            write_mod_row(v, mod + (size_t)b * 6144 + 0, mod + (size_t)b * 6144 + 1024, H + (size_t)t * 1024, c.lane); }
    }
}

__device__ __forceinline__ void ph_post_in(const Params& p, const Ctx& c, int l) {
    unsigned char* ws = p.ws;
    const bf16_t* P = (const bf16_t*)(ws + WS_P); bf16_t* Kf = (bf16_t*)(ws + WS_KF); bf16_t* MIX = (bf16_t*)(ws + WS_MIX);
    float* rsq = (float*)(ws + WS_RSQ); float* rskv = (float*)(ws + WS_RSKV); const f32x2* cs = (const f32x2*)(ws + WS_CS);
    LAS float* wp = (LAS float*)c.lds;
    for (int i = c.tid; i < 4 * 64 * 64; i += NTHREADS) wp[i] = p.w_pool[(size_t)l * 16384 + i];
    __syncthreads();
    const int lane = c.lane;
    for (int t = c.gw; t < T; t += c.ngw) {
        const bf16_t* row = P + (size_t)t * 1024;
        { const unsigned* q32 = (const unsigned*)(row + 256) + lane * 3; float s = 0.f;
#pragma unroll
            for (int j = 0; j < 3; ++j) { const unsigned w = q32[j]; const float a = bflo(w), b = bfhi(w); s += a * a + b * b; }
            s = wave_sum(s); if (lane == 0) rsq[t] = 1.0f / sqrtf(s * (1.f / 384.f) + RMS_EPS); }
        { const u32x2 w = *((const u32x2*)(row + 640) + lane); const float a = bflo(w.x), b = bfhi(w.x), c2 = bflo(w.y), d2 = bfhi(w.y);
            float s = a * a + b * b + c2 * c2 + d2 * d2; s = wave_sum(s); if (lane == 0) rskv[t] = 1.0f / sqrtf(s * (1.f / 256.f) + RMS_EPS); }
        if (lane < 32) { const float x1 = bf2f(row[896 + lane]), x2 = bf2f(row[928 + lane]); const f32x2 cc = cs[(size_t)t * 32 + lane];
            const unsigned o = cvt_pk_bf16(x1 * cc.x - x2 * cc.y, x2 * cc.x + x1 * cc.y);
#pragma unroll
            for (int h = 0; h < NH; ++h) { bf16_t* kp = Kf + (size_t)t * 1152 + h * 192 + 128; kp[lane] = (bf16_t)(o & 0xffffu); kp[32 + lane] = (bf16_t)(o >> 16); } }
        const int s = t % S;
        float tm[4];
#pragma unroll
        for (int g = 0; g < 4; ++g) { const int w = 2 << g, cnt = (s + 1 < w) ? s + 1 : w; float sum = 0.f;
            for (int j = 0; j < cnt; ++j) sum += bf2f(P[(size_t)(t - j) * 1024 + 64 * g + lane]);
            tm[g] = sum / (float)cnt - bf2f(row[64 * g + lane]); }
#pragma unroll
        for (int g = 0; g < 4; ++g) { float o = 0.f;
            for (int cc = 0; cc < 64; ++cc) o += __int_as_float(__builtin_amdgcn_readlane(__float_as_int(tm[g]), cc)) * wp[(g * 64 + cc) * 64 + lane];
            o *= p.pool_scale[l * 256 + 64 * g + lane];
            MIX[(size_t)t * 1024 + 64 * g + lane] = (bf16_t)(cvt_pk_bf16(o, 0.f) & 0xffffu); }
    }
}

__device__ __forceinline__ void ph_attn_naive(const Params& p, const Ctx& c) {
    unsigned char* ws = p.ws;
    const bf16_t* Q = (const bf16_t*)(ws + WS_Q); const bf16_t* Kf = (const bf16_t*)(ws + WS_KF); const bf16_t* V = (const bf16_t*)(ws + WS_V); bf16_t* MIX = (bf16_t*)(ws + WS_MIX);
    LAS float* qs = (LAS float*)(c.lds + c.wid * 8192);
    const int lane = c.lane;
    for (int item = c.bid; item < 96 * 32; item += c.G) {
        const int bh = item % 96, qb = 31 - item / 96, b = bh / NH, h = bh % NH;
        const int q0 = qb * 64 + c.wid * 8;
        for (int i = lane; i < 8 * 192; i += 64) { const int r = i / 192, d = i % 192; qs[i] = bf2f(Q[(size_t)(b * S + q0 + r) * 1152 + h * 192 + d]); }
        asm volatile("s_waitcnt lgkmcnt(0)" ::: "memory");
        float m[8], lsum[8], o0[8], o1[8];
#pragma unroll
        for (int r = 0; r < 8; ++r) { m[r] = -1e30f; lsum[r] = 0.f; o0[r] = 0.f; o1[r] = 0.f; }
        const int last = q0 + 7, nch = last / 64 + 1;
        for (int ch = 0; ch < nch; ++ch) {
            const int key = ch * 64 + lane; float sc[8];
#pragma unroll
            for (int r = 0; r < 8; ++r) sc[r] = 0.f;
            if (key <= last) {
                const bf16_t* kp = Kf + (size_t)(b * S + key) * 1152 + h * 192;
                for (int cc = 0; cc < 24; ++cc) { const u32x4 kw = *(const u32x4*)(kp + 8 * cc); float kf[8];
#pragma unroll
                    for (int j = 0; j < 4; ++j) { kf[2 * j] = bflo(kw[j]); kf[2 * j + 1] = bfhi(kw[j]); }
#pragma unroll
                    for (int r = 0; r < 8; ++r) { const f32x4 qa = *(const LAS f32x4*)&qs[r * 192 + 8 * cc], qb2 = *(const LAS f32x4*)&qs[r * 192 + 8 * cc + 4];
                        sc[r] += qa[0] * kf[0] + qa[1] * kf[1] + qa[2] * kf[2] + qa[3] * kf[3] + qb2[0] * kf[4] + qb2[1] * kf[5] + qb2[2] * kf[6] + qb2[3] * kf[7]; } }
            }
            float pr[8];
#pragma unroll
            for (int r = 0; r < 8; ++r) { const float sv = (key <= q0 + r) ? sc[r] : -__builtin_inff(); const float mx = wave_max(sv), mn = fmaxf(m[r], mx);
                const float al = __builtin_amdgcn_exp2f(m[r] - mn); const float pv = __builtin_amdgcn_exp2f(sv - mn);
                lsum[r] = lsum[r] * al + wave_sum(pv); o0[r] *= al; o1[r] *= al; m[r] = mn; pr[r] = pv; }
            const int kmax = (last - ch * 64 < 63) ? last - ch * 64 : 63;
            const bf16_t* vp = V + (size_t)(b * S + ch * 64) * 768 + h * 128 + 2 * lane;
            for (int kk = 0; kk <= kmax; ++kk) { const unsigned vw = *(const unsigned*)(vp + (size_t)kk * 768); const float v0 = bflo(vw), v1 = bfhi(vw);
#pragma unroll
                for (int r = 0; r < 8; ++r) { const float pk = __int_as_float(__builtin_amdgcn_readlane(__float_as_int(pr[r]), kk)); o0[r] += pk * v0; o1[r] += pk * v1; } }
        }
#pragma unroll
        for (int r = 0; r < 8; ++r) { const float il = 1.f / lsum[r];
            *(unsigned*)(MIX + (size_t)(b * S + q0 + r) * 1024 + 256 + h * 128 + 2 * lane) = cvt_pk_bf16(o0[r] * il, o1[r] * il); }
    }
}

__device__ __forceinline__ void ln_row(f32x4 (&v)[4], const float* g, const float* bta, int lane) {
    float s = 0.f;
#pragma unroll
    for (int j = 0; j < 4; ++j) s += (v[j][0] + v[j][1]) + (v[j][2] + v[j][3]);
    const float mean = wave_sum(s) * (1.f / D); float s2 = 0.f;
#pragma unroll
    for (int j = 0; j < 4; ++j) { v[j] = v[j] - mean; s2 += (v[j][0] * v[j][0] + v[j][1] * v[j][1]) + (v[j][2] * v[j][2] + v[j][3] * v[j][3]); }
    const float rstd = 1.0f / sqrtf(wave_sum(s2) * (1.f / D) + LN_EPS);
#pragma unroll
    for (int j = 0; j < 4; ++j) { const f32x4 gg = *(const f32x4*)(g + 4 * lane + 256 * j), bb = *(const f32x4*)(bta + 4 * lane + 256 * j); v[j] = v[j] * rstd * gg + bb; }
}

__device__ __forceinline__ void ph_ln1(const Params& p, const Ctx& c, int l) {
    const float* mod = (const float*)(p.ws + WS_MOD) + (size_t)l * 16 * 6144; bf16_t* H = (bf16_t*)(p.ws + WS_H);
    for (int t = c.gw; t < T; t += c.ngw) { const int b = t / S; f32x4 v[4]; float* xr = p.out + (size_t)t * 1024;
#pragma unroll
        for (int j = 0; j < 4; ++j) v[j] = *(const f32x4*)(xr + 4 * c.lane + 256 * j);
        ln_row(v, p.ln1g + l * 1024, p.ln1b + l * 1024, c.lane);
#pragma unroll
        for (int j = 0; j < 4; ++j) *(f32x4*)(xr + 4 * c.lane + 256 * j) = v[j];
        write_mod_row(v, mod + (size_t)b * 6144 + 3 * 1024, mod + (size_t)b * 6144 + 4 * 1024, H + (size_t)t * 1024, c.lane); }
}

__device__ __forceinline__ void ph_route(const Params& p, const Ctx& c, int l) {
    unsigned char* ws = p.ws;
    const float* logits = (const float*)(ws + WS_LOG); float* tg = (float*)(ws + WS_TG); int* lists = (int*)(ws + WS_LIST);
    unsigned* cnt = (unsigned*)(ws + WS_CTL) + CW_CNT + l * 64;
    LAS float* sc = (LAS float*)c.lds;
    LAS unsigned* lcnt = (LAS unsigned*)(c.lds + LDS_MISC + 1024); LAS unsigned* gbase = lcnt + 64;
    const int tid = c.tid;
    for (int i = c.bid * NTHREADS + tid; i < T; i += c.G * NTHREADS) lists[(size_t)64 * T + i] = 8 * T + i;
    for (int t0 = c.bid * NTHREADS; t0 < T; t0 += c.G * NTHREADS) {
        const int t = t0 + tid;
        if (tid < 64) lcnt[tid] = 0u;
        const float* lr = logits + (size_t)t * 64;
#pragma unroll
        for (int q = 0; q < 16; ++q) { const f32x4 v = *(const f32x4*)(lr + 4 * q);
#pragma unroll
            for (int j = 0; j < 4; ++j) { const int e = 4 * q + j; sc[e * NTHREADS + tid] = 1.f / (1.f + __expf(-v[j])) + p.rbias[l * 64 + e]; } }
        float gs[8];
#pragma unroll
        for (int g = 0; g < 8; ++g) { float a = -__builtin_inff(), b2 = -__builtin_inff();
#pragma unroll
            for (int j = 0; j < 8; ++j) { const float v = sc[(8 * g + j) * NTHREADS + tid]; if (v > a) { b2 = a; a = v; } else if (v > b2) b2 = v; }
            gs[g] = a + b2; }
        unsigned gmask = 0u;
#pragma unroll
        for (int r = 0; r < 4; ++r) { float best = -__builtin_inff(); int bi = 0;
#pragma unroll
            for (int g = 0; g < 8; ++g) { const bool ok = !((gmask >> g) & 1u) && gs[g] > best; best = ok ? gs[g] : best; bi = ok ? g : bi; }
            gmask |= 1u << bi; }
        unsigned long long taken = 0ull; int ek[8]; float wk[8]; float wsum = 0.f;
#pragma unroll
        for (int k = 0; k < 8; ++k) { float best = -__builtin_inff(); int bi = 0;
            for (int e = 0; e < 64; ++e) { const bool ok = ((gmask >> (e >> 3)) & 1u) && !((taken >> e) & 1ull); const float v = sc[e * NTHREADS + tid]; if (ok && v > best) { best = v; bi = e; } }
            taken |= 1ull << bi; ek[k] = bi; const float w = 1.f / (1.f + __expf(-lr[bi])); wk[k] = w; wsum += w; }
        __syncthreads();
        unsigned rk[8];
#pragma unroll
        for (int k = 0; k < 8; ++k) rk[k] = atomicAdd((unsigned*)&lcnt[ek[k]], 1u);
        __syncthreads();
        if (tid < 64) gbase[tid] = atomicAdd(&cnt[tid], lcnt[tid]);
        __syncthreads();
        const float inv = 2.5f / wsum;
#pragma unroll
        for (int k = 0; k < 8; ++k) { tg[(size_t)t * 8 + k] = wk[k] * inv; lists[(size_t)ek[k] * T + gbase[ek[k]] + rk[k]] = t * 8 + k; }
        __syncthreads();
    }
}

__device__ __forceinline__ void ph_combine(const Params& p, const Ctx& c, int l) {
    unsigned char* ws = p.ws;
    const float* mod = (const float*)(ws + WS_MOD) + (size_t)l * 16 * 6144; const float* modn = mod + 16 * 6144; bf16_t* H = (bf16_t*)(ws + WS_H);
    const bf16_t* Y = (const bf16_t*)(ws + WS_Y); const float* tg = (const float*)(ws + WS_TG);
    for (int t = c.gw; t < T; t += c.ngw) { const int b = t / S; f32x4 f[4]; float* xr = p.out + (size_t)t * 1024;
        { const bf16_t* yr = Y + (size_t)(8 * T + t) * 1024;
#pragma unroll
            for (int j = 0; j < 4; ++j) { const u32x2 w = *(const u32x2*)(yr + 4 * c.lane + 256 * j); f[j] = (f32x4){bflo(w.x), bfhi(w.x), bflo(w.y), bfhi(w.y)}; } }
        f32x4 r4[4];
#pragma unroll
        for (int j = 0; j < 4; ++j) r4[j] = (f32x4){0.f, 0.f, 0.f, 0.f};
#pragma unroll
        for (int k = 0; k < 8; ++k) { const float gk = tg[(size_t)t * 8 + k]; const bf16_t* yr = Y + (size_t)(t * 8 + k) * 1024;
#pragma unroll
            for (int j = 0; j < 4; ++j) { const u32x2 w = *(const u32x2*)(yr + 4 * c.lane + 256 * j); r4[j] += (f32x4){bflo(w.x), bfhi(w.x), bflo(w.y), bfhi(w.y)} * gk; } }
        f32x4 v[4];
#pragma unroll
        for (int j = 0; j < 4; ++j) { const f32x4 g2 = *(const f32x4*)(mod + (size_t)b * 6144 + 5 * 1024 + 4 * c.lane + 256 * j); v[j] = *(const f32x4*)(xr + 4 * c.lane + 256 * j) * ALPHA + g2 * (f[j] + r4[j]); }
        ln_row(v, p.ln2g + l * 1024, p.ln2b + l * 1024, c.lane);
#pragma unroll
        for (int j = 0; j < 4; ++j) *(f32x4*)(xr + 4 * c.lane + 256 * j) = v[j];
        if (l + 1 < NL) write_mod_row(v, modn + (size_t)b * 6144 + 0, modn + (size_t)b * 6144 + 1024, H + (size_t)t * 1024, c.lane); }
}

#ifndef GEMM_BODY
#define GEMM_BODY gemm_mfma
#endif
#ifndef GB_EpiP
#define GB_EpiP GEMM_BODY
#endif
#ifndef GB_EpiQ
#define GB_EpiQ GEMM_BODY
#endif
#ifndef GB_EpiKV
#define GB_EpiKV GEMM_BODY
#endif
#ifndef GB_EpiOut
#define GB_EpiOut GEMM_BODY
#endif
#ifndef GB_EpiRouter
#define GB_EpiRouter GEMM_BODY
#endif
#ifndef GB_EpiSwiglu
#define GB_EpiSwiglu GEMM_BODY
#endif
#ifndef GB_EpiDown
#define GB_EpiDown GEMM_BODY
#endif

__global__ void __launch_bounds__(NTHREADS, 2) mk_fwd(Params p, int seg_lo, int seg_hi) {
    extern __shared__ __attribute__((aligned(16))) unsigned char lds_raw[];
    Ctx c0; c0.lds = (LAS unsigned char*)lds_raw; c0.tid = threadIdx.x; c0.lane = c0.tid & 63; c0.wid = __builtin_amdgcn_readfirstlane(c0.tid >> 6);
    c0.G = gridDim.x; c0.bid = blockIdx.x; c0.gw = c0.bid * NWAVES + c0.wid; c0.ngw = c0.G * NWAVES;
    volatile LAS unsigned* misc = (volatile LAS unsigned*)(c0.lds + LDS_MISC);
    if (c0.tid < 64) misc[c0.tid] = 0u;
    __syncthreads();
    XcdBarrier bar; { LOAD_Q bar = xcd_barrier_post((unsigned*)(q.ws + WS_CTL) + CW_BAR, misc); }
    LAS int* tp = (LAS int*)(c0.lds + LDS_MISC + 256);
#define IN(k) (seg_lo <= (k) && (k) < seg_hi)
#define SEAM(k) do { if (IN((k) + 1)) xcd_barrier(bar); } while (0)

    if (IN(0)) { PHASE_Q ph_prologue(q, c); SEAM(0); }
    for (int l = 0; l < NL; ++l) {
        const int sb = 1 + l * PH_PER_LAYER;
        if (IN(sb + 0)) { PHASE_Q ph_prep(q, c, l); SEAM(sb + 0); }
        if (IN(sb + 1)) {
            PHASE_Q
            GemmDesc g{(const GAS bf16_t*)(ws + WS_H), 1024, 1024, 1024};
            DenseSched sc{(const GAS bf16_t*)(ws + WS_WIN) + (size_t)l * 1024 * 1024, 1024, T / 256, 4, c.G, c.bid};
            EpiP e{(bf16_t*)(ws + WS_P)};
            GB_EpiP<EpiP::PERM>(c.lds, c.wid, g, sc, e); SEAM(sb + 1); }
        if (IN(sb + 2)) { PHASE_Q ph_post_in(q, c, l); SEAM(sb + 2); }
        if (IN(sb + 3)) {
            PHASE_Q
            { GemmDesc g{(const GAS bf16_t*)(ws + WS_P) + 256, 1024, 384, 384};
              DenseSched sc{(const GAS bf16_t*)(ws + WS_WUQ) + (size_t)l * 1280 * 384, 384, T / 256, 5, c.G, c.bid};
              EpiQ e{(bf16_t*)(ws + WS_Q), (const float*)(ws + WS_RSQ), (const f32x2*)(ws + WS_CS)};
              GB_EpiQ<EpiQ::PERM>(c.lds, c.wid, g, sc, e); }
            { GemmDesc g{(const GAS bf16_t*)(ws + WS_P) + 640, 1024, 256, 256};
              int bid2 = c0.bid, g2 = c0.G; asm volatile("" : "+s"(bid2), "+s"(g2));
              DenseSched sc{(const GAS bf16_t*)(ws + WS_WUKV) + (size_t)l * 1536 * 256, 256, T / 256, 6, g2, g2 - 1 - bid2};
              EpiKV e{(bf16_t*)(ws + WS_KF), (bf16_t*)(ws + WS_V), (const float*)(ws + WS_RSKV)};
              GB_EpiKV<EpiKV::PERM>(c.lds, c.wid, g, sc, e); }
            SEAM(sb + 3); }
        if (IN(sb + 4)) { PHASE_Q ph_attn_naive(q, c); SEAM(sb + 4); }
        if (IN(sb + 5)) {
            PHASE_Q const float* mod = (const float*)(ws + WS_MOD) + (size_t)l * 16 * 6144;
            GemmDesc g{(const GAS bf16_t*)(ws + WS_MIX), 1024, 1024, 1024};
            DenseSched sc{(const GAS bf16_t*)(ws + WS_WOUT) + (size_t)l * 1024 * 1024, 1024, T / 256, 4, c.G, c.bid};
            EpiOut e{l == 0 ? q.x : q.out, q.out, mod + 2 * 1024};
            GB_EpiOut<EpiOut::PERM>(c.lds, c.wid, g, sc, e); SEAM(sb + 5); }
        if (IN(sb + 6)) { PHASE_Q ph_ln1(q, c, l); SEAM(sb + 6); }
        if (IN(sb + 7)) {
            PHASE_Q
            GemmDesc g{(const GAS bf16_t*)(ws + WS_H), 1024, 1024, 1024};
            DenseSched sc{(const GAS bf16_t*)(ws + WS_WR) + (size_t)l * 256 * 1024, 1024, T / 256, 1, c.G, c.bid};
            EpiRouter e{(float*)(ws + WS_LOG)};
            GB_EpiRouter<EpiRouter::PERM>(c.lds, c.wid, g, sc, e); SEAM(sb + 7); }
        if (IN(sb + 8)) { PHASE_Q ph_route(q, c, l); SEAM(sb + 8); }
        if (IN(sb + 9)) {
            PHASE_Q
            moe_build_tiles(tp, (const int*)((unsigned*)(ws + WS_CTL) + CW_CNT + l * 64));
            GemmDesc g{(const GAS bf16_t*)(ws + WS_H), 1024, 1024, 1024};
            MoeSched sc{(const GAS bf16_t*)(ws + WS_WGU), (size_t)512 * 1024, 1024, (const GAS int*)(ws + WS_LIST), (const GAS int*)((unsigned*)(ws + WS_CTL) + CW_CNT + l * 64), tp, 2, c.G, c.bid, true};
            EpiSwiglu e{(bf16_t*)(ws + WS_ACT)};
            GB_EpiSwiglu<EpiSwiglu::PERM>(c.lds, c.wid, g, sc, e); SEAM(sb + 9); }
        if (IN(sb + 10)) {
            PHASE_Q
            moe_build_tiles(tp, (const int*)((unsigned*)(ws + WS_CTL) + CW_CNT + l * 64));
            GemmDesc g{(const GAS bf16_t*)(ws + WS_ACT), 256, 256, 256};
            MoeSched sc{(const GAS bf16_t*)(ws + WS_WD), (size_t)1024 * 256, 256, (const GAS int*)(ws + WS_LIST), (const GAS int*)((unsigned*)(ws + WS_CTL) + CW_CNT + l * 64), tp, 4, c.G, c.bid, false};
            EpiDown e{(bf16_t*)(ws + WS_Y)};
            GB_EpiDown<EpiDown::PERM>(c.lds, c.wid, g, sc, e); SEAM(sb + 10); }
        if (IN(sb + 11)) { PHASE_Q ph_combine(q, c, l); SEAM(sb + 11); }
    }
#undef IN
#undef SEAM
}

#ifndef MK_ONE_LAUNCH
#define MK_ONE_LAUNCH 1
#endif
extern "C" void kernel_launch(void* const* d_in, const int* in_sizes, int n_in, void* d_out, int out_size, void* d_ws, size_t ws_size, hipStream_t stream) {
    static int grid = 0;
    if (grid == 0) {
        if (n_in != 25 || out_size != T * D || ws_size < WS_END) { fprintf(stderr, "kernel_launch: unexpected shapes (n_in %d out %d ws %zu need %zu)\n", n_in, out_size, ws_size, (size_t)WS_END); grid = -1; return; }
        int dev = 0, cus = 0, per_cu = 0;
        if (hipGetDevice(&dev) != hipSuccess || hipDeviceGetAttribute(&cus, hipDeviceAttributeMultiprocessorCount, dev) != hipSuccess) { grid = -1; return; }
        if (hipFuncSetAttribute((const void*)mk_fwd, hipFuncAttributeMaxDynamicSharedMemorySize, LDS_BYTES) != hipSuccess) { fprintf(stderr, "kernel_launch: hipFuncSetAttribute failed\n"); grid = -1; return; }
        if (hipOccupancyMaxActiveBlocksPerMultiprocessor(&per_cu, (const void*)mk_fwd, NTHREADS, LDS_BYTES) != hipSuccess || per_cu < 1) { fprintf(stderr, "kernel_launch: occupancy query says %d\n", per_cu); }
        (void)hipGetLastError();
        grid = cus;
    }
    if (grid < 0) return;
    (void)hipMemsetAsync((char*)d_ws + WS_CTL, 0, CTL_BYTES, stream);
    Params p{};
    p.x = (const float*)d_in[0]; p.c = (const float*)d_in[1]; p.pos = (const int*)d_in[2];
    p.w_ada = (const float*)d_in[3]; p.b_ada = (const float*)d_in[4]; p.w_in = (const float*)d_in[5]; p.qg = (const float*)d_in[6]; p.kvg = (const float*)d_in[7];
    p.w_uq = (const float*)d_in[8]; p.w_ukv = (const float*)d_in[9]; p.w_pool = (const float*)d_in[10]; p.pool_scale = (const float*)d_in[11]; p.w_out = (const float*)d_in[12];
    p.ln1g = (const float*)d_in[13]; p.ln1b = (const float*)d_in[14]; p.w_router = (const float*)d_in[15]; p.rbias = (const float*)d_in[16];
    p.weg = (const float*)d_in[17]; p.weu = (const float*)d_in[18]; p.wed = (const float*)d_in[19]; p.wsg = (const float*)d_in[20]; p.wsu = (const float*)d_in[21]; p.wsd = (const float*)d_in[22];
    p.ln2g = (const float*)d_in[23]; p.ln2b = (const float*)d_in[24];
    p.out = (float*)d_out; p.ws = (unsigned char*)d_ws;
#if MK_ONE_LAUNCH
    hipLaunchKernelGGL(mk_fwd, dim3(grid), dim3(NTHREADS), LDS_BYTES, stream, p, 0, NSEG);
#else
    for (int s = 0; s < NSEG; ++s) hipLaunchKernelGGL(mk_fwd, dim3(grid), dim3(NTHREADS), LDS_BYTES, stream, p, s, s + 1);
#endif
}
```

```cpp
#include <hip/hip_runtime.h>
#include <stdint.h>
#include <cstdio>

#define LAS __attribute__((address_space(3)))
#define GAS __attribute__((address_space(1)))
typedef unsigned short bf16_t;
typedef short bf16x8 __attribute__((ext_vector_type(8)));
typedef float f32x4 __attribute__((ext_vector_type(4)));
typedef float f32x2 __attribute__((ext_vector_type(2)));
typedef unsigned u32x4 __attribute__((ext_vector_type(4)));
typedef unsigned u32x2 __attribute__((ext_vector_type(2)));

constexpr int D = 1024, NB = 16, S = 2048, T = NB * S, NL = 4;
constexpr int NE = 64, TOPK = 8, FE = 256, NH = 6;
constexpr int INW = 960;
constexpr int A_TOT = T * 9;
constexpr float ALPHA = 1.6817928305074290f;
constexpr float LN_EPS = 1e-5f, RMS_EPS = 1e-6f;
constexpr float QSCALE = 0.07216878364870322f * 1.4426950408889634f;
constexpr int NTHREADS = 512, NWAVES = 8;
constexpr int LDS_BYTES = 163840, LDS_MISC = 131072;
constexpr int PH_PER_LAYER = 12, NSEG = 1 + NL * PH_PER_LAYER;

constexpr size_t al256(size_t x) { return (x + 255) & ~(size_t)255; }
constexpr size_t WS_CTL = 0, CTL_BYTES = 1u << 20;
constexpr size_t CW_BAR = 4096;
constexpr size_t CW_CNT = 16384;
constexpr size_t WS_MOD = WS_CTL + CTL_BYTES;
constexpr size_t WS_CS = al256(WS_MOD + (size_t)NL * 16 * 6144 * 4);
constexpr size_t WS_RSQ = al256(WS_CS + (size_t)T * 32 * 8);
constexpr size_t WS_RSKV = al256(WS_RSQ + (size_t)T * 4);
constexpr size_t WS_WIN = al256(WS_RSKV + (size_t)T * 4);
constexpr size_t WS_WUQ = al256(WS_WIN + (size_t)NL * 1024 * 1024 * 2);
constexpr size_t WS_WUKV = al256(WS_WUQ + (size_t)NL * 1280 * 384 * 2);
constexpr size_t WS_WOUT = al256(WS_WUKV + (size_t)NL * 1536 * 256 * 2);
constexpr size_t WS_WR = al256(WS_WOUT + (size_t)NL * 1024 * 1024 * 2);
constexpr size_t WS_WGU = al256(WS_WR + (size_t)NL * 256 * 1024 * 2);
constexpr size_t WS_WD = al256(WS_WGU + (size_t)65 * 512 * 1024 * 2);
constexpr size_t WS_H = al256(WS_WD + (size_t)65 * 1024 * 256 * 2);
constexpr size_t WS_R = al256(WS_H + (size_t)T * 1024 * 2);
constexpr size_t WS_P = WS_R;
constexpr size_t WS_Q = al256(WS_P + (size_t)T * 1024 * 2);
constexpr size_t WS_KF = al256(WS_Q + (size_t)T * 1152 * 2);
constexpr size_t WS_V = al256(WS_KF + (size_t)T * 1152 * 2);
constexpr size_t WS_MIX = al256(WS_V + (size_t)T * 768 * 2);
constexpr size_t WS_MIX_END = al256(WS_MIX + (size_t)T * 1024 * 2);
constexpr size_t WS_ACT = WS_R;
constexpr size_t WS_LOG = al256(WS_ACT + (size_t)(A_TOT + 1) * 256 * 2);
constexpr size_t WS_TG = al256(WS_LOG + (size_t)T * 64 * 4);
constexpr size_t WS_LIST = al256(WS_TG + (size_t)T * 8 * 4);
constexpr size_t WS_Y = al256(WS_LIST + (size_t)65 * T * 4);
constexpr size_t WS_END = al256(WS_Y + (size_t)(A_TOT + 1) * 1024 * 2);
static_assert(WS_MIX_END <= WS_END && WS_END < 1000000000ull, "workspace map");

struct Params {
    const float *x, *c; const int* pos;
    const float *w_ada, *b_ada, *w_in, *qg, *kvg, *w_uq, *w_ukv, *w_pool, *pool_scale, *w_out, *ln1g, *ln1b, *w_router, *rbias;
    const float *weg, *weu, *wed, *wsg, *wsu, *wsd, *ln2g, *ln2b;
    float* out; unsigned char* ws;
};

__device__ __forceinline__ unsigned cvt_pk_bf16(float lo, float hi) { unsigned r; asm volatile("v_cvt_pk_bf16_f32 %0, %1, %2" : "=v"(r) : "v"(lo), "v"(hi)); return r; }
__device__ __forceinline__ float bf2f(bf16_t b) { return __uint_as_float(((unsigned)b) << 16); }
__device__ __forceinline__ float bflo(unsigned w) { return __uint_as_float(w << 16); }
__device__ __forceinline__ float bfhi(unsigned w) { return __uint_as_float(w & 0xffff0000u); }
#define SWZ_XOR(v, x) __int_as_float(__builtin_amdgcn_ds_swizzle(__float_as_int(v), ((x) << 10) | 0x1F))
__device__ __forceinline__ float wave_sum(float v) {
    v += SWZ_XOR(v, 1); v += SWZ_XOR(v, 2); v += SWZ_XOR(v, 4); v += SWZ_XOR(v, 8); v += SWZ_XOR(v, 16);
    const auto rr = __builtin_amdgcn_permlane32_swap(__float_as_uint(v), __float_as_uint(v), false, false);
    return __uint_as_float(rr[0]) + __uint_as_float(rr[1]);
}
__device__ __forceinline__ float wave_max(float v) {
    v = fmaxf(v, SWZ_XOR(v, 1)); v = fmaxf(v, SWZ_XOR(v, 2)); v = fmaxf(v, SWZ_XOR(v, 4)); v = fmaxf(v, SWZ_XOR(v, 8)); v = fmaxf(v, SWZ_XOR(v, 16));
    const auto rr = __builtin_amdgcn_permlane32_swap(__float_as_uint(v), __float_as_uint(v), false, false);
    return fmaxf(__uint_as_float(rr[0]), __uint_as_float(rr[1]));
}
__device__ __forceinline__ void store8_bf16(bf16_t* p, f32x4 a, f32x4 b) {
    u32x4 w; w.x = cvt_pk_bf16(a[0], a[1]); w.y = cvt_pk_bf16(a[2], a[3]); w.z = cvt_pk_bf16(b[0], b[1]); w.w = cvt_pk_bf16(b[2], b[3]);
    *(u32x4*)p = w;
}

__device__ __forceinline__ int fresh_lane() { int l; asm volatile("v_mbcnt_lo_u32_b32 %0, -1, 0\n\tv_mbcnt_hi_u32_b32 %0, -1, %0" : "=v"(l)); return l; }
template <class Tp> __device__ __forceinline__ Tp* launder(Tp* p) { asm volatile("" : "+s"(p)); return p; }
typedef __attribute__((address_space(4))) const Params CParams;
#if defined(__HIP_DEVICE_COMPILE__)
#define LOAD_Q CParams* kp_ = (CParams*)__builtin_amdgcn_kernarg_segment_ptr(); asm volatile("" : "+s"(kp_)); const Params q = *kp_;
#else
#define LOAD_Q const Params q = p;
#endif
#define PHASE_Q LOAD_Q unsigned char* ws = q.ws; (void)ws; \
    Ctx c = c0; asm volatile("" : "+s"(c.gw), "+s"(c.wid), "+s"(c.bid), "+s"(c.G), "+s"(c.ngw)); \
    c.lane = fresh_lane(); c.tid = c.wid * 64 + c.lane;

#define XB_TMO      128
#define XB_XCNT(j)  (256  + 64 * (j))
#define XB_XSUB(j)  (1280 + 64 * (j))
#define XB_XGEN(j)  (2304 + 64 * (j))
#define XB_TOP      3328
#define XB_TOPGEN   3392
#define XCD_BAR_WORDS 3456
#define XB_SPIN_CAP (1u << 20)
__device__ __forceinline__ unsigned xb_ld(unsigned* p)              { return __hip_atomic_load(p, __ATOMIC_RELAXED, __HIP_MEMORY_SCOPE_AGENT); }
__device__ __forceinline__ unsigned xb_add(unsigned* p, unsigned v) { return __hip_atomic_fetch_add(p, v, __ATOMIC_RELAXED, __HIP_MEMORY_SCOPE_AGENT); }
__device__ __forceinline__ unsigned xb_xcc_id() { return (unsigned)__builtin_amdgcn_s_getreg((3 << 11) | 20) & 0xFu; }
#define XB_SPIN(cond, bar) do { unsigned _sp = 0; while (cond) { __builtin_amdgcn_s_sleep(1); \
    if ((++_sp & 255u) == 0u) { if (xb_ld(&(bar)[XB_TMO])) break; if (_sp > XB_SPIN_CAP) { atomicAdd(&(bar)[XB_TMO], 1u); break; } } } } while (0)
struct XcdBarrier { unsigned* bar; unsigned x; volatile LAS unsigned* st; };
__device__ __forceinline__ XcdBarrier xcd_barrier_post(unsigned* bar, volatile LAS unsigned* st) {
    XcdBarrier b; b.bar = bar; b.x = xb_xcc_id(); b.st = st;
    if (threadIdx.x == 0) (void)xb_add(&bar[XB_XCNT(b.x)], 1u);
    return b;
}
__device__ __forceinline__ void xcd_barrier_complete(unsigned* bar, unsigned x, unsigned& nloc, unsigned& nx) {
    const unsigned G = gridDim.x * gridDim.y * gridDim.z;
    unsigned sum, cnt, mine, sp = 0u;
    for (;;) {
        sum = 0u; cnt = 0u; mine = 0u;
#pragma unroll
        for (unsigned j = 0; j < 16; ++j) { const unsigned c = xb_ld(&bar[XB_XCNT(j)]); sum += c; cnt += (c > 0u) ? 1u : 0u; mine = (j == x) ? c : mine; }
        if (sum == G) break;
        __builtin_amdgcn_s_sleep(1);
        if ((++sp & 255u) == 0u) { if (xb_ld(&bar[XB_TMO])) break; if (sp > XB_SPIN_CAP) { atomicAdd(&bar[XB_TMO], 1u); break; } }
    }
    nloc = mine > 0u ? mine : 1u; nx = cnt > 0u ? cnt : 1u;
}
__device__ __forceinline__ void xcd_barrier(const XcdBarrier& b) {
    asm volatile("s_waitcnt vmcnt(0)" ::: "memory");
    __syncthreads();
    if (threadIdx.x == 0) {
        unsigned* bar = b.bar;
        __builtin_amdgcn_s_waitcnt(0);
        unsigned nloc = b.st[0], nx = b.st[1];
        if (nloc == 0u) { xcd_barrier_complete(bar, b.x, nloc, nx); b.st[0] = nloc; b.st[1] = nx; }
        const unsigned old = xb_add(&bar[XB_XSUB(b.x)], 1u);
        const unsigned gen = old / nloc;
        if (old + 1u == (gen + 1u) * nloc) {
            __builtin_amdgcn_fence(__ATOMIC_RELEASE, "agent");
            asm volatile("s_waitcnt vmcnt(0)" ::: "memory");
            const unsigned og = xb_add(&bar[XB_TOP], 1u);
            const unsigned tg = og / nx;
            if (og + 1u == (tg + 1u) * nx) xb_add(&bar[XB_TOPGEN], 1u);
            else XB_SPIN(xb_ld(&bar[XB_TOPGEN]) == tg, bar);
            __builtin_amdgcn_fence(__ATOMIC_ACQUIRE, "agent");
            xb_add(&bar[XB_XGEN(b.x)], 1u);
            asm volatile("s_waitcnt vmcnt(0)" ::: "memory");
        } else {
            XB_SPIN(xb_ld(&bar[XB_XGEN(b.x)]) == gen, bar);
            __builtin_amdgcn_fence(__ATOMIC_ACQUIRE, "agent");
            asm volatile("s_waitcnt vmcnt(0)" ::: "memory");
        }
    }
    __syncthreads();
}

struct Unit { const GAS bf16_t* Bt; int pm, pn, e, base, cnt; };
struct GemmDesc { const GAS bf16_t* A; int lda, ldb, K; };
__device__ __forceinline__ int uni(int v) { return __builtin_amdgcn_readfirstlane(v); }

struct DenseSched {
    static constexpr bool GATHER = false;
    const GAS bf16_t* Bt; int ldb, nM, nN, G, c;
    __device__ __forceinline__ bool next(int i, Unit& u) const {
        const int Lx = uni(i * G + c); if (Lx >= nM * nN) return false;
        const int nig = 8 * nN, gid = Lx / nig, fm = gid * 8, gsz = (nM - fm) < 8 ? (nM - fm) : 8, w = Lx % nig;
        u.pm = fm + (w % gsz); u.pn = w / gsz; u.e = 0; u.base = u.pm * 256; u.cnt = 256;
        u.Bt = Bt + (size_t)u.pn * 256 * ldb; return true;
    }
    __device__ __forceinline__ int arow(const Unit& u, int r) const { return u.base + r; }
    __device__ __forceinline__ int orow(const Unit& u, int r) const { return u.base + r; }
};
struct MoeSched {
    static constexpr bool GATHER = true;
    const GAS bf16_t* W; size_t w_estride; int ldb; const GAS int* lists; const GAS int* cnt; const LAS int* tp; int nsub, G, c; bool up;
    __device__ __forceinline__ bool next(int i, Unit& u) const {
        const int Lx = uni(i * G + c), ntile = uni(tp[65]); if (Lx >= ntile * nsub) return false;
        int e = 0;
#pragma unroll 1
        for (int s = 32; s >= 1; s >>= 1) if (e + s <= 64 && uni(tp[e + s]) * nsub <= Lx) e += s;
        if (e < 64 && uni(tp[e + 1]) * nsub <= Lx) e += 1;
        const int tpe = uni(tp[e]), nt_e = uni(tp[e + 1]) - tpe, w = Lx - tpe * nsub, sub = w / nt_e, ti = w % nt_e;
        u.e = e; u.pn = sub; u.pm = ti; u.base = ti * 256; u.cnt = (e < 64) ? uni(cnt[e]) : T;
        u.Bt = W + (size_t)e * w_estride + (size_t)sub * 256 * ldb; return true;
    }
    __device__ __forceinline__ int asg(const Unit& u, int r) const {
        const int pos = u.base + r, pc = pos < u.cnt ? pos : u.cnt - 1;
        const int a = lists[(size_t)u.e * T + pc];
        return pos < u.cnt ? a : A_TOT;
    }
    __device__ __forceinline__ int arow(const Unit& u, int r) const {
        const int a = asg(u, r);
        if (!up) return a;
        const int sh = a - 8 * T;
        return a < 8 * T ? (a >> 3) : (sh < T ? sh : T - 1);
    }
    __device__ __forceinline__ int orow(const Unit& u, int r) const { return asg(u, r); }
};
__device__ __forceinline__ void moe_build_tiles(LAS int* tp, const int* cnt) {
    if (threadIdx.x == 0) { int s = 0; for (int e = 0; e < 64; ++e) { tp[e] = s; s += (cnt[e] + 255) >> 8; } tp[64] = s; tp[65] = s + T / 256; }
    __syncthreads();
}

template <bool PERM, class Sch, class Epi>
__device__ __forceinline__ void gemm_naive(LAS unsigned char* lds, int wid_in, const GemmDesc g, const Sch& Sc, const Epi& E) {
    const int tid = wid_in * 64 + fresh_lane(), wid = tid >> 6, lane = tid & 63, wr = wid >> 2, wc = wid & 3, fr = lane & 15, fq = lane >> 4;
    constexpr int LP = 260;
    LAS float* As = (LAS float*)lds; LAS float* Bs = As + 32 * LP;
    const int sr = tid >> 1, kh = tid & 1;
    Unit u;
    for (int i = 0; Sc.next(i, u); ++i) {
        f32x4 acc[2][2][4][2];
#pragma unroll
        for (int a = 0; a < 2; ++a)
#pragma unroll
            for (int b = 0; b < 2; ++b)
#pragma unroll
                for (int m = 0; m < 4; ++m)
#pragma unroll
                    for (int n = 0; n < 2; ++n) acc[a][b][m][n] = (f32x4){0.f, 0.f, 0.f, 0.f};
        const GAS bf16_t* ap = g.A + (size_t)Sc.arow(u, sr) * g.lda + kh * 16;
        const GAS bf16_t* bp = u.Bt + (size_t)sr * g.ldb + kh * 16;
        for (int k0 = 0; k0 < g.K; k0 += 32) {
            const u32x4 a0 = *(const GAS u32x4*)(ap + k0), a1 = *(const GAS u32x4*)(ap + k0 + 8);
            const u32x4 b0 = *(const GAS u32x4*)(bp + k0), b1 = *(const GAS u32x4*)(bp + k0 + 8);
            __syncthreads();
#pragma unroll
            for (int j = 0; j < 4; ++j) {
                As[(kh * 16 + 2 * j) * LP + sr] = bflo(a0[j]); As[(kh * 16 + 2 * j + 1) * LP + sr] = bfhi(a0[j]);
                As[(kh * 16 + 8 + 2 * j) * LP + sr] = bflo(a1[j]); As[(kh * 16 + 9 + 2 * j) * LP + sr] = bfhi(a1[j]);
                Bs[(kh * 16 + 2 * j) * LP + sr] = bflo(b0[j]); Bs[(kh * 16 + 2 * j + 1) * LP + sr] = bfhi(b0[j]);
                Bs[(kh * 16 + 8 + 2 * j) * LP + sr] = bflo(b1[j]); Bs[(kh * 16 + 9 + 2 * j) * LP + sr] = bfhi(b1[j]);
            }
            __syncthreads();
#pragma unroll 4
            for (int kk = 0; kk < 32; ++kk) {
                float av[2][4]; f32x4 bv[2][2];
#pragma unroll
                for (int ai = 0; ai < 2; ++ai)
#pragma unroll
                    for (int m = 0; m < 4; ++m) av[ai][m] = As[kk * LP + 128 * ai + 64 * wr + 16 * m + fr];
#pragma unroll
                for (int bj = 0; bj < 2; ++bj)
#pragma unroll
                    for (int n = 0; n < 2; ++n) bv[bj][n] = *(const LAS f32x4*)&Bs[kk * LP + 128 * bj + 32 * wc + (PERM ? 8 * fq + 4 * n : 16 * n + 4 * fq)];
#pragma unroll
                for (int ai = 0; ai < 2; ++ai)
#pragma unroll
                    for (int bj = 0; bj < 2; ++bj)
#pragma unroll
                        for (int m = 0; m < 4; ++m)
#pragma unroll
                            for (int n = 0; n < 2; ++n) acc[ai][bj][m][n] += bv[bj][n] * av[ai][m];
            }
        }
        E(acc, u, Sc, wr, wc, fr, fq);
    }
    __syncthreads();
}

constexpr int HTB = 128 * 64 * 2;
__device__ __forceinline__ int lds_byte(int r, int c) { const int st = (r >> 4) * 2 + (c >> 5), rr = r & 15, cc = c & 31, ob = rr * 64 + cc * 2; return st * 1024 + (ob ^ (((ob >> 9) & 1) << 5)); }
__device__ __forceinline__ void stage_rc(int b, int& R, int& C) { const int st = b / 1024, sb = b % 1024, swz = sb ^ (((sb >> 9) & 1) << 5); R = (st >> 1) * 16 + swz / 64; C = (st & 1) * 32 + (swz % 64) / 2; }
__device__ __forceinline__ int perm32(int rho) { const int n = rho >> 4, i = rho & 15; return 8 * (i >> 2) + 4 * n + (i & 3); }
template <class Sch> __device__ __forceinline__ void calc_voff(const Sch& Sc, const Unit& u, int tid, int lda, unsigned (&vo)[2][2]) {
#pragma unroll
    for (int i = 0; i < 2; ++i) { int R, C; stage_rc(tid * 16 + i * 8192, R, C);
#pragma unroll
        for (int h = 0; h < 2; ++h) vo[h][i] = (unsigned)(Sc.arow(u, h * 128 + R) * lda + C) * 2u; }
}
template <bool PERM, class Sch, class Epi>
__device__ __forceinline__ void gemm_mfma(LAS unsigned char* lds, int wid_in, const GemmDesc g, const Sch& Sc, const Epi& E) {
    constexpr bool GA = Sch::GATHER;
    const int wid = __builtin_amdgcn_readfirstlane(wid_in), lane = fresh_lane(), tid = wid * 64 + lane, wr = wid >> 2, wc = wid & 3, fr = lane & 15, fq = lane >> 4;
    const int nt = g.K / 64;
    unsigned voffB[2], va[2];
#pragma unroll
    for (int i = 0; i < 2; ++i) { int R, C; stage_rc(tid * 16 + i * 8192, R, C); const int Rb = PERM ? ((R & ~31) + perm32(R & 31)) : R; voffB[i] = (unsigned)(Rb * g.ldb + C) * 2u; va[i] = (unsigned)(R * g.lda + C) * 2u; }
    const unsigned hstepB = (unsigned)(128 * g.ldb * 2), hstepA = (unsigned)(128 * g.lda * 2);
    const unsigned ldsw = (unsigned)wid * 1024u;
    const int aoff = lds_byte(wr * 64 + fr, fq * 8), boff = lds_byte(wc * 32 + fr, fq * 8);
    const GAS char* gA = (const GAS char*)g.A;
    LAS u32x4* nslot = (LAS u32x4*)(lds + LDS_MISC + 4096) + tid;
#define G_SA(b, h) (((b) * 2 + (h)) * HTB)
#define G_SB(b, h) ((4 + (b) * 2 + (h)) * HTB)
#define G_STAGE_A(bufoff, h, kb) do { const GAS char* _sb = GA ? (gA + (size_t)(kb)) : (uA + (size_t)(((h) ? hstepA : 0u) + (kb)));     \
        _Pragma("unroll") for (int _i = 0; _i < 2; ++_i) { \
        const GAS char* _p = _sb + (GA ? cvo[h][_i] : va[_i]); \
        __builtin_amdgcn_global_load_lds((const GAS unsigned*)_p, (LAS unsigned*)(lds + (bufoff) + ldsw + _i * 8192), 16, 0, 0); } } while (0)
#define G_STAGE_B(bufoff, bp) do { _Pragma("unroll") for (int _i = 0; _i < 2; ++_i) \
        __builtin_amdgcn_global_load_lds((const GAS unsigned*)((bp) + voffB[_i]), (LAS unsigned*)(lds + (bufoff) + ldsw + _i * 8192), 16, 0, 0); } while (0)
#define G_LDA(dst, b, h) do { _Pragma("unroll") for (int m = 0; m < 4; ++m) _Pragma("unroll") for (int k = 0; k < 2; ++k) dst[m][k] = *(const LAS bf16x8*)(lds + G_SA(b, h) + aoff + m * 2048 + k * 1024); } while (0)
#define G_LDB(dst, b, h) do { _Pragma("unroll") for (int n = 0; n < 2; ++n) _Pragma("unroll") for (int k = 0; k < 2; ++k) dst[n][k] = *(const LAS bf16x8*)(lds + G_SB(b, h) + boff + n * 2048 + k * 1024); } while (0)
#define G_MMA(ai, bj, At, Bt) do { __builtin_amdgcn_s_setprio(1); _Pragma("unroll") for (int m = 0; m < 4; ++m) _Pragma("unroll") for (int n = 0; n < 2; ++n) _Pragma("unroll") for (int k = 0; k < 2; ++k) \
        acc[ai][bj][m][n] = __builtin_amdgcn_mfma_f32_16x16x32_bf16(Bt[n][k], At[m][k], acc[ai][bj][m][n], 0, 0, 0); __builtin_amdgcn_s_setprio(0); } while (0)
#define G_WAIT_V(n) asm volatile("s_waitcnt vmcnt(" #n ")" ::: "memory")
#define G_WAIT_L(n) asm volatile("s_waitcnt lgkmcnt(" #n ")" ::: "memory")
#define G_BAR __builtin_amdgcn_s_barrier()
#define G_SCHED __builtin_amdgcn_sched_barrier(0)
    Unit cur, nxt; int ui = 0;
    if (!Sc.next(0, cur)) return;
    f32x4 acc[2][2][4][2];
#pragma unroll
    for (int a = 0; a < 2; ++a)
#pragma unroll
        for (int b = 0; b < 2; ++b)
#pragma unroll
            for (int m = 0; m < 4; ++m)
#pragma unroll
                for (int n = 0; n < 2; ++n) acc[a][b][m][n] = (f32x4){0.f, 0.f, 0.f, 0.f};
    bf16x8 At[4][2], B0[2][2], B1[2][2];
    unsigned cvo[2][2] = {{0u, 0u}, {0u, 0u}};
    const GAS char* uA = gA;
    bool has_next = Sc.next(1, nxt);
    if constexpr (GA) {
        calc_voff(Sc, cur, tid, g.lda, cvo);
        unsigned nv[2][2];
        if (has_next) calc_voff(Sc, nxt, tid, g.lda, nv);
        *nslot = has_next ? (u32x4){nv[0][0], nv[0][1], nv[1][0], nv[1][1]} : (u32x4){cvo[0][0], cvo[0][1], cvo[1][0], cvo[1][1]};
    } else {
        uA = gA + (size_t)Sc.arow(cur, 0) * g.lda * 2;
    }
    const GAS char* cB = (const GAS char*)cur.Bt;
    G_STAGE_B(G_SB(0, 0), cB); G_STAGE_A(G_SA(0, 0), 0, 0u); G_STAGE_B(G_SB(0, 1), cB + hstepB); G_STAGE_A(G_SA(0, 1), 1, 0u);
    if (wr == 1) G_BAR;
    G_WAIT_V(4); G_BAR;
    G_STAGE_B(G_SB(1, 0), cB + 128); G_STAGE_A(G_SA(1, 0), 0, 128u); G_STAGE_B(G_SB(1, 1), cB + hstepB + 128);
    G_WAIT_V(6); G_BAR;
    for (;;) {
        const GAS char* nB = has_next ? (const GAS char*)nxt.Bt : cB;
        const GAS char* nA = (!GA && has_next) ? gA + (size_t)Sc.arow(nxt, 0) * g.lda * 2 : uA;
        for (int t = 0; t < nt; t += 2) {
            const bool last = (t == nt - 2);
            const unsigned k1 = (unsigned)(t + 1) * 128u, k2 = last ? 0u : (unsigned)(t + 2) * 128u, k3 = k2 + 128u;
            const GAS char* b2 = last ? nB : cB + (size_t)(t + 2) * 128; const GAS char* b3 = b2 + 128;
            G_LDB(B0, 0, 0); G_SCHED; G_LDA(At, 0, 0); G_STAGE_A(G_SA(1, 1), 1, k1);
            if (last) {
                if constexpr (GA) { const u32x4 nv = *nslot; cvo[0][0] = nv[0]; cvo[0][1] = nv[1]; cvo[1][0] = nv[2]; cvo[1][1] = nv[3]; }
                else uA = nA;
            }
            G_WAIT_L(8); G_BAR; G_WAIT_L(0); G_MMA(0, 0, At, B0); G_BAR; G_SCHED;
            G_LDB(B1, 0, 1); G_STAGE_B(G_SB(0, 0), b2);
            G_BAR; G_WAIT_L(0); G_MMA(0, 1, At, B1); G_BAR;
            G_LDA(At, 0, 1); G_STAGE_A(G_SA(0, 0), 0, k2);
            G_BAR; G_WAIT_L(0); G_MMA(1, 0, At, B0); G_BAR; G_SCHED;
            G_STAGE_B(G_SB(0, 1), b2 + hstepB);
            G_WAIT_V(6); G_BAR; G_MMA(1, 1, At, B1); G_BAR;
            G_LDB(B0, 1, 0); G_SCHED; G_LDA(At, 1, 0); G_STAGE_A(G_SA(0, 1), 1, k2);
            G_WAIT_L(8); G_BAR; G_WAIT_L(0); G_MMA(0, 0, At, B0); G_BAR; G_SCHED;
            G_LDB(B1, 1, 1); G_STAGE_B(G_SB(1, 0), b3);
            G_BAR; G_WAIT_L(0); G_MMA(0, 1, At, B1); G_BAR;
            G_LDA(At, 1, 1); G_STAGE_A(G_SA(1, 0), 0, k3);
            G_BAR; G_WAIT_L(0); G_MMA(1, 0, At, B0); G_BAR; G_SCHED;
            G_STAGE_B(G_SB(1, 1), b3 + hstepB);
            G_WAIT_V(6); G_BAR; G_MMA(1, 1, At, B1); G_BAR;
        }
        { const int l2 = fresh_lane();
          E(acc, cur, Sc, wr, wc, l2 & 15, l2 >> 4); }
        if (!has_next) break;
        cur = nxt; cB = nB; ++ui;
        has_next = Sc.next(ui + 1, nxt);
        if constexpr (GA) {
            if (has_next) { const int tid2 = wid * 64 + fresh_lane(); unsigned nv[2][2]; calc_voff(Sc, nxt, tid2, g.lda, nv); *nslot = (u32x4){nv[0][0], nv[0][1], nv[1][0], nv[1][1]}; }
        }
#pragma unroll
        for (int a = 0; a < 2; ++a)
#pragma unroll
            for (int b = 0; b < 2; ++b)
#pragma unroll
                for (int m = 0; m < 4; ++m)
#pragma unroll
                    for (int n = 0; n < 2; ++n) acc[a][b][m][n] = (f32x4){0.f, 0.f, 0.f, 0.f};
    }
    G_WAIT_V(0);
    if (wr == 0) G_BAR;
    G_BAR;
#undef G_SA
#undef G_SB
#undef G_STAGE_A
#undef G_STAGE_B
#undef G_LDA
#undef G_LDB
#undef G_MMA
#undef G_WAIT_V
#undef G_WAIT_L
#undef G_BAR
#undef G_SCHED
}

#define EPI_ROWS(ai, m) (128 * (ai) + 64 * wr + 16 * (m) + fr)
struct EpiP {
    static constexpr bool PERM = true;
    bf16_t* P;
    template <class Sch> __device__ __forceinline__ void operator()(const f32x4 (&acc)[2][2][4][2], const Unit& u, const Sch& Sc, int wr, int wc, int fr, int fq) const {
#pragma unroll
        for (int ai = 0; ai < 2; ++ai)
#pragma unroll
            for (int m = 0; m < 4; ++m) { bf16_t* rp = P + (size_t)Sc.orow(u, EPI_ROWS(ai, m)) * 1024 + u.pn * 256 + 32 * wc + 8 * fq;
#pragma unroll
                for (int bj = 0; bj < 2; ++bj) store8_bf16(rp + 128 * bj, acc[ai][bj][m][0], acc[ai][bj][m][1]); asm volatile("" ::: "memory"); }
    }
};
struct EpiQ {
    static constexpr bool PERM = true;
    bf16_t* Q; const float* rsq; const f32x2* cs;
    template <class Sch> __device__ __forceinline__ void operator()(const f32x4 (&acc)[2][2][4][2], const Unit& u, const Sch& Sc, int wr, int wc, int fr, int fq) const {
#pragma unroll
        for (int ai = 0; ai < 2; ++ai)
#pragma unroll
            for (int m = 0; m < 4; ++m) {
                const int row = Sc.orow(u, EPI_ROWS(ai, m)); const float rs = rsq[row];
                if (u.pn < 3) {
#pragma unroll
                    for (int bj = 0; bj < 2; ++bj) store8_bf16(Q + (size_t)row * 1152 + (2 * u.pn + bj) * 192 + 32 * wc + 8 * fq, acc[ai][bj][m][0] * rs, acc[ai][bj][m][1] * rs);
                } else {
                    const int head = (u.pn == 3) ? wc : 4 + wc;
                    if (head < NH) {
                        const f32x2* cp = cs + (size_t)row * 32 + 8 * fq;
                        f32x4 lo[2], hi[2];
#pragma unroll
                        for (int n = 0; n < 2; ++n)
#pragma unroll
                            for (int j = 0; j < 4; ++j) { const f32x2 c = cp[4 * n + j]; const float x1 = acc[ai][0][m][n][j], x2 = acc[ai][1][m][n][j];
                                lo[n][j] = (x1 * c.x - x2 * c.y) * rs; hi[n][j] = (x2 * c.x + x1 * c.y) * rs; }
                        bf16_t* qp = Q + (size_t)row * 1152 + head * 192 + 128 + 8 * fq;
                        store8_bf16(qp, lo[0], lo[1]); store8_bf16(qp + 32, hi[0], hi[1]);
                    }
                }
            }
    }
};
struct EpiKV {
    static constexpr bool PERM = true;
    bf16_t* Kf; bf16_t* V; const float* rskv;
    template <class Sch> __device__ __forceinline__ void operator()(const f32x4 (&acc)[2][2][4][2], const Unit& u, const Sch& Sc, int wr, int wc, int fr, int fq) const {
#pragma unroll
        for (int ai = 0; ai < 2; ++ai)
#pragma unroll
            for (int m = 0; m < 4; ++m) {
                const int row = Sc.orow(u, EPI_ROWS(ai, m)); const float rs = rskv[row];
                store8_bf16(Kf + (size_t)row * 1152 + u.pn * 192 + 32 * wc + 8 * fq, acc[ai][0][m][0] * rs, acc[ai][0][m][1] * rs);
                store8_bf16(V + (size_t)row * 768 + u.pn * 128 + 32 * wc + 8 * fq, acc[ai][1][m][0] * rs, acc[ai][1][m][1] * rs);
            asm volatile("" ::: "memory"); }
    }
};
struct EpiOut {
    static constexpr bool PERM = false;
    const float* xin; float* y; const float* g1;
    template <class Sch> __device__ __forceinline__ void operator()(const f32x4 (&acc)[2][2][4][2], const Unit& u, const Sch& Sc, int wr, int wc, int fr, int fq) const {
        const int b = (u.pm * 256) / S; const int col0 = u.pn * 256 + 32 * wc + 4 * fq;
        f32x4 gv[2][2];
#pragma unroll
        for (int bj = 0; bj < 2; ++bj)
#pragma unroll
            for (int n = 0; n < 2; ++n) gv[bj][n] = *(const f32x4*)(g1 + (size_t)b * 6144 + col0 + 128 * bj + 16 * n);
#pragma unroll
        for (int ai = 0; ai < 2; ++ai)
#pragma unroll
            for (int m = 0; m < 4; ++m) { const size_t off = (size_t)Sc.orow(u, EPI_ROWS(ai, m)) * 1024 + col0;
#pragma unroll
                for (int bj = 0; bj < 2; ++bj)
#pragma unroll
                    for (int n = 0; n < 2; ++n) { const f32x4 xv = *(const f32x4*)(xin + off + 128 * bj + 16 * n);
                        *(f32x4*)(y + off + 128 * bj + 16 * n) = xv * ALPHA + gv[bj][n] * acc[ai][bj][m][n]; } asm volatile("" ::: "memory"); }
    }
};
struct EpiRouter {
    static constexpr bool PERM = false;
    float* logits;
    template <class Sch> __device__ __forceinline__ void operator()(const f32x4 (&acc)[2][2][4][2], const Unit& u, const Sch& Sc, int wr, int wc, int fr, int fq) const {
        if (wc < 2) {
#pragma unroll
            for (int ai = 0; ai < 2; ++ai)
#pragma unroll
                for (int m = 0; m < 4; ++m) { float* rp = logits + (size_t)Sc.orow(u, EPI_ROWS(ai, m)) * 64 + 32 * wc + 4 * fq;
#pragma unroll
                    for (int n = 0; n < 2; ++n) *(f32x4*)(rp + 16 * n) = acc[ai][0][m][n]; }
        }
    }
};
struct EpiSwiglu {
    static constexpr bool PERM = true;
    bf16_t* act;
    template <class Sch> __device__ __forceinline__ void operator()(const f32x4 (&acc)[2][2][4][2], const Unit& u, const Sch& Sc, int wr, int wc, int fr, int fq) const {
#pragma unroll
        for (int ai = 0; ai < 2; ++ai)
#pragma unroll
            for (int m = 0; m < 4; ++m) { f32x4 o[2];
#pragma unroll
                for (int n = 0; n < 2; ++n)
#pragma unroll
                    for (int j = 0; j < 4; ++j) { const float gt = acc[ai][0][m][n][j], up = acc[ai][1][m][n][j]; o[n][j] = gt / (1.f + __expf(-gt)) * up; }
                store8_bf16(act + (size_t)Sc.orow(u, EPI_ROWS(ai, m)) * 256 + u.pn * 128 + 32 * wc + 8 * fq, o[0], o[1]); asm volatile("" ::: "memory"); }
    }
};
struct EpiDown {
    static constexpr bool PERM = true;
    bf16_t* Y;
    template <class Sch> __device__ __forceinline__ void operator()(const f32x4 (&acc)[2][2][4][2], const Unit& u, const Sch& Sc, int wr, int wc, int fr, int fq) const {
#pragma unroll
        for (int ai = 0; ai < 2; ++ai)
#pragma unroll
            for (int m = 0; m < 4; ++m) { bf16_t* rp = Y + (size_t)Sc.orow(u, EPI_ROWS(ai, m)) * 1024 + u.pn * 256 + 32 * wc + 8 * fq;
#pragma unroll
                for (int bj = 0; bj < 2; ++bj) store8_bf16(rp + 128 * bj, acc[ai][bj][m][0], acc[ai][bj][m][1]); asm volatile("" ::: "memory"); }
    }
};

__device__ __forceinline__ void xpose_item(const float* src, int ld, bf16_t* dst, int Kdst, const float* kscale  , float mul, LAS float* scr, int lane) {
#pragma unroll 8
    for (int i = 0; i < 32; ++i) { const int kk = 2 * i + (lane >> 5); float v = src[(size_t)kk * ld + (lane & 31)]; if (kscale) v *= kscale[kk]; scr[kk * 33 + (lane & 31)] = v * mul; }
    asm volatile("s_waitcnt lgkmcnt(0)" ::: "memory");
    const int c = lane & 7;
#pragma unroll
    for (int j = 0; j < 4; ++j) { const int n = (lane >> 3) + 8 * j; const LAS float* s = scr + (8 * c) * 33 + n;
        u32x4 o; o.x = cvt_pk_bf16(s[0 * 33], s[1 * 33]); o.y = cvt_pk_bf16(s[2 * 33], s[3 * 33]); o.z = cvt_pk_bf16(s[4 * 33], s[5 * 33]); o.w = cvt_pk_bf16(s[6 * 33], s[7 * 33]);
        *(u32x4*)(dst + (size_t)n * Kdst + 8 * c) = o; }
    asm volatile("s_waitcnt lgkmcnt(0)" ::: "memory");
}
__device__ __forceinline__ void zero_rows(bf16_t* dst, size_t nelem, int gw, int ngw, int lane) {
    for (size_t i = ((size_t)gw * 64 + lane) * 8; i < nelem; i += (size_t)ngw * 64 * 8) *(u32x4*)(dst + i) = (u32x4){0u, 0u, 0u, 0u};
}
__device__ __forceinline__ int uq_srccol(int g) {
    const int n = 32 * g;
    if (n < 768) return (n / 128) * 192 + (n % 128);
    if (n < 1024) { const int q = n - 768, half = q / 128, hh = (q % 128) / 32; return hh * 192 + 128 + half * 32; }
    { const int q = n - 1024, half = q / 128, w = q % 128; if (w >= 64) return -1; return (4 + w / 32) * 192 + 128 + half * 32; }
}

struct Ctx { LAS unsigned char* lds; int tid, lane, wid, gw, ngw, G, bid; };

__device__ __forceinline__ void ph_prologue(const Params& p, const Ctx& c) {
    unsigned char* ws = p.ws;
    float* mod = (float*)(ws + WS_MOD);
    {
        LAS float* cond = (LAS float*)c.lds;
        LAS float* red = cond + 16 * 1024;
        for (int i = c.tid; i < 16 * 1024; i += NTHREADS) { const float v = p.c[i]; cond[i] = v / (1.f + __expf(-v)); }
        __syncthreads();
        const int nc = c.tid & 127, kq = c.tid >> 7;
        for (int u = c.bid; u < NL * 48; u += c.G) {
            const int l = u / 48, n0 = (u % 48) * 128;
            float acc[16];
#pragma unroll
            for (int b = 0; b < 16; ++b) acc[b] = 0.f;
            const float* wp = p.w_ada + ((size_t)l * 1024 + kq * 256) * 6144 + n0 + nc;
#pragma unroll 4
            for (int k = 0; k < 256; ++k) { const float w = wp[(size_t)k * 6144];
#pragma unroll
                for (int b = 0; b < 16; ++b) acc[b] += cond[b * 1024 + kq * 256 + k] * w; }
#pragma unroll
            for (int b = 0; b < 16; ++b) red[(kq * 16 + b) * 128 + nc] = acc[b];
            __syncthreads();
            for (int o = c.tid; o < 2048; o += NTHREADS) { const int b = o >> 7, n = o & 127;
                mod[((size_t)l * 16 + b) * 6144 + n0 + n] = red[(0 * 16 + b) * 128 + n] + red[(1 * 16 + b) * 128 + n] + red[(2 * 16 + b) * 128 + n] + red[(3 * 16 + b) * 128 + n] + p.b_ada[l * 6144 + n0 + n]; }
            __syncthreads();
        }
    }
    {
        f32x2* cs = (f32x2*)(ws + WS_CS);
        for (int i = c.bid * NTHREADS + c.tid; i < T * 32; i += c.G * NTHREADS) {
            const int t = i >> 5, k = i & 31; const float inv = powf(10000.f, -(float)k / 32.f); const float ang = (float)p.pos[t] * inv;
            float sn, cn; sincosf(ang, &sn, &cn); cs[i] = (f32x2){cn, sn};
        }
    }
    {
        LAS float* scr = (LAS float*)(c.lds + c.wid * 16384);
        bf16_t* WinT = (bf16_t*)(ws + WS_WIN); bf16_t* WuqT = (bf16_t*)(ws + WS_WUQ); bf16_t* WukvT = (bf16_t*)(ws + WS_WUKV);
        bf16_t* WoutT = (bf16_t*)(ws + WS_WOUT); bf16_t* WrT = (bf16_t*)(ws + WS_WR);
        constexpr int I_IN = 30 * 16, I_UQ = 40 * 6, I_UKV = 48 * 4, I_OUT = 32 * 16, I_R = 2 * 16, I_L = I_IN + I_UQ + I_UKV + I_OUT + I_R;
        for (int it = c.gw; it < NL * I_L; it += c.ngw) {
            const int l = it / I_L; int r = it % I_L;
            if (r < I_IN) { const int g = r / 16, kb = r % 16; xpose_item(p.w_in + ((size_t)l * 1024 + 64 * kb) * INW + 32 * g, INW, WinT + ((size_t)l * 1024 + 32 * g) * 1024 + 64 * kb, 1024, nullptr, 1.f, scr, c.lane); continue; } r -= I_IN;
            if (r < I_UQ) { const int g = r / 6, kb = r % 6, sc = uq_srccol(g); bf16_t* dst = WuqT + ((size_t)l * 1280 + 32 * g) * 384 + 64 * kb;
                if (sc >= 0) xpose_item(p.w_uq + ((size_t)l * 384 + 64 * kb) * 1152 + sc, 1152, dst, 384, p.qg + l * 384 + 64 * kb, QSCALE, scr, c.lane);
                else { const int n = c.lane >> 1, h8 = (c.lane & 1) * 32; for (int q = 0; q < 4; ++q) *(u32x4*)(dst + (size_t)n * 384 + h8 + 8 * q) = (u32x4){0u, 0u, 0u, 0u}; }
                continue; } r -= I_UQ;
            if (r < I_UKV) { const int g = r / 4, kb = r % 4; xpose_item(p.w_ukv + ((size_t)l * 256 + 64 * kb) * 1536 + 32 * g, 1536, WukvT + ((size_t)l * 1536 + 32 * g) * 256 + 64 * kb, 256, p.kvg + l * 256 + 64 * kb, 1.f, scr, c.lane); continue; } r -= I_UKV;
            if (r < I_OUT) { const int g = r / 16, kb = r % 16; xpose_item(p.w_out + ((size_t)l * 1024 + 64 * kb) * 1024 + 32 * g, 1024, WoutT + ((size_t)l * 1024 + 32 * g) * 1024 + 64 * kb, 1024, nullptr, 1.f, scr, c.lane); continue; } r -= I_OUT;
            { const int g = r / 16, kb = r % 16; xpose_item(p.w_router + ((size_t)l * 1024 + 64 * kb) * 64 + 32 * g, 64, WrT + ((size_t)l * 256 + 32 * g) * 1024 + 64 * kb, 1024, nullptr, 1.f, scr, c.lane); }
        }
        for (int l = 0; l < NL; ++l) {
            zero_rows(WinT + ((size_t)l * 1024 + 960) * 1024, (size_t)64 * 1024, c.gw, c.ngw, c.lane);
            zero_rows(WrT + ((size_t)l * 256 + 64) * 1024, (size_t)192 * 1024, c.gw, c.ngw, c.lane);
        }
    }
}

__device__ __forceinline__ void write_mod_row(const f32x4 (&v)[4], const float* sh, const float* sc, bf16_t* hrow, int lane) {
#pragma unroll
    for (int j = 0; j < 4; ++j) { const f32x4 s1 = *(const f32x4*)(sc + 4 * lane + 256 * j), s0 = *(const f32x4*)(sh + 4 * lane + 256 * j);
        const f32x4 o = v[j] * (s1 + 1.f) + s0; u32x2 w; w.x = cvt_pk_bf16(o[0], o[1]); w.y = cvt_pk_bf16(o[2], o[3]);
        *(u32x2*)(hrow + 4 * lane + 256 * j) = w; }
}

__device__ __forceinline__ void ph_prep(const Params& p, const Ctx& c, int l) {
    unsigned char* ws = p.ws;
    LAS float* scr = (LAS float*)(c.lds + c.wid * 16384);
    bf16_t* Wgu = (bf16_t*)(ws + WS_WGU); bf16_t* Wd = (bf16_t*)(ws + WS_WD);
    constexpr int I_GU = 16 * 16, I_D = 32 * 4, I_E = I_GU + I_D;
    for (int it = c.gw; it < 65 * I_E; it += c.ngw) {
        const int e = it / I_E; int r = it % I_E;
        if (r < I_GU) { const int g = r / 16, kb = r % 16, r0 = 32 * g, cb = r0 >> 8, half = (r0 >> 7) & 1, c0 = cb * 128 + (r0 & 127);
            const float* src = (e < 64) ? ((half ? p.weu : p.weg) + ((size_t)(l * 64 + e) * 1024) * 256) : ((half ? p.wsu : p.wsg) + (size_t)l * 1024 * 256);
            xpose_item(src + (size_t)(64 * kb) * 256 + c0, 256, Wgu + ((size_t)e * 512 + r0) * 1024 + 64 * kb, 1024, nullptr, 1.f, scr, c.lane);
        } else { r -= I_GU; const int g = r / 4, kb = r % 4;
            const float* src = (e < 64) ? (p.wed + ((size_t)(l * 64 + e) * 256) * 1024) : (p.wsd + (size_t)l * 256 * 1024);
            xpose_item(src + (size_t)(64 * kb) * 1024 + 32 * g, 1024, Wd + ((size_t)e * 1024 + 32 * g) * 256 + 64 * kb, 256, nullptr, 1.f, scr, c.lane);
        }
    }
    if (l == 0) {
        const float* mod = (const float*)(ws + WS_MOD); bf16_t* H = (bf16_t*)(ws + WS_H);
        for (int t = c.gw; t < T; t += c.ngw) { const int b = t / S; f32x4 v[4];
#pragma unroll
            for (int j = 0; j < 4; ++j) v[j] = *(const f32x4*)(p.x + (size_t)t * 1024 + 4 * c.lane + 256 * j);
            write_mod_row(v, mod + (size_t)b * 6144 + 0, mod + (size_t)b * 6144 + 1024, H + (size_t)t * 1024, c.lane); }
    }
}

__device__ __forceinline__ void ph_post_in(const Params& p, const Ctx& c, int l) {
    unsigned char* ws = p.ws;
    const bf16_t* P = (const bf16_t*)(ws + WS_P); bf16_t* Kf = (bf16_t*)(ws + WS_KF); bf16_t* MIX = (bf16_t*)(ws + WS_MIX);
    float* rsq = (float*)(ws + WS_RSQ); float* rskv = (float*)(ws + WS_RSKV); const f32x2* cs = (const f32x2*)(ws + WS_CS);
    LAS float* wp = (LAS float*)c.lds;
    for (int i = c.tid; i < 4 * 64 * 64; i += NTHREADS) wp[i] = p.w_pool[(size_t)l * 16384 + i];
    __syncthreads();
    const int lane = c.lane;
    for (int t = c.gw; t < T; t += c.ngw) {
        const bf16_t* row = P + (size_t)t * 1024;
        { const unsigned* q32 = (const unsigned*)(row + 256) + lane * 3; float s = 0.f;
#pragma unroll
            for (int j = 0; j < 3; ++j) { const unsigned w = q32[j]; const float a = bflo(w), b = bfhi(w); s += a * a + b * b; }
            s = wave_sum(s); if (lane == 0) rsq[t] = 1.0f / sqrtf(s * (1.f / 384.f) + RMS_EPS); }
        { const u32x2 w = *((const u32x2*)(row + 640) + lane); const float a = bflo(w.x), b = bfhi(w.x), c2 = bflo(w.y), d2 = bfhi(w.y);
            float s = a * a + b * b + c2 * c2 + d2 * d2; s = wave_sum(s); if (lane == 0) rskv[t] = 1.0f / sqrtf(s * (1.f / 256.f) + RMS_EPS); }
        if (lane < 32) { const float x1 = bf2f(row[896 + lane]), x2 = bf2f(row[928 + lane]); const f32x2 cc = cs[(size_t)t * 32 + lane];
            const unsigned o = cvt_pk_bf16(x1 * cc.x - x2 * cc.y, x2 * cc.x + x1 * cc.y);
#pragma unroll
            for (int h = 0; h < NH; ++h) { bf16_t* kp = Kf + (size_t)t * 1152 + h * 192 + 128; kp[lane] = (bf16_t)(o & 0xffffu); kp[32 + lane] = (bf16_t)(o >> 16); } }
        const int s = t % S;
        float tm[4];
#pragma unroll
        for (int g = 0; g < 4; ++g) { const int w = 2 << g, cnt = (s + 1 < w) ? s + 1 : w; float sum = 0.f;
            for (int j = 0; j < cnt; ++j) sum += bf2f(P[(size_t)(t - j) * 1024 + 64 * g + lane]);
            tm[g] = sum / (float)cnt - bf2f(row[64 * g + lane]); }
#pragma unroll
        for (int g = 0; g < 4; ++g) { float o = 0.f;
            for (int cc = 0; cc < 64; ++cc) o += __int_as_float(__builtin_amdgcn_readlane(__float_as_int(tm[g]), cc)) * wp[(g * 64 + cc) * 64 + lane];
            o *= p.pool_scale[l * 256 + 64 * g + lane];
            MIX[(size_t)t * 1024 + 64 * g + lane] = (bf16_t)(cvt_pk_bf16(o, 0.f) & 0xffffu); }
    }
}

__device__ __forceinline__ void ph_attn_naive(const Params& p, const Ctx& c) {
    unsigned char* ws = p.ws;
    const bf16_t* Q = (const bf16_t*)(ws + WS_Q); const bf16_t* Kf = (const bf16_t*)(ws + WS_KF); const bf16_t* V = (const bf16_t*)(ws + WS_V); bf16_t* MIX = (bf16_t*)(ws + WS_MIX);
    LAS float* qs = (LAS float*)(c.lds + c.wid * 8192);
    const int lane = c.lane;
    for (int item = c.bid; item < 96 * 32; item += c.G) {
        const int bh = item % 96, qb = 31 - item / 96, b = bh / NH, h = bh % NH;
        const int q0 = qb * 64 + c.wid * 8;
        for (int i = lane; i < 8 * 192; i += 64) { const int r = i / 192, d = i % 192; qs[i] = bf2f(Q[(size_t)(b * S + q0 + r) * 1152 + h * 192 + d]); }
        asm volatile("s_waitcnt lgkmcnt(0)" ::: "memory");
        float m[8], lsum[8], o0[8], o1[8];
#pragma unroll
        for (int r = 0; r < 8; ++r) { m[r] = -1e30f; lsum[r] = 0.f; o0[r] = 0.f; o1[r] = 0.f; }
        const int last = q0 + 7, nch = last / 64 + 1;
        for (int ch = 0; ch < nch; ++ch) {
            const int key = ch * 64 + lane; float sc[8];
#pragma unroll
            for (int r = 0; r < 8; ++r) sc[r] = 0.f;
            if (key <= last) {
                const bf16_t* kp = Kf + (size_t)(b * S + key) * 1152 + h * 192;
                for (int cc = 0; cc < 24; ++cc) { const u32x4 kw = *(const u32x4*)(kp + 8 * cc); float kf[8];
#pragma unroll
                    for (int j = 0; j < 4; ++j) { kf[2 * j] = bflo(kw[j]); kf[2 * j + 1] = bfhi(kw[j]); }
#pragma unroll
                    for (int r = 0; r < 8; ++r) { const f32x4 qa = *(const LAS f32x4*)&qs[r * 192 + 8 * cc], qb2 = *(const LAS f32x4*)&qs[r * 192 + 8 * cc + 4];
                        sc[r] += qa[0] * kf[0] + qa[1] * kf[1] + qa[2] * kf[2] + qa[3] * kf[3] + qb2[0] * kf[4] + qb2[1] * kf[5] + qb2[2] * kf[6] + qb2[3] * kf[7]; } }
            }
            float pr[8];
#pragma unroll
            for (int r = 0; r < 8; ++r) { const float sv = (key <= q0 + r) ? sc[r] : -__builtin_inff(); const float mx = wave_max(sv), mn = fmaxf(m[r], mx);
                const float al = __builtin_amdgcn_exp2f(m[r] - mn); const float pv = __builtin_amdgcn_exp2f(sv - mn);
                lsum[r] = lsum[r] * al + wave_sum(pv); o0[r] *= al; o1[r] *= al; m[r] = mn; pr[r] = pv; }
            const int kmax = (last - ch * 64 < 63) ? last - ch * 64 : 63;
            const bf16_t* vp = V + (size_t)(b * S + ch * 64) * 768 + h * 128 + 2 * lane;
            for (int kk = 0; kk <= kmax; ++kk) { const unsigned vw = *(const unsigned*)(vp + (size_t)kk * 768); const float v0 = bflo(vw), v1 = bfhi(vw);
#pragma unroll
                for (int r = 0; r < 8; ++r) { const float pk = __int_as_float(__builtin_amdgcn_readlane(__float_as_int(pr[r]), kk)); o0[r] += pk * v0; o1[r] += pk * v1; } }
        }
#pragma unroll
        for (int r = 0; r < 8; ++r) { const float il = 1.f / lsum[r];
            *(unsigned*)(MIX + (size_t)(b * S + q0 + r) * 1024 + 256 + h * 128 + 2 * lane) = cvt_pk_bf16(o0[r] * il, o1[r] * il); }
    }
}


namespace att {
typedef short s16x4 __attribute__((ext_vector_type(4)));
typedef float f32x16 __attribute__((ext_vector_type(16)));
constexpr int VB = 16384, KNB = 16384, KRB = 8192;
constexpr int O_V = 0, O_KN = 2 * VB, O_KR = O_KN + 2 * KNB, O_WS = O_KR + 2 * KRB;
constexpr float THR2 = 11.5f;
#define A_KSWZ(row, colB) ((row) * 256 + ((colB) ^ (((row) & 7) << 4)))
#define A_RSWZ(row, colB) ((row) * 128 + ((colB) ^ ((((row) >> 1) & 7) << 4)))
#define A_SBAR() __builtin_amdgcn_sched_barrier(0)
__device__ __forceinline__ int v_st(int k, int c) { const int kk = (k & ~0xC) | ((k & 4) << 1) | ((k & 8) >> 1); return ((kk >> 3) * 4 + (c >> 5)) * 512 + ((kk & 7) * 32 + (c & 31)) * 2; }
__device__ __forceinline__ int v_rd_base(int lane) { return ((lane & 3) << 3) | (((lane >> 2) & 3) << 6) | (((lane >> 4) & 1) << 5) | (((lane >> 5) & 1) << 8); }
constexpr int v_rd_off(int d0, int ks, int half) { return d0 * 512 + ks * 4096 + half * 2048; }
__device__ __forceinline__ int crow(int r, int hi) { return (r & 3) + 8 * (r >> 2) + 4 * hi; }
__device__ __forceinline__ void mask_tile(f32x16& p0, f32x16& p1, int dq) {
    const float NEG = -__builtin_inff();
#pragma unroll
    for (int r = 0; r < 16; ++r) { const int cc = (r & 3) + 8 * (r >> 2); if (dq - cc < 0) p0[r] = NEG; if (dq - cc - 32 < 0) p1[r] = NEG; }
}
__device__ __forceinline__ void softmax_tile(f32x16& p0, f32x16& p1, float& m_reg, float& l_reg, float& alpha, bf16x8& pa0, bf16x8& pa1, bf16x8& pa2, bf16x8& pa3) {
    float pmax = p0[0];
#pragma unroll
    for (int r = 1; r < 16; ++r) pmax = fmaxf(pmax, p0[r]);
#pragma unroll
    for (int r = 0; r < 16; ++r) pmax = fmaxf(pmax, p1[r]);
    { auto rr = __builtin_amdgcn_permlane32_swap(__float_as_uint(pmax), __float_as_uint(pmax), false, false); pmax = fmaxf(__uint_as_float(rr[0]), __uint_as_float(rr[1])); }
    float mn;
    if (__builtin_expect(__all(pmax - m_reg <= THR2), 1)) { mn = m_reg; alpha = 1.f; }
    else { mn = fmaxf(m_reg, pmax); alpha = __builtin_amdgcn_exp2f(m_reg - mn); m_reg = mn; }
#pragma unroll
    for (int r = 0; r < 16; ++r) { p0[r] = __builtin_amdgcn_exp2f(p0[r] - mn); p1[r] = __builtin_amdgcn_exp2f(p1[r] - mn); }
    float ps = 0.f;
#pragma unroll
    for (int r = 0; r < 16; ++r) ps += p0[r];
#pragma unroll
    for (int r = 0; r < 16; ++r) ps += p1[r];
    { auto rr = __builtin_amdgcn_permlane32_swap(__float_as_uint(ps), __float_as_uint(ps), false, false); ps = __uint_as_float(rr[0]) + __uint_as_float(rr[1]); }
    l_reg = l_reg * alpha + ps;
#define A_PK4(P, B_, OUT) do { unsigned a0 = cvt_pk_bf16(P[B_ + 0], P[B_ + 1]), a1 = cvt_pk_bf16(P[B_ + 2], P[B_ + 3]);                   \
        unsigned b0 = cvt_pk_bf16(P[B_ + 4], P[B_ + 5]), b1 = cvt_pk_bf16(P[B_ + 6], P[B_ + 7]);                                          \
        auto r0 = __builtin_amdgcn_permlane32_swap(a0, b0, false, false); auto r1 = __builtin_amdgcn_permlane32_swap(a1, b1, false, false); \
        u32x4 w = {r0[0], r1[0], r0[1], r1[1]}; OUT = *reinterpret_cast<bf16x8*>(&w); } while (0)
    A_PK4(p0, 0, pa0); A_PK4(p0, 8, pa1); A_PK4(p1, 0, pa2); A_PK4(p1, 8, pa3);
#undef A_PK4
}
template <int KBUF>
__device__ __forceinline__ void qkt(f32x16& p0, f32x16& p1, const LAS char* lds, int r32, int hi, const bf16x8 (&qr)[12]) {
    p0 = f32x16{}; p1 = f32x16{};
    const LAS char* kb[4]; const LAS char* rb[4];
#pragma unroll
    for (int dd = 0; dd < 4; ++dd) { kb[dd] = lds + O_KN + KBUF * KNB + A_KSWZ(r32, (dd * 16 + hi * 8) * 2); rb[dd] = lds + O_KR + KBUF * KRB + A_RSWZ(r32, (dd * 16 + hi * 8) * 2); }
#pragma unroll
    for (int d0 = 0; d0 < 8; ++d0) { const LAS char* a = kb[d0 & 3] + (d0 >> 2) * 128;
        const bf16x8 b0 = *reinterpret_cast<const LAS bf16x8*>(a), b1 = *reinterpret_cast<const LAS bf16x8*>(a + 32 * 256);
        p0 = __builtin_amdgcn_mfma_f32_32x32x16_bf16(b0, qr[d0], p0, 0, 0, 0);
        p1 = __builtin_amdgcn_mfma_f32_32x32x16_bf16(b1, qr[d0], p1, 0, 0, 0); }
#pragma unroll
    for (int dd = 0; dd < 4; ++dd) { const bf16x8 b0 = *reinterpret_cast<const LAS bf16x8*>(rb[dd]), b1 = *reinterpret_cast<const LAS bf16x8*>(rb[dd] + 32 * 128);
        p0 = __builtin_amdgcn_mfma_f32_32x32x16_bf16(b0, qr[8 + dd], p0, 0, 0, 0);
        p1 = __builtin_amdgcn_mfma_f32_32x32x16_bf16(b1, qr[8 + dd], p1, 0, 0, 0); }
}
template <int VBUF>
__device__ __forceinline__ void pv_tile(f32x16 (&o)[4], int vb0, bf16x8 pa0, bf16x8 pa1, bf16x8 pa2, bf16x8 pa3) {
#define A_TRRD(dst, off) asm volatile("ds_read_b64_tr_b16 %0, %1 offset:%2" : "=&v"(dst) : "v"(vb0), "i"(off) : "memory")
#define A_PV_D0(d0) do { s16x4 l0, l1, l2, l3, h0, h1, h2, h3; constexpr int b_ = O_V + VBUF * VB + v_rd_off(d0, 0, 0); \
        A_TRRD(l0, b_); A_TRRD(h0, b_ + 2048); A_TRRD(l1, b_ + 4096); A_TRRD(h1, b_ + 6144); A_TRRD(l2, b_ + 8192); A_TRRD(h2, b_ + 10240); A_TRRD(l3, b_ + 12288); A_TRRD(h3, b_ + 14336); \
        asm volatile("s_waitcnt lgkmcnt(0)" ::: "memory"); A_SBAR(); \
        o[d0] = __builtin_amdgcn_mfma_f32_32x32x16_bf16(pa0, (bf16x8){l0[0], l0[1], l0[2], l0[3], h0[0], h0[1], h0[2], h0[3]}, o[d0], 0, 0, 0); \
        o[d0] = __builtin_amdgcn_mfma_f32_32x32x16_bf16(pa1, (bf16x8){l1[0], l1[1], l1[2], l1[3], h1[0], h1[1], h1[2], h1[3]}, o[d0], 0, 0, 0); \
        o[d0] = __builtin_amdgcn_mfma_f32_32x32x16_bf16(pa2, (bf16x8){l2[0], l2[1], l2[2], l2[3], h2[0], h2[1], h2[2], h2[3]}, o[d0], 0, 0, 0); \
        o[d0] = __builtin_amdgcn_mfma_f32_32x32x16_bf16(pa3, (bf16x8){l3[0], l3[1], l3[2], l3[3], h3[0], h3[1], h3[2], h3[3]}, o[d0], 0, 0, 0); } while (0)
    A_PV_D0(0); A_PV_D0(1); A_PV_D0(2); A_PV_D0(3);
#undef A_PV_D0
#undef A_TRRD
}
struct Stage { bf16x8 kn0, kn1, kr, v0, v1; };
__device__ __forceinline__ void block(const GAS bf16_t* Q, const GAS bf16_t* Kf, const GAS bf16_t* V, GAS bf16_t* MIX, LAS char* lds, int b, int h, int qb, int wid, int lane) {
    const int tid = wid * 64 + lane, r32 = lane & 31, hi = lane >> 5;
    const int tb = b * S, P0 = qb * 256, qlo = P0 + wid * 32, NT = 4 * qb + 4;
    LAS float* wsf = (LAS float*)(lds + O_WS) + wid * 64; LAS float* li_l = wsf; LAS float* al_l = wsf + 32;
    const int sr = tid >> 4, sc = (tid & 15) * 8, rr = tid >> 3, rc = (tid & 7) * 8;
    const int kws = A_KSWZ(sr, sc * 2), rws = A_RSWZ(rr, rc * 2), vst0 = v_st(sr, sc), vst1 = v_st(32 + sr, sc);
    const GAS bf16_t* kng = Kf + (size_t)(tb + sr) * 1152 + h * 192 + sc;
    const GAS bf16_t* krg = Kf + (size_t)(tb + rr) * 1152 + h * 192 + 128 + rc;
    const GAS bf16_t* vg = V + (size_t)(tb + sr) * 768 + h * 128 + sc;
    const int vb0 = (int)(uintptr_t)(lds) + v_rd_base(lane);
    Stage st;
#define A_SLOAD(kb0) do { st.kn0 = *(const GAS bf16x8*)(kng + (size_t)(kb0) * 1152); st.kn1 = *(const GAS bf16x8*)(kng + (size_t)((kb0) + 32) * 1152); \
        st.kr = *(const GAS bf16x8*)(krg + (size_t)(kb0) * 1152); st.v0 = *(const GAS bf16x8*)(vg + (size_t)(kb0) * 768); st.v1 = *(const GAS bf16x8*)(vg + (size_t)((kb0) + 32) * 768); } while (0)
#define A_SWRITE(bf) do { *(LAS bf16x8*)(lds + O_KN + (bf) * KNB + kws) = st.kn0; *(LAS bf16x8*)(lds + O_KN + (bf) * KNB + kws + 32 * 256) = st.kn1; \
        *(LAS bf16x8*)(lds + O_KR + (bf) * KRB + rws) = st.kr; *(LAS bf16x8*)(lds + O_V + (bf) * VB + vst0) = st.v0; *(LAS bf16x8*)(lds + O_V + (bf) * VB + vst1) = st.v1; } while (0)
    bf16x8 qr[12];
    { const GAS bf16_t* qp = Q + (size_t)(tb + qlo + r32) * 1152 + h * 192 + hi * 8;
#pragma unroll
      for (int d0 = 0; d0 < 12; ++d0) qr[d0] = *(const GAS bf16x8*)(qp + d0 * 16); }
    A_SLOAD(0);
    asm volatile("s_waitcnt vmcnt(0)" ::: "memory");
    A_SWRITE(0);
    __syncthreads();
    float m_reg = -1e30f, l_reg = 0.f; f32x16 o[4] = {};
    f32x16 p0, p1; bf16x8 pa0, pa1, pa2, pa3; float alpha;
#define A_STEP(t, KB_, SB_) do { \
        if ((t) + 1 < NT) A_SLOAD(((t) + 1) * 64); \
        A_SBAR(); \
        if ((t) * 64 <= qlo + 31) { \
            qkt<KB_>(p0, p1, lds, r32, hi, qr); \
            if ((t) * 64 + 63 > qlo) mask_tile(p0, p1, qlo + r32 - (t) * 64 - 4 * hi); \
            softmax_tile(p0, p1, m_reg, l_reg, alpha, pa0, pa1, pa2, pa3); \
            if (__any(alpha < 1.f)) { if (hi == 0) al_l[r32] = alpha; asm volatile("s_waitcnt lgkmcnt(0)" ::: "memory"); \
                _Pragma("unroll") for (int d_ = 0; d_ < 4; ++d_) _Pragma("unroll") for (int r = 0; r < 16; ++r) o[d_][r] *= al_l[crow(r, hi)]; } \
            A_SBAR(); \
            pv_tile<KB_>(o, vb0, pa0, pa1, pa2, pa3); } \
        if ((t) + 1 < NT) { asm volatile("s_waitcnt vmcnt(0)" ::: "memory"); A_SWRITE(SB_); } \
        __syncthreads(); } while (0)
    for (int t = 0; t < NT; t += 2) { A_STEP(t, 0, 1); A_STEP(t + 1, 1, 0); }
    if (hi == 0) li_l[r32] = l_reg;
    asm volatile("s_waitcnt lgkmcnt(0)" ::: "memory");
    GAS bf16_t* op = MIX + (size_t)(tb + qlo) * 1024 + 256 + h * 128 + r32;
#pragma unroll
    for (int r = 0; r < 16; ++r) { const int orow = crow(r, hi); const float il = __builtin_amdgcn_rcpf(li_l[orow]);
#pragma unroll
        for (int d0 = 0; d0 < 4; ++d0) { const float v = o[d0][r] * il; const float vn = SWZ_XOR(v, 1);
            if ((r32 & 1) == 0) *(GAS unsigned*)(op + (size_t)orow * 1024 + d0 * 32) = cvt_pk_bf16(v, vn); } }
    __syncthreads();
#undef A_STEP
#undef A_SLOAD
#undef A_SWRITE
}
}

__device__ __forceinline__ void ph_attn(const Params& p, const Ctx& c) {
    unsigned char* ws = p.ws;
    const GAS bf16_t* Q = (const GAS bf16_t*)(ws + WS_Q); const GAS bf16_t* Kf = (const GAS bf16_t*)(ws + WS_KF); const GAS bf16_t* V = (const GAS bf16_t*)(ws + WS_V); GAS bf16_t* MIX = (GAS bf16_t*)(ws + WS_MIX);
    LAS char* lds = (LAS char*)c.lds;
    int nit = 0, trv = 0; unsigned tabv = 0u;
    if (c.G == 256) {
        const int x = c.bid & 7, y = c.bid >> 3, tr = x * 4 + (y >> 3), bin = y & 7;
        const unsigned tab = bin == 0 ? ((0u << 3 | 7) | (0u << 3 | 4) << 5 | (0u << 3 | 0) << 10 | 0x1fu << 15 | 0x1fu << 20)
                           : bin == 1 ? ((1u << 3 | 7) | (1u << 3 | 4) << 5 | (1u << 3 | 0) << 10 | 0x1fu << 15 | 0x1fu << 20)
                           : bin == 2 ? ((2u << 3 | 7) | (2u << 3 | 4) << 5 | (2u << 3 | 0) << 10 | 0x1fu << 15 | 0x1fu << 20)
                           : bin == 3 ? ((0u << 3 | 6) | (0u << 3 | 5) << 5 | 0x1fu << 10 | 0x1fu << 15 | 0x1fu << 20)
                           : bin == 4 ? ((1u << 3 | 6) | (1u << 3 | 5) << 5 | 0x1fu << 10 | 0x1fu << 15 | 0x1fu << 20)
                           : bin == 5 ? ((2u << 3 | 6) | (2u << 3 | 5) << 5 | 0x1fu << 10 | 0x1fu << 15 | 0x1fu << 20)
                           : bin == 6 ? ((0u << 3 | 3) | (1u << 3 | 3) << 5 | (0u << 3 | 2) << 10 | (1u << 3 | 2) << 15 | 0x1fu << 20)
                           :            ((2u << 3 | 3) | (2u << 3 | 2) << 5 | (0u << 3 | 1) << 10 | (1u << 3 | 1) << 15 | (2u << 3 | 1) << 20);
        nit = 5; tabv = tab; trv = tr;
    } else { nit = (96 * 8 - c.bid + c.G - 1) / c.G; }
    for (int k = 0; k < nit; ++k) {
        int bh, qb;
        if (c.G == 256) { const unsigned en = (tabv >> (5 * k)) & 0x1fu; if (en == 0x1fu) break; bh = trv * 3 + (int)(en >> 3); qb = (int)(en & 7u); }
        else { const int item = c.bid + k * c.G; bh = item % 96; qb = 7 - item / 96; }
        att::block(Q, Kf, V, MIX, lds, bh / NH, bh % NH, qb, c.wid, c.lane);
    }
}

__device__ __forceinline__ void ln_row(f32x4 (&v)[4], const float* g, const float* bta, int lane) {
    float s = 0.f;
#pragma unroll
    for (int j = 0; j < 4; ++j) s += (v[j][0] + v[j][1]) + (v[j][2] + v[j][3]);
    const float mean = wave_sum(s) * (1.f / D); float s2 = 0.f;
#pragma unroll
    for (int j = 0; j < 4; ++j) { v[j] = v[j] - mean; s2 += (v[j][0] * v[j][0] + v[j][1] * v[j][1]) + (v[j][2] * v[j][2] + v[j][3] * v[j][3]); }
    const float rstd = 1.0f / sqrtf(wave_sum(s2) * (1.f / D) + LN_EPS);
#pragma unroll
    for (int j = 0; j < 4; ++j) { const f32x4 gg = *(const f32x4*)(g + 4 * lane + 256 * j), bb = *(const f32x4*)(bta + 4 * lane + 256 * j); v[j] = v[j] * rstd * gg + bb; }
}

__device__ __forceinline__ void ph_ln1(const Params& p, const Ctx& c, int l) {
    const float* mod = (const float*)(p.ws + WS_MOD) + (size_t)l * 16 * 6144; bf16_t* H = (bf16_t*)(p.ws + WS_H);
    for (int t = c.gw; t < T; t += c.ngw) { const int b = t / S; f32x4 v[4]; float* xr = p.out + (size_t)t * 1024;
#pragma unroll
        for (int j = 0; j < 4; ++j) v[j] = *(const f32x4*)(xr + 4 * c.lane + 256 * j);
        ln_row(v, p.ln1g + l * 1024, p.ln1b + l * 1024, c.lane);
#pragma unroll
        for (int j = 0; j < 4; ++j) *(f32x4*)(xr + 4 * c.lane + 256 * j) = v[j];
        write_mod_row(v, mod + (size_t)b * 6144 + 3 * 1024, mod + (size_t)b * 6144 + 4 * 1024, H + (size_t)t * 1024, c.lane); }
}

__device__ __forceinline__ void ph_route(const Params& p, const Ctx& c, int l) {
    unsigned char* ws = p.ws;
    const float* logits = (const float*)(ws + WS_LOG); float* tg = (float*)(ws + WS_TG); int* lists = (int*)(ws + WS_LIST);
    unsigned* cnt = (unsigned*)(ws + WS_CTL) + CW_CNT + l * 64;
    LAS float* sc = (LAS float*)c.lds;
    LAS unsigned* lcnt = (LAS unsigned*)(c.lds + LDS_MISC + 1024); LAS unsigned* gbase = lcnt + 64;
    const int tid = c.tid;
    for (int i = c.bid * NTHREADS + tid; i < T; i += c.G * NTHREADS) lists[(size_t)64 * T + i] = 8 * T + i;
    for (int t0 = c.bid * NTHREADS; t0 < T; t0 += c.G * NTHREADS) {
        const int t = t0 + tid;
        if (tid < 64) lcnt[tid] = 0u;
        const float* lr = logits + (size_t)t * 64;
#pragma unroll
        for (int q = 0; q < 16; ++q) { const f32x4 v = *(const f32x4*)(lr + 4 * q);
#pragma unroll
            for (int j = 0; j < 4; ++j) { const int e = 4 * q + j; sc[e * NTHREADS + tid] = 1.f / (1.f + __expf(-v[j])) + p.rbias[l * 64 + e]; } }
        float gs[8];
#pragma unroll
        for (int g = 0; g < 8; ++g) { float a = -__builtin_inff(), b2 = -__builtin_inff();
#pragma unroll
            for (int j = 0; j < 8; ++j) { const float v = sc[(8 * g + j) * NTHREADS + tid]; if (v > a) { b2 = a; a = v; } else if (v > b2) b2 = v; }
            gs[g] = a + b2; }
        unsigned gmask = 0u;
#pragma unroll
        for (int r = 0; r < 4; ++r) { float best = -__builtin_inff(); int bi = 0;
#pragma unroll
            for (int g = 0; g < 8; ++g) { const bool ok = !((gmask >> g) & 1u) && gs[g] > best; best = ok ? gs[g] : best; bi = ok ? g : bi; }
            gmask |= 1u << bi; }
        unsigned long long taken = 0ull; int ek[8]; float wk[8]; float wsum = 0.f;
#pragma unroll
        for (int k = 0; k < 8; ++k) { float best = -__builtin_inff(); int bi = 0;
            for (int e = 0; e < 64; ++e) { const bool ok = ((gmask >> (e >> 3)) & 1u) && !((taken >> e) & 1ull); const float v = sc[e * NTHREADS + tid]; if (ok && v > best) { best = v; bi = e; } }
            taken |= 1ull << bi; ek[k] = bi; const float w = 1.f / (1.f + __expf(-lr[bi])); wk[k] = w; wsum += w; }
        __syncthreads();
        unsigned rk[8];
#pragma unroll
        for (int k = 0; k < 8; ++k) rk[k] = atomicAdd((unsigned*)&lcnt[ek[k]], 1u);
        __syncthreads();
        if (tid < 64) gbase[tid] = atomicAdd(&cnt[tid], lcnt[tid]);
        __syncthreads();
        const float inv = 2.5f / wsum;
#pragma unroll
        for (int k = 0; k < 8; ++k) { tg[(size_t)t * 8 + k] = wk[k] * inv; lists[(size_t)ek[k] * T + gbase[ek[k]] + rk[k]] = t * 8 + k; }
        __syncthreads();
    }
}

__device__ __forceinline__ void ph_combine(const Params& p, const Ctx& c, int l) {
    unsigned char* ws = p.ws;
    const float* mod = (const float*)(ws + WS_MOD) + (size_t)l * 16 * 6144; const float* modn = mod + 16 * 6144; bf16_t* H = (bf16_t*)(ws + WS_H);
    const bf16_t* Y = (const bf16_t*)(ws + WS_Y); const float* tg = (const float*)(ws + WS_TG);
    for (int t = c.gw; t < T; t += c.ngw) { const int b = t / S; f32x4 f[4]; float* xr = p.out + (size_t)t * 1024;
        { const bf16_t* yr = Y + (size_t)(8 * T + t) * 1024;
#pragma unroll
            for (int j = 0; j < 4; ++j) { const u32x2 w = *(const u32x2*)(yr + 4 * c.lane + 256 * j); f[j] = (f32x4){bflo(w.x), bfhi(w.x), bflo(w.y), bfhi(w.y)}; } }
        f32x4 r4[4];
#pragma unroll
        for (int j = 0; j < 4; ++j) r4[j] = (f32x4){0.f, 0.f, 0.f, 0.f};
#pragma unroll
        for (int k = 0; k < 8; ++k) { const float gk = tg[(size_t)t * 8 + k]; const bf16_t* yr = Y + (size_t)(t * 8 + k) * 1024;
#pragma unroll
            for (int j = 0; j < 4; ++j) { const u32x2 w = *(const u32x2*)(yr + 4 * c.lane + 256 * j); r4[j] += (f32x4){bflo(w.x), bfhi(w.x), bflo(w.y), bfhi(w.y)} * gk; } }
        f32x4 v[4];
#pragma unroll
        for (int j = 0; j < 4; ++j) { const f32x4 g2 = *(const f32x4*)(mod + (size_t)b * 6144 + 5 * 1024 + 4 * c.lane + 256 * j); v[j] = *(const f32x4*)(xr + 4 * c.lane + 256 * j) * ALPHA + g2 * (f[j] + r4[j]); }
        ln_row(v, p.ln2g + l * 1024, p.ln2b + l * 1024, c.lane);
#pragma unroll
        for (int j = 0; j < 4; ++j) *(f32x4*)(xr + 4 * c.lane + 256 * j) = v[j];
        if (l + 1 < NL) write_mod_row(v, modn + (size_t)b * 6144 + 0, modn + (size_t)b * 6144 + 1024, H + (size_t)t * 1024, c.lane); }
}

#ifndef GEMM_BODY
#define GEMM_BODY gemm_mfma
#endif
#ifndef ATTN_BODY
#define ATTN_BODY ph_attn
#endif
#ifndef GB_EpiP
#define GB_EpiP GEMM_BODY
#endif
#ifndef GB_EpiQ
#define GB_EpiQ GEMM_BODY
#endif
#ifndef GB_EpiKV
#define GB_EpiKV GEMM_BODY
#endif
#ifndef GB_EpiOut
#define GB_EpiOut GEMM_BODY
#endif
#ifndef GB_EpiRouter
#define GB_EpiRouter GEMM_BODY
#endif
#ifndef GB_EpiSwiglu
#define GB_EpiSwiglu GEMM_BODY
#endif
#ifndef GB_EpiDown
#define GB_EpiDown GEMM_BODY
#endif

__global__ void __launch_bounds__(NTHREADS, 2) mk_fwd(Params p, int seg_lo, int seg_hi) {
    extern __shared__ __attribute__((aligned(16))) unsigned char lds_raw[];
    Ctx c0; c0.lds = (LAS unsigned char*)lds_raw; c0.tid = threadIdx.x; c0.lane = c0.tid & 63; c0.wid = __builtin_amdgcn_readfirstlane(c0.tid >> 6);
    c0.G = gridDim.x; c0.bid = blockIdx.x; c0.gw = c0.bid * NWAVES + c0.wid; c0.ngw = c0.G * NWAVES;
    volatile LAS unsigned* misc = (volatile LAS unsigned*)(c0.lds + LDS_MISC);
    if (c0.tid < 64) misc[c0.tid] = 0u;
    __syncthreads();
    XcdBarrier bar; { LOAD_Q bar = xcd_barrier_post((unsigned*)(q.ws + WS_CTL) + CW_BAR, misc); }
    LAS int* tp = (LAS int*)(c0.lds + LDS_MISC + 256);
#define IN(k) (seg_lo <= (k) && (k) < seg_hi)
#define SEAM(k) do { if (IN((k) + 1)) xcd_barrier(bar); } while (0)

    if (IN(0)) { PHASE_Q ph_prologue(q, c); SEAM(0); }
    for (int l = 0; l < NL; ++l) {
        const int sb = 1 + l * PH_PER_LAYER;
        if (IN(sb + 0)) { PHASE_Q ph_prep(q, c, l); SEAM(sb + 0); }
        if (IN(sb + 1)) {
            PHASE_Q
            GemmDesc g{(const GAS bf16_t*)(ws + WS_H), 1024, 1024, 1024};
            DenseSched sc{(const GAS bf16_t*)(ws + WS_WIN) + (size_t)l * 1024 * 1024, 1024, T / 256, 4, c.G, c.bid};
            EpiP e{(bf16_t*)(ws + WS_P)};
            GB_EpiP<EpiP::PERM>(c.lds, c.wid, g, sc, e); SEAM(sb + 1); }
        if (IN(sb + 2)) { PHASE_Q ph_post_in(q, c, l); SEAM(sb + 2); }
        if (IN(sb + 3)) {
            PHASE_Q
            { GemmDesc g{(const GAS bf16_t*)(ws + WS_P) + 256, 1024, 384, 384};
              DenseSched sc{(const GAS bf16_t*)(ws + WS_WUQ) + (size_t)l * 1280 * 384, 384, T / 256, 5, c.G, c.bid};
              EpiQ e{(bf16_t*)(ws + WS_Q), (const float*)(ws + WS_RSQ), (const f32x2*)(ws + WS_CS)};
              GB_EpiQ<EpiQ::PERM>(c.lds, c.wid, g, sc, e); }
            { GemmDesc g{(const GAS bf16_t*)(ws + WS_P) + 640, 1024, 256, 256};
              int bid2 = c0.bid, g2 = c0.G; asm volatile("" : "+s"(bid2), "+s"(g2));
              DenseSched sc{(const GAS bf16_t*)(ws + WS_WUKV) + (size_t)l * 1536 * 256, 256, T / 256, 6, g2, g2 - 1 - bid2};
              EpiKV e{(bf16_t*)(ws + WS_KF), (bf16_t*)(ws + WS_V), (const float*)(ws + WS_RSKV)};
              GB_EpiKV<EpiKV::PERM>(c.lds, c.wid, g, sc, e); }
            SEAM(sb + 3); }
        if (IN(sb + 4)) { PHASE_Q ATTN_BODY(q, c); SEAM(sb + 4); }
        if (IN(sb + 5)) {
            PHASE_Q const float* mod = (const float*)(ws + WS_MOD) + (size_t)l * 16 * 6144;
            GemmDesc g{(const GAS bf16_t*)(ws + WS_MIX), 1024, 1024, 1024};
            DenseSched sc{(const GAS bf16_t*)(ws + WS_WOUT) + (size_t)l * 1024 * 1024, 1024, T / 256, 4, c.G, c.bid};
            EpiOut e{l == 0 ? q.x : q.out, q.out, mod + 2 * 1024};
            GB_EpiOut<EpiOut::PERM>(c.lds, c.wid, g, sc, e); SEAM(sb + 5); }
        if (IN(sb + 6)) { PHASE_Q ph_ln1(q, c, l); SEAM(sb + 6); }
        if (IN(sb + 7)) {
            PHASE_Q
            GemmDesc g{(const GAS bf16_t*)(ws + WS_H), 1024, 1024, 1024};
            DenseSched sc{(const GAS bf16_t*)(ws + WS_WR) + (size_t)l * 256 * 1024, 1024, T / 256, 1, c.G, c.bid};
            EpiRouter e{(float*)(ws + WS_LOG)};
            GB_EpiRouter<EpiRouter::PERM>(c.lds, c.wid, g, sc, e); SEAM(sb + 7); }
        if (IN(sb + 8)) { PHASE_Q ph_route(q, c, l); SEAM(sb + 8); }
        if (IN(sb + 9)) {
            PHASE_Q
            moe_build_tiles(tp, (const int*)((unsigned*)(ws + WS_CTL) + CW_CNT + l * 64));
            GemmDesc g{(const GAS bf16_t*)(ws + WS_H), 1024, 1024, 1024};
            MoeSched sc{(const GAS bf16_t*)(ws + WS_WGU), (size_t)512 * 1024, 1024, (const GAS int*)(ws + WS_LIST), (const GAS int*)((unsigned*)(ws + WS_CTL) + CW_CNT + l * 64), tp, 2, c.G, c.bid, true};
            EpiSwiglu e{(bf16_t*)(ws + WS_ACT)};
            GB_EpiSwiglu<EpiSwiglu::PERM>(c.lds, c.wid, g, sc, e); SEAM(sb + 9); }
        if (IN(sb + 10)) {
            PHASE_Q
            moe_build_tiles(tp, (const int*)((unsigned*)(ws + WS_CTL) + CW_CNT + l * 64));
            GemmDesc g{(const GAS bf16_t*)(ws + WS_ACT), 256, 256, 256};
            MoeSched sc{(const GAS bf16_t*)(ws + WS_WD), (size_t)1024 * 256, 256, (const GAS int*)(ws + WS_LIST), (const GAS int*)((unsigned*)(ws + WS_CTL) + CW_CNT + l * 64), tp, 4, c.G, c.bid, false};
            EpiDown e{(bf16_t*)(ws + WS_Y)};
            GB_EpiDown<EpiDown::PERM>(c.lds, c.wid, g, sc, e); SEAM(sb + 10); }
        if (IN(sb + 11)) { PHASE_Q ph_combine(q, c, l); SEAM(sb + 11); }
    }
#undef IN
#undef SEAM
}

#ifndef MK_ONE_LAUNCH
#define MK_ONE_LAUNCH 1
#endif
extern "C" void kernel_launch(void* const* d_in, const int* in_sizes, int n_in, void* d_out, int out_size, void* d_ws, size_t ws_size, hipStream_t stream) {
    static int grid = 0;
    if (grid == 0) {
        if (n_in != 25 || out_size != T * D || ws_size < WS_END) { fprintf(stderr, "kernel_launch: unexpected shapes (n_in %d out %d ws %zu need %zu)\n", n_in, out_size, ws_size, (size_t)WS_END); grid = -1; return; }
        int dev = 0, cus = 0, per_cu = 0;
        if (hipGetDevice(&dev) != hipSuccess || hipDeviceGetAttribute(&cus, hipDeviceAttributeMultiprocessorCount, dev) != hipSuccess) { grid = -1; return; }
        if (hipFuncSetAttribute((const void*)mk_fwd, hipFuncAttributeMaxDynamicSharedMemorySize, LDS_BYTES) != hipSuccess) { fprintf(stderr, "kernel_launch: hipFuncSetAttribute failed\n"); grid = -1; return; }
        if (hipOccupancyMaxActiveBlocksPerMultiprocessor(&per_cu, (const void*)mk_fwd, NTHREADS, LDS_BYTES) != hipSuccess || per_cu < 1) { fprintf(stderr, "kernel_launch: occupancy query says %d\n", per_cu); }
        (void)hipGetLastError();
        grid = cus;
    }
    if (grid < 0) return;
    (void)hipMemsetAsync((char*)d_ws + WS_CTL, 0, CTL_BYTES, stream);
    Params p{};
    p.x = (const float*)d_in[0]; p.c = (const float*)d_in[1]; p.pos = (const int*)d_in[2];
    p.w_ada = (const float*)d_in[3]; p.b_ada = (const float*)d_in[4]; p.w_in = (const float*)d_in[5]; p.qg = (const float*)d_in[6]; p.kvg = (const float*)d_in[7];
    p.w_uq = (const float*)d_in[8]; p.w_ukv = (const float*)d_in[9]; p.w_pool = (const float*)d_in[10]; p.pool_scale = (const float*)d_in[11]; p.w_out = (const float*)d_in[12];
    p.ln1g = (const float*)d_in[13]; p.ln1b = (const float*)d_in[14]; p.w_router = (const float*)d_in[15]; p.rbias = (const float*)d_in[16];
    p.weg = (const float*)d_in[17]; p.weu = (const float*)d_in[18]; p.wed = (const float*)d_in[19]; p.wsg = (const float*)d_in[20]; p.wsu = (const float*)d_in[21]; p.wsd = (const float*)d_in[22];
    p.ln2g = (const float*)d_in[23]; p.ln2b = (const float*)d_in[24];
    p.out = (float*)d_out; p.ws = (unsigned char*)d_ws;
#if MK_ONE_LAUNCH
    hipLaunchKernelGGL(mk_fwd, dim3(grid), dim3(NTHREADS), LDS_BYTES, stream, p, 0, NSEG);
#else
    for (int s = 0; s < NSEG; ++s) hipLaunchKernelGGL(mk_fwd, dim3(grid), dim3(NTHREADS), LDS_BYTES, stream, p, s, s + 1);
#endif
}
```

```cpp
#include <hip/hip_runtime.h>
#include <stdint.h>
#include <cstdio>

#define LAS __attribute__((address_space(3)))
#define GAS __attribute__((address_space(1)))
typedef unsigned short bf16_t;
typedef short bf16x8 __attribute__((ext_vector_type(8)));
typedef float f32x4 __attribute__((ext_vector_type(4)));
typedef float f32x2 __attribute__((ext_vector_type(2)));
typedef unsigned u32x4 __attribute__((ext_vector_type(4)));
typedef unsigned u32x2 __attribute__((ext_vector_type(2)));

constexpr int D = 1024, NB = 16, S = 2048, T = NB * S, NL = 4;
constexpr int NE = 64, TOPK = 8, FE = 256, NH = 6;
constexpr int INW = 960;
constexpr int A_TOT = T * 9;
constexpr float ALPHA = 1.6817928305074290f;
constexpr float LN_EPS = 1e-5f, RMS_EPS = 1e-6f;
constexpr float QSCALE = 0.07216878364870322f * 1.4426950408889634f;
constexpr int NTHREADS = 512, NWAVES = 8;
constexpr int LDS_BYTES = 163840, LDS_MISC = 131072;
constexpr int PH_PER_LAYER = 12, NSEG = 1 + NL * PH_PER_LAYER;

constexpr size_t al256(size_t x) { return (x + 255) & ~(size_t)255; }
constexpr size_t WS_CTL = 0, CTL_BYTES = 1u << 20;
constexpr size_t CW_BAR = 4096;
constexpr size_t CW_CNT = 16384;
constexpr size_t WS_MOD = WS_CTL + CTL_BYTES;
constexpr size_t WS_CS = al256(WS_MOD + (size_t)NL * 16 * 6144 * 4);
constexpr size_t WS_RSQ = al256(WS_CS + (size_t)T * 32 * 8);
constexpr size_t WS_RSKV = al256(WS_RSQ + (size_t)T * 4);
constexpr size_t WS_WIN = al256(WS_RSKV + (size_t)T * 4);
constexpr size_t WS_WUQ = al256(WS_WIN + (size_t)NL * 1024 * 1024 * 2);
constexpr size_t WS_WUKV = al256(WS_WUQ + (size_t)NL * 1280 * 384 * 2);
constexpr size_t WS_WOUT = al256(WS_WUKV + (size_t)NL * 1536 * 256 * 2);
constexpr size_t WS_WR = al256(WS_WOUT + (size_t)NL * 1024 * 1024 * 2);
constexpr size_t WS_WGU = al256(WS_WR + (size_t)NL * 256 * 1024 * 2);
constexpr size_t WS_WD = al256(WS_WGU + (size_t)65 * 512 * 1024 * 2);
constexpr size_t WS_H = al256(WS_WD + (size_t)65 * 1024 * 256 * 2);
constexpr size_t WS_R = al256(WS_H + (size_t)T * 1024 * 2);
constexpr size_t WS_P = WS_R;
constexpr size_t WS_Q = al256(WS_P + (size_t)T * 1024 * 2);
constexpr size_t WS_KF = al256(WS_Q + (size_t)T * 1152 * 2);
constexpr size_t WS_V = al256(WS_KF + (size_t)T * 1152 * 2);
constexpr size_t WS_MIX = al256(WS_V + (size_t)T * 768 * 2);
constexpr size_t WS_MIX_END = al256(WS_MIX + (size_t)T * 1024 * 2);
constexpr size_t WS_ACT = WS_R;
constexpr size_t WS_LOG = al256(WS_ACT + (size_t)(A_TOT + 1) * 256 * 2);
constexpr size_t WS_TG = al256(WS_LOG + (size_t)T * 64 * 4);
constexpr size_t WS_LIST = al256(WS_TG + (size_t)T * 8 * 4);
constexpr size_t WS_Y = al256(WS_LIST + (size_t)65 * T * 4);
constexpr size_t WS_H8 = al256(WS_Y + (size_t)(A_TOT + 1) * 1024);
constexpr size_t WS_X16 = al256(WS_H8 + (size_t)T * 1024);
constexpr size_t WS_END = al256(WS_X16 + (size_t)T * 1024 * 2);
static_assert(WS_MIX_END <= WS_END && WS_END < 1000000000ull, "workspace map");

struct Params {
    const float *x, *c; const int* pos;
    const float *w_ada, *b_ada, *w_in, *qg, *kvg, *w_uq, *w_ukv, *w_pool, *pool_scale, *w_out, *ln1g, *ln1b, *w_router, *rbias;
    const float *weg, *weu, *wed, *wsg, *wsu, *wsd, *ln2g, *ln2b;
    float* out; unsigned char* ws;
};

__device__ __forceinline__ unsigned cvt_pk_bf16(float lo, float hi) { unsigned r; asm volatile("v_cvt_pk_bf16_f32 %0, %1, %2" : "=v"(r) : "v"(lo), "v"(hi)); return r; }
__device__ __forceinline__ unsigned pk4_fp8(float a, float b, float c, float d) {
    int w = __builtin_amdgcn_cvt_pk_fp8_f32(a, b, 0, false); w = __builtin_amdgcn_cvt_pk_fp8_f32(c, d, w, true); return (unsigned)w;
}
__device__ __forceinline__ float bf2f(bf16_t b) { return __uint_as_float(((unsigned)b) << 16); }
__device__ __forceinline__ float bflo(unsigned w) { return __uint_as_float(w << 16); }
__device__ __forceinline__ float bfhi(unsigned w) { return __uint_as_float(w & 0xffff0000u); }
#define SWZ_XOR(v, x) __int_as_float(__builtin_amdgcn_ds_swizzle(__float_as_int(v), ((x) << 10) | 0x1F))
__device__ __forceinline__ float wave_sum(float v) {
    v += SWZ_XOR(v, 1); v += SWZ_XOR(v, 2); v += SWZ_XOR(v, 4); v += SWZ_XOR(v, 8); v += SWZ_XOR(v, 16);
    const auto rr = __builtin_amdgcn_permlane32_swap(__float_as_uint(v), __float_as_uint(v), false, false);
    return __uint_as_float(rr[0]) + __uint_as_float(rr[1]);
}
__device__ __forceinline__ float wave_max(float v) {
    v = fmaxf(v, SWZ_XOR(v, 1)); v = fmaxf(v, SWZ_XOR(v, 2)); v = fmaxf(v, SWZ_XOR(v, 4)); v = fmaxf(v, SWZ_XOR(v, 8)); v = fmaxf(v, SWZ_XOR(v, 16));
    const auto rr = __builtin_amdgcn_permlane32_swap(__float_as_uint(v), __float_as_uint(v), false, false);
    return fmaxf(__uint_as_float(rr[0]), __uint_as_float(rr[1]));
}
__device__ __forceinline__ void store8_bf16(bf16_t* p, f32x4 a, f32x4 b) {
    u32x4 w; w.x = cvt_pk_bf16(a[0], a[1]); w.y = cvt_pk_bf16(a[2], a[3]); w.z = cvt_pk_bf16(b[0], b[1]); w.w = cvt_pk_bf16(b[2], b[3]);
    *(u32x4*)p = w;
}

__device__ __forceinline__ int fresh_lane() { int l; asm volatile("v_mbcnt_lo_u32_b32 %0, -1, 0\n\tv_mbcnt_hi_u32_b32 %0, -1, %0" : "=v"(l)); return l; }
template <class Tp> __device__ __forceinline__ Tp* launder(Tp* p) { asm volatile("" : "+s"(p)); return p; }
typedef __attribute__((address_space(4))) const Params CParams;
#if defined(__HIP_DEVICE_COMPILE__)
#define LOAD_Q CParams* kp_ = (CParams*)__builtin_amdgcn_kernarg_segment_ptr(); asm volatile("" : "+s"(kp_)); const Params q = *kp_;
#else
#define LOAD_Q const Params q = p;
#endif
#define PHASE_Q LOAD_Q unsigned char* ws = q.ws; (void)ws; \
    Ctx c = c0; asm volatile("" : "+s"(c.gw), "+s"(c.wid), "+s"(c.bid), "+s"(c.G), "+s"(c.ngw)); \
    c.lane = fresh_lane(); c.tid = c.wid * 64 + c.lane;

#define XB_TMO      128
#define XB_XCNT(j)  (256  + 64 * (j))
#define XB_XSUB(j)  (1280 + 64 * (j))
#define XB_XGEN(j)  (2304 + 64 * (j))
#define XB_TOP      3328
#define XB_TOPGEN   3392
#define XCD_BAR_WORDS 3456
#define XB_SPIN_CAP (1u << 20)
__device__ __forceinline__ unsigned xb_ld(unsigned* p)              { return __hip_atomic_load(p, __ATOMIC_RELAXED, __HIP_MEMORY_SCOPE_AGENT); }
__device__ __forceinline__ unsigned xb_add(unsigned* p, unsigned v) { return __hip_atomic_fetch_add(p, v, __ATOMIC_RELAXED, __HIP_MEMORY_SCOPE_AGENT); }
__device__ __forceinline__ unsigned xb_xcc_id() { return (unsigned)__builtin_amdgcn_s_getreg((3 << 11) | 20) & 0xFu; }
#define XB_SPIN(cond, bar) do { unsigned _sp = 0; while (cond) { __builtin_amdgcn_s_sleep(1); \
    if ((++_sp & 255u) == 0u) { if (xb_ld(&(bar)[XB_TMO])) break; if (_sp > XB_SPIN_CAP) { atomicAdd(&(bar)[XB_TMO], 1u); break; } } } } while (0)
struct XcdBarrier { unsigned* bar; unsigned x; volatile LAS unsigned* st; };
__device__ __forceinline__ XcdBarrier xcd_barrier_post(unsigned* bar, volatile LAS unsigned* st) {
    XcdBarrier b; b.bar = bar; b.x = xb_xcc_id(); b.st = st;
    if (threadIdx.x == 0) (void)xb_add(&bar[XB_XCNT(b.x)], 1u);
    return b;
}
__device__ __forceinline__ void xcd_barrier_complete(unsigned* bar, unsigned x, unsigned& nloc, unsigned& nx) {
    const unsigned G = gridDim.x * gridDim.y * gridDim.z;
    unsigned sum, cnt, mine, sp = 0u;
    for (;;) {
        sum = 0u; cnt = 0u; mine = 0u;
#pragma unroll
        for (unsigned j = 0; j < 16; ++j) { const unsigned c = xb_ld(&bar[XB_XCNT(j)]); sum += c; cnt += (c > 0u) ? 1u : 0u; mine = (j == x) ? c : mine; }
        if (sum == G) break;
        __builtin_amdgcn_s_sleep(1);
        if ((++sp & 255u) == 0u) { if (xb_ld(&bar[XB_TMO])) break; if (sp > XB_SPIN_CAP) { atomicAdd(&bar[XB_TMO], 1u); break; } }
    }
    nloc = mine > 0u ? mine : 1u; nx = cnt > 0u ? cnt : 1u;
}
__device__ __forceinline__ void xcd_barrier(const XcdBarrier& b) {
    asm volatile("s_waitcnt vmcnt(0)" ::: "memory");
    __syncthreads();
    if (threadIdx.x == 0) {
        unsigned* bar = b.bar;
        __builtin_amdgcn_s_waitcnt(0);
        unsigned nloc = b.st[0], nx = b.st[1];
        if (nloc == 0u) { xcd_barrier_complete(bar, b.x, nloc, nx); b.st[0] = nloc; b.st[1] = nx; }
        const unsigned old = xb_add(&bar[XB_XSUB(b.x)], 1u);
        const unsigned gen = old / nloc;
        if (old + 1u == (gen + 1u) * nloc) {
            __builtin_amdgcn_fence(__ATOMIC_RELEASE, "agent");
            asm volatile("s_waitcnt vmcnt(0)" ::: "memory");
            const unsigned og = xb_add(&bar[XB_TOP], 1u);
            const unsigned tg = og / nx;
            if (og + 1u == (tg + 1u) * nx) xb_add(&bar[XB_TOPGEN], 1u);
            else XB_SPIN(xb_ld(&bar[XB_TOPGEN]) == tg, bar);
            __builtin_amdgcn_fence(__ATOMIC_ACQUIRE, "agent");
            xb_add(&bar[XB_XGEN(b.x)], 1u);
            asm volatile("s_waitcnt vmcnt(0)" ::: "memory");
        } else {
            XB_SPIN(xb_ld(&bar[XB_XGEN(b.x)]) == gen, bar);
            __builtin_amdgcn_fence(__ATOMIC_ACQUIRE, "agent");
            asm volatile("s_waitcnt vmcnt(0)" ::: "memory");
        }
    }
    __syncthreads();
}

struct Unit { const GAS bf16_t* Bt; int pm, pn, e, base, cnt, par; };
struct GemmDesc { const GAS bf16_t* A; int lda, ldb, K; };
__device__ __forceinline__ int uni(int v) { return __builtin_amdgcn_readfirstlane(v); }

struct DenseSched {
    static constexpr bool GATHER = false;
    const GAS bf16_t* Bt; int ldb, nM, nN, G, c;
    __device__ __forceinline__ bool next(int i, Unit& u) const {
        const int Lx = uni(i * G + c); if (Lx >= nM * nN) return false;
        const int nig = 8 * nN, gid = Lx / nig, fm = gid * 8, gsz = (nM - fm) < 8 ? (nM - fm) : 8, w = Lx % nig;
        u.pm = fm + (w % gsz); u.pn = w / gsz; u.e = 0; u.base = u.pm * 256; u.cnt = 256; u.par = -1;
        u.Bt = Bt + (size_t)u.pn * 256 * ldb; return true;
    }
    __device__ __forceinline__ int arow(const Unit& u, int r) const { return u.base + r; }
    __device__ __forceinline__ int orow(const Unit& u, int r) const { return u.base + r; }
    __device__ __forceinline__ int asg(const Unit& u, int r) const { return u.base + r; }
    __device__ __forceinline__ const GAS int* asg_ptr(const Unit&) const { return nullptr; }
    LAS int* idx;
};
struct MoeSched {
    static constexpr bool GATHER = true;
    const GAS bf16_t* W; size_t w_estride; int ldb; const GAS int* lists; const LAS int* tp; int nsub, G, c; bool up; LAS int* idx;
    const LAS int* utab;
    __device__ __forceinline__ int decode(int i) const {
        int Lx = i * G + c; const int ntile = tp[65]; if (Lx >= ntile * nsub) return -1;
        { const int base = Lx & ~255; if (base + 256 <= ntile * nsub) { const int w = Lx & 255; Lx = base + (w & 7) * 32 + (w >> 3); } }
        int e = 0;
#pragma unroll 1
        for (int s = 32; s >= 1; s >>= 1) if (e + s <= 64 && tp[e + s] * nsub <= Lx) e += s;
        if (e < 64 && tp[e + 1] * nsub <= Lx) e += 1;
        const int tpe = tp[e], w = Lx - tpe * nsub, ti = nsub == 4 ? (w >> 2) : (w >> 1), sub = nsub == 4 ? (w & 3) : (w & 1);
        return (ti << 12) | (sub << 8) | e;
    }
    __device__ __forceinline__ bool next(int i, Unit& u) const {
        const int v = uni(i < 128 ? utab[i] : decode(i)); if (v < 0) return false;
        const int e = v & 0xff, sub = (v >> 8) & 0xf, ti = v >> 12;
        u.e = e; u.pn = sub; u.pm = ti; u.base = ti * 256; u.cnt = 0; u.par = -1;
        u.Bt = W + (size_t)e * w_estride + (size_t)sub * 256 * ldb; return true;
    }
    __device__ __forceinline__ const GAS int* asg_ptr(const Unit& u) const { return lists + (size_t)u.e * T + u.base; }
    __device__ __forceinline__ int asg(const Unit& u, int r) const { return asg_ptr(u)[r]; }
    __device__ __forceinline__ int arow_of(int a) const {
        if (!up) return a;
        const int sh = a - 8 * T;
        return a < 8 * T ? (a >> 3) : (sh < T ? sh : T - 1);
    }
    __device__ __forceinline__ int arow(const Unit& u, int r) const { return arow_of(u.par >= 0 ? idx[u.par * 256 + r] : asg(u, r)); }
    __device__ __forceinline__ int orow(const Unit& u, int r) const { return u.par >= 0 ? idx[u.par * 256 + r] : asg(u, r); }
};
__device__ __forceinline__ void moe_build_tiles(LAS int* tp, const int* cnt, int wid) {
    if (wid == 0) { const int lane = fresh_lane(); const int n = (cnt[lane] + 255) >> 8; int v = n;
#pragma unroll
        for (int d = 1; d < 64; d <<= 1) { const int o = __builtin_amdgcn_ds_bpermute((lane - d) * 4, v); v += (lane >= d) ? o : 0; }
        tp[lane] = v - n; if (lane == 63) { tp[64] = v; tp[65] = v + T / 256; } }
    __syncthreads();
}
__device__ __forceinline__ void moe_build_units(const MoeSched& sc, LAS int* utab, int wid) {
    const int tid = wid * 64 + fresh_lane();
    if (tid < 128) utab[tid] = sc.decode(tid);
    __syncthreads();
}
template <bool PERM, bool F8 = false, class Sch, class Epi>
__device__ __forceinline__ void gemm_naive(LAS unsigned char* lds, int wid_in, const GemmDesc g, const Sch& Sc, const Epi& E) {
    const int tid = wid_in * 64 + fresh_lane(), wid = tid >> 6, lane = tid & 63, wr = wid >> 2, wc = wid & 3, fr = lane & 15, fq = lane >> 4;
    constexpr int LP = 260;
    LAS float* As = (LAS float*)lds; LAS float* Bs = As + 32 * LP;
    const int sr = tid >> 1, kh = tid & 1;
    Unit u;
    for (int i = 0; Sc.next(i, u); ++i) {
        f32x4 acc[2][2][4][2];
#pragma unroll
        for (int a = 0; a < 2; ++a)
#pragma unroll
            for (int b = 0; b < 2; ++b)
#pragma unroll
                for (int m = 0; m < 4; ++m)
#pragma unroll
                    for (int n = 0; n < 2; ++n) acc[a][b][m][n] = (f32x4){0.f, 0.f, 0.f, 0.f};
        const GAS bf16_t* ap = g.A + (size_t)Sc.arow(u, sr) * g.lda + kh * 16;
        const GAS bf16_t* bp = u.Bt + (size_t)sr * g.ldb + kh * 16;
        for (int k0 = 0; k0 < g.K; k0 += 32) {
            const u32x4 a0 = *(const GAS u32x4*)(ap + k0), a1 = *(const GAS u32x4*)(ap + k0 + 8);
            const u32x4 b0 = *(const GAS u32x4*)(bp + k0), b1 = *(const GAS u32x4*)(bp + k0 + 8);
            __syncthreads();
#pragma unroll
            for (int j = 0; j < 4; ++j) {
                As[(kh * 16 + 2 * j) * LP + sr] = bflo(a0[j]); As[(kh * 16 + 2 * j + 1) * LP + sr] = bfhi(a0[j]);
                As[(kh * 16 + 8 + 2 * j) * LP + sr] = bflo(a1[j]); As[(kh * 16 + 9 + 2 * j) * LP + sr] = bfhi(a1[j]);
                Bs[(kh * 16 + 2 * j) * LP + sr] = bflo(b0[j]); Bs[(kh * 16 + 2 * j + 1) * LP + sr] = bfhi(b0[j]);
                Bs[(kh * 16 + 8 + 2 * j) * LP + sr] = bflo(b1[j]); Bs[(kh * 16 + 9 + 2 * j) * LP + sr] = bfhi(b1[j]);
            }
            __syncthreads();
#pragma unroll 4
            for (int kk = 0; kk < 32; ++kk) {
                float av[2][4]; f32x4 bv[2][2];
#pragma unroll
                for (int ai = 0; ai < 2; ++ai)
#pragma unroll
                    for (int m = 0; m < 4; ++m) av[ai][m] = As[kk * LP + 128 * ai + 64 * wr + 16 * m + fr];
#pragma unroll
                for (int bj = 0; bj < 2; ++bj)
#pragma unroll
                    for (int n = 0; n < 2; ++n) bv[bj][n] = *(const LAS f32x4*)&Bs[kk * LP + 128 * bj + 32 * wc + (PERM ? 8 * fq + 4 * n : 16 * n + 4 * fq)];
#pragma unroll
                for (int ai = 0; ai < 2; ++ai)
#pragma unroll
                    for (int bj = 0; bj < 2; ++bj)
#pragma unroll
                        for (int m = 0; m < 4; ++m)
#pragma unroll
                            for (int n = 0; n < 2; ++n) acc[ai][bj][m][n] += bv[bj][n] * av[ai][m];
            }
        }
        E(acc, u, Sc, wr, wc, fr, fq);
    }
    __syncthreads();
}

constexpr int HTB = 128 * 64 * 2;
__device__ __forceinline__ int lds_byte(int r, int c) { const int st = (r >> 4) * 2 + (c >> 5), rr = r & 15, cc = c & 31, ob = rr * 64 + cc * 2; return st * 1024 + (ob ^ (((ob >> 9) & 1) << 5)); }
__device__ __forceinline__ void stage_rc(int b, int& R, int& C) { const int st = b / 1024, sb = b % 1024, swz = sb ^ (((sb >> 9) & 1) << 5); R = (st >> 1) * 16 + swz / 64; C = (st & 1) * 32 + (swz % 64) / 2; }
__device__ __forceinline__ int perm32(int rho) { const int n = rho >> 4, i = rho & 15; return 8 * (i >> 2) + 4 * n + (i & 3); }
template <class Sch> __device__ __forceinline__ void calc_voff(const Sch& Sc, const Unit& u, int tid, int ldaB  , unsigned (&vo)[2][2]) {
#pragma unroll
    for (int i = 0; i < 2; ++i) { int R, C; stage_rc(tid * 16 + i * 8192, R, C);
#pragma unroll
        for (int h = 0; h < 2; ++h) vo[h][i] = (unsigned)(Sc.arow(u, h * 128 + R) * ldaB + 2 * C); }
}
typedef int i32x8 __attribute__((ext_vector_type(8)));
#ifndef GEMM_SP2
#define GEMM_SP2 true
#endif
#ifndef GEMM_ALIGN
#define GEMM_ALIGN true
#endif
template <bool PERM, bool F8 = false, class Sch, class Epi>
__device__ __forceinline__ void gemm_mfma(LAS unsigned char* lds, int wid_in, const GemmDesc g, const Sch& Sc, const Epi& E) {
    constexpr bool SP2 = GEMM_SP2, ALIGN = GEMM_ALIGN;
    constexpr bool GA = Sch::GATHER; constexpr int ESZ = F8 ? 1 : 2;
    const int wid = __builtin_amdgcn_readfirstlane(wid_in), lane = fresh_lane(), tid = wid * 64 + lane, wr = wid >> 2, wc = wid & 3, fr = lane & 15, fq = lane >> 4;
    int nt = g.K * ESZ / 128; asm volatile("" : "+s"(nt));
    const int ldaB = g.lda * ESZ, ldbB = g.ldb * ESZ;
    unsigned voffB[2], va[2];
#pragma unroll
    for (int i = 0; i < 2; ++i) { int R, C; stage_rc(tid * 16 + i * 8192, R, C); const int Rb = PERM ? ((R & ~31) + perm32(R & 31)) : R; voffB[i] = (unsigned)(Rb * ldbB + 2 * C); va[i] = (unsigned)(R * ldaB + 2 * C); }
    const unsigned hstepB = (unsigned)(128 * ldbB), hstepA = (unsigned)(128 * ldaB);
    const unsigned ldsw = (unsigned)wid * 1024u;
    const int aoff = lds_byte(wr * 64 + fr, fq * 8), boff = lds_byte(wc * 32 + fr, fq * 8);
    constexpr int KST = 1024;
    const GAS char* gA = (const GAS char*)g.A;
#define G_SA(b, h) (((b) * 2 + (h)) * HTB)
#define G_SB(b, h) ((4 + (b) * 2 + (h)) * HTB)
#define G_STAGE_A(bufoff, h, kb) do { const GAS char* _sb = GA ? (gA + (size_t)(kb)) : (uA + (size_t)(((h) ? hstepA : 0u) + (kb)));     \
        _Pragma("unroll") for (int _i = 0; _i < 2; ++_i) { \
        const GAS char* _p = _sb + (GA ? cvo[h][_i] : va[_i]); \
        __builtin_amdgcn_global_load_lds((const GAS unsigned*)_p, (LAS unsigned*)(lds + (bufoff) + ldsw + _i * 8192), 16, 0, 0); } } while (0)
#define G_STAGE_B(bufoff, bp) do { _Pragma("unroll") for (int _i = 0; _i < 2; ++_i) \
        __builtin_amdgcn_global_load_lds((const GAS unsigned*)((bp) + voffB[_i]), (LAS unsigned*)(lds + (bufoff) + ldsw + _i * 8192), 16, 0, 0); } while (0)
#define G_LDA(dst, b, h) do { _Pragma("unroll") for (int m = 0; m < 4; ++m) _Pragma("unroll") for (int k = 0; k < 2; ++k) dst[m][k] = *(const LAS bf16x8*)(lds + G_SA(b, h) + aoff + m * 2048 + k * KST); } while (0)
#define G_LDB(dst, b, h) do { _Pragma("unroll") for (int n = 0; n < 2; ++n) _Pragma("unroll") for (int k = 0; k < 2; ++k) dst[n][k] = *(const LAS bf16x8*)(lds + G_SB(b, h) + boff + n * 2048 + k * KST); } while (0)
#define G_MMA(ai, bj, At, Bt) do { __builtin_amdgcn_s_setprio(1); \
        if constexpr (F8) { _Pragma("unroll") for (int m = 0; m < 4; ++m) _Pragma("unroll") for (int n = 0; n < 2; ++n) { \
            const u32x4 b0_ = __builtin_bit_cast(u32x4, Bt[n][0]), b1_ = __builtin_bit_cast(u32x4, Bt[n][1]), a0_ = __builtin_bit_cast(u32x4, At[m][0]), a1_ = __builtin_bit_cast(u32x4, At[m][1]); \
            const i32x8 bb_ = {(int)b0_.x, (int)b0_.y, (int)b0_.z, (int)b0_.w, (int)b1_.x, (int)b1_.y, (int)b1_.z, (int)b1_.w}, aa_ = {(int)a0_.x, (int)a0_.y, (int)a0_.z, (int)a0_.w, (int)a1_.x, (int)a1_.y, (int)a1_.z, (int)a1_.w}; \
            acc[ai][bj][m][n] = __builtin_amdgcn_mfma_scale_f32_16x16x128_f8f6f4(bb_, aa_, acc[ai][bj][m][n], 0, 0, 0, 0x7f7f7f7f, 0, 0x7f7f7f7f); } } \
        else { _Pragma("unroll") for (int m = 0; m < 4; ++m) _Pragma("unroll") for (int n = 0; n < 2; ++n) _Pragma("unroll") for (int k = 0; k < 2; ++k) \
            acc[ai][bj][m][n] = __builtin_amdgcn_mfma_f32_16x16x32_bf16(Bt[n][k], At[m][k], acc[ai][bj][m][n], 0, 0, 0); } \
        __builtin_amdgcn_s_setprio(0); } while (0)
#define G_WAIT_V(n) asm volatile("s_waitcnt vmcnt(" #n ")" ::: "memory")
#define G_WAIT_VN(N) asm volatile("s_waitcnt vmcnt(%0)" :: "n"(N) : "memory")
#define G_WAIT_VSEL(N) asm volatile("s_cmp_eq_u32 %0, 0\n\ts_cbranch_scc1 1f\n\ts_waitcnt vmcnt(8)\n\ts_branch 2f\n1:\n\ts_waitcnt vmcnt(%1)\n2:" :: "s"(t), "n"(N) : "memory", "scc")
#define G_WAIT_L(n) asm volatile("s_waitcnt lgkmcnt(" #n ")" ::: "memory")
#define G_BAR __builtin_amdgcn_s_barrier()
#define G_SCHED __builtin_amdgcn_sched_barrier(0)
    Unit cur, nxt; int ui = 0;
    if (!Sc.next(0, cur)) return;
    f32x4 acc[2][2][4][2];
    { float z = 0.f; asm volatile("" : "+v"(z));
#pragma unroll
    for (int a = 0; a < 2; ++a)
#pragma unroll
        for (int b = 0; b < 2; ++b)
#pragma unroll
            for (int m = 0; m < 4; ++m)
#pragma unroll
                for (int n = 0; n < 2; ++n) acc[a][b][m][n] = (f32x4){z, z, z, z}; }
    bf16x8 At[4][2], B0[2][2], B1[2][2];
    unsigned cvo[2][2] = {{0u, 0u}, {0u, 0u}};
    const GAS char* uA = gA;
    bool has_next = Sc.next(1, nxt);
    if constexpr (GA) {
        cur.par = 0; nxt.par = 1;
        { Unit u2; const bool h2 = has_next && Sc.next(2, u2);
          if (wid < 4) { __builtin_amdgcn_global_load_lds((const GAS unsigned*)(Sc.asg_ptr(cur) + tid), (LAS unsigned*)(Sc.idx + wid * 64), 4, 0, 0);
              if (has_next) __builtin_amdgcn_global_load_lds((const GAS unsigned*)(Sc.asg_ptr(nxt) + tid), (LAS unsigned*)(Sc.idx + 256 + wid * 64), 4, 0, 0);
              if (h2) __builtin_amdgcn_global_load_lds((const GAS unsigned*)(Sc.asg_ptr(u2) + tid), (LAS unsigned*)(Sc.idx + 512 + wid * 64), 4, 0, 0); } }
        asm volatile("s_waitcnt vmcnt(0)" ::: "memory");
        __syncthreads();
        calc_voff(Sc, cur, tid, ldaB, cvo);
    } else {
        uA = gA + (size_t)Sc.arow(cur, 0) * ldaB;
    }
    const GAS char* cB = (const GAS char*)cur.Bt;
    G_STAGE_B(G_SB(0, 0), cB); G_STAGE_B(G_SB(0, 1), cB + hstepB); G_STAGE_A(G_SA(0, 0), 0, 0u); G_STAGE_A(G_SA(0, 1), 1, 0u);
    if (wr == 1) G_BAR;
    G_WAIT_V(2); G_BAR;
    G_STAGE_B(G_SB(1, 0), cB + 128); G_STAGE_A(G_SA(1, 0), 0, 128u); G_STAGE_B(G_SB(1, 1), cB + hstepB + 128);
    G_WAIT_V(0); G_BAR;
    for (;;) {
        const GAS char* nB = has_next ? (const GAS char*)nxt.Bt : cB;
        const GAS char* nA = (!GA && has_next) ? gA + (size_t)Sc.arow(nxt, 0) * ldaB : uA;
#define G_ITER(W0, W1) do { \
            const bool last = (t == nt - 2); \
            const unsigned k1 = (unsigned)(t + 1) * 128u, k2 = last ? 0u : (unsigned)(t + 2) * 128u, k3 = k2 + 128u; \
            const GAS char* b2 = last ? nB : cB + (size_t)(t + 2) * 128; const GAS char* b3 = b2 + 128; \
              \
            G_LDB(B0, 0, 0); G_LDB(B1, 0, 1); G_SCHED; G_LDA(At, 0, 0); G_STAGE_A(G_SA(1, 1), 1, k1); \
            if (last) {     \
                if constexpr (GA) { if (has_next) calc_voff(Sc, nxt, wid * 64 + fresh_lane(), ldaB, cvo); } \
                else uA = nA; \
            } \
            G_WAIT_VSEL(W0); G_WAIT_L(0); G_BAR; G_MMA(0, 0, At, B0); G_MMA(0, 1, At, B1); G_BAR; G_SCHED; \
              \
            G_LDA(At, 0, 1); G_STAGE_B(G_SB(0, 0), b2); G_STAGE_B(G_SB(0, 1), b2 + hstepB); G_STAGE_A(G_SA(0, 0), 0, k2); \
            G_WAIT_VSEL(W1); G_WAIT_L(0); G_BAR; G_MMA(1, 0, At, B0); G_MMA(1, 1, At, B1); G_BAR; G_SCHED; \
              \
            G_LDB(B0, 1, 0); G_LDB(B1, 1, 1); G_SCHED; G_LDA(At, 1, 0); G_STAGE_A(G_SA(0, 1), 1, k2); \
            G_WAIT_VN(8); G_WAIT_L(0); G_BAR; G_MMA(0, 0, At, B0); G_MMA(0, 1, At, B1); G_BAR; G_SCHED; \
              \
            G_LDA(At, 1, 1); G_STAGE_B(G_SB(1, 0), b3); G_STAGE_B(G_SB(1, 1), b3 + hstepB); G_STAGE_A(G_SA(1, 0), 0, k3); \
            G_WAIT_VN(8); G_WAIT_L(0); G_BAR; G_MMA(1, 0, At, B0); G_MMA(1, 1, At, B1); G_BAR; G_SCHED; } while (0)
        for (int t = 0; t < nt; t += 2) G_ITER(Epi::E_MIN + 8, Epi::E_MIN + 8);
#undef G_ITER
        if constexpr (ALIGN) { if (wr == 0) G_BAR; }
        { const int l2 = fresh_lane();
          if constexpr (GA) { Unit pf; const bool has_pf = Sc.next(ui + 3, pf);
              if (has_pf && wid < 4) __builtin_amdgcn_global_load_lds((const GAS unsigned*)(Sc.asg_ptr(pf) + wid * 64 + l2), (LAS unsigned*)(Sc.idx + ((ui + 3) & 3) * 256 + wid * 64), 4, 0, 0); }
          E(acc, cur, Sc, wr, wc, l2 & 15, l2 >> 4); }
        if (!has_next) break;
        cur = nxt; cB = nB; ++ui;
        if constexpr (ALIGN) { if (wr == 1) G_BAR; }
        has_next = Sc.next(ui + 1, nxt);
        if constexpr (GA) nxt.par = (ui + 1) & 3;
        { float z = 0.f; asm volatile("" : "+v"(z));
#pragma unroll
        for (int a = 0; a < 2; ++a)
#pragma unroll
            for (int b = 0; b < 2; ++b)
#pragma unroll
                for (int m = 0; m < 4; ++m)
#pragma unroll
                    for (int n = 0; n < 2; ++n) acc[a][b][m][n] = (f32x4){z, z, z, z}; }
    }
    G_WAIT_V(0);
    if constexpr (!ALIGN) { if (wr == 0) G_BAR; }
    G_BAR;
#undef G_SA
#undef G_SB
#undef G_STAGE_A
#undef G_STAGE_B
#undef G_LDA
#undef G_LDB
#undef G_MMA
#undef G_WAIT_V
#undef G_WAIT_VN
#undef G_WAIT_VSEL
#undef G_WAIT_L
#undef G_BAR
#undef G_SCHED
}

#define EPI_ROWS(ai, m) (128 * (ai) + 64 * wr + 16 * (m) + fr)
struct EpiP {
    static constexpr bool PERM = true; static constexpr int E_MIN = 16;
    bf16_t* P;
    template <class Sch> __device__ __forceinline__ void operator()(const f32x4 (&acc)[2][2][4][2], const Unit& u, const Sch& Sc, int wr, int wc, int fr, int fq) const {
#pragma unroll
        for (int ai = 0; ai < 2; ++ai)
#pragma unroll
            for (int m = 0; m < 4; ++m) { bf16_t* rp = P + (size_t)Sc.orow(u, EPI_ROWS(ai, m)) * 1024 + u.pn * 256 + 32 * wc + 8 * fq;
#pragma unroll
                for (int bj = 0; bj < 2; ++bj) store8_bf16(rp + 128 * bj, acc[ai][bj][m][0], acc[ai][bj][m][1]); asm volatile("" ::: "memory"); }
    }
};
struct EpiQ {
    static constexpr bool PERM = true; static constexpr int E_MIN = 8;
    bf16_t* Q; const float* rsq; const f32x2* cs;
    template <class Sch> __device__ __forceinline__ void operator()(const f32x4 (&acc)[2][2][4][2], const Unit& u, const Sch& Sc, int wr, int wc, int fr, int fq) const {
        float rs[8];
#pragma unroll
        for (int i = 0; i < 8; ++i) rs[i] = rsq[Sc.orow(u, EPI_ROWS(i >> 2, i & 3))];
        if (u.pn < 3) {
#pragma unroll
            for (int ai = 0; ai < 2; ++ai)
#pragma unroll
                for (int m = 0; m < 4; ++m) { const int row = Sc.orow(u, EPI_ROWS(ai, m)); const float r1 = rs[ai * 4 + m];
#pragma unroll
                    for (int bj = 0; bj < 2; ++bj) store8_bf16(Q + (size_t)row * 1152 + (2 * u.pn + bj) * 192 + 32 * wc + 8 * fq, acc[ai][bj][m][0] * r1, acc[ai][bj][m][1] * r1); }
        } else {
            const int head = (u.pn == 3) ? wc : 4 + wc;
            if (head < NH) {
                f32x4 cq[2][4];
                { const f32x4* cp = (const f32x4*)(cs + (size_t)Sc.orow(u, EPI_ROWS(0, 0)) * 32 + 8 * fq); cq[0][0] = cp[0]; cq[0][1] = cp[1]; cq[0][2] = cp[2]; cq[0][3] = cp[3]; }
#pragma unroll
                for (int i = 0; i < 8; ++i) { const int ai = i >> 2, m = i & 3, cb = i & 1;
                    if (i + 1 < 8) { const f32x4* cp = (const f32x4*)(cs + (size_t)Sc.orow(u, EPI_ROWS((i + 1) >> 2, (i + 1) & 3)) * 32 + 8 * fq); cq[cb ^ 1][0] = cp[0]; cq[cb ^ 1][1] = cp[1]; cq[cb ^ 1][2] = cp[2]; cq[cb ^ 1][3] = cp[3]; }
                    const int row = Sc.orow(u, EPI_ROWS(ai, m)); const float r1 = rs[i];
                    f32x4 lo[2], hi[2];
#pragma unroll
                    for (int n = 0; n < 2; ++n)
#pragma unroll
                        for (int j = 0; j < 4; ++j) { const f32x4 cv = cq[cb][2 * n + (j >> 1)]; const float co = cv[2 * (j & 1)], sn = cv[2 * (j & 1) + 1]; const float x1 = acc[ai][0][m][n][j], x2 = acc[ai][1][m][n][j];
                            lo[n][j] = (x1 * co - x2 * sn) * r1; hi[n][j] = (x2 * co + x1 * sn) * r1; }
                    bf16_t* qp = Q + (size_t)row * 1152 + head * 192 + 128 + 8 * fq;
                    store8_bf16(qp, lo[0], lo[1]); store8_bf16(qp + 32, hi[0], hi[1]); }
            }
        }
    }
};
struct EpiKV {
    static constexpr bool PERM = true; static constexpr int E_MIN = 24;
    bf16_t* Kf; bf16_t* V; const float* rskv;
    template <class Sch> __device__ __forceinline__ void operator()(const f32x4 (&acc)[2][2][4][2], const Unit& u, const Sch& Sc, int wr, int wc, int fr, int fq) const {
        float rs[8];
#pragma unroll
        for (int i = 0; i < 8; ++i) rs[i] = rskv[Sc.orow(u, EPI_ROWS(i >> 2, i & 3))];
#pragma unroll
        for (int ai = 0; ai < 2; ++ai)
#pragma unroll
            for (int m = 0; m < 4; ++m) {
                const int row = Sc.orow(u, EPI_ROWS(ai, m)); const float r1 = rs[ai * 4 + m];
                store8_bf16(Kf + (size_t)row * 1152 + u.pn * 192 + 32 * wc + 8 * fq, acc[ai][0][m][0] * r1, acc[ai][0][m][1] * r1);
                store8_bf16(V + (size_t)row * 768 + u.pn * 128 + 32 * wc + 8 * fq, acc[ai][1][m][0] * r1, acc[ai][1][m][1] * r1);
            }
    }
};
struct EpiOut {
    static constexpr bool PERM = true; static constexpr int E_MIN = 36;
    bf16_t* x; const float* g1;
    template <class Sch> __device__ __forceinline__ void operator()(const f32x4 (&acc)[2][2][4][2], const Unit& u, const Sch& Sc, int wr, int wc, int fr, int fq) const {
        const int b = (u.pm * 256) / S; const int col0 = u.pn * 256 + 32 * wc + 8 * fq;
        f32x4 gv[2][2];
#pragma unroll
        for (int bj = 0; bj < 2; ++bj)
#pragma unroll
            for (int n = 0; n < 2; ++n) gv[bj][n] = *(const f32x4*)(g1 + (size_t)b * 6144 + col0 + 128 * bj + 4 * n);
        u32x4 xv[2][2];
        { const size_t off = (size_t)Sc.orow(u, EPI_ROWS(0, 0)) * 1024 + col0; xv[0][0] = *(const u32x4*)(x + off); xv[0][1] = *(const u32x4*)(x + off + 128); }
#pragma unroll
        for (int i = 0; i < 8; ++i) { const int ai = i >> 2, m = i & 3, cb = i & 1;
            if (i + 1 < 8) { const size_t offn = (size_t)Sc.orow(u, EPI_ROWS((i + 1) >> 2, (i + 1) & 3)) * 1024 + col0; xv[cb ^ 1][0] = *(const u32x4*)(x + offn); xv[cb ^ 1][1] = *(const u32x4*)(x + offn + 128); }
            const size_t off = (size_t)Sc.orow(u, EPI_ROWS(ai, m)) * 1024 + col0;
#pragma unroll
            for (int bj = 0; bj < 2; ++bj) { const u32x4 w = xv[cb][bj];
                const f32x4 x0 = {bflo(w.x), bfhi(w.x), bflo(w.y), bfhi(w.y)}, x1 = {bflo(w.z), bfhi(w.z), bflo(w.w), bfhi(w.w)};
                store8_bf16(x + off + 128 * bj, x0 * ALPHA + gv[bj][0] * acc[ai][bj][m][0], x1 * ALPHA + gv[bj][1] * acc[ai][bj][m][1]); }
        }
    }
};
struct EpiRouter {
    static constexpr int E_MIN = 0; static constexpr bool PERM = false;
    float* logits;
    template <class Sch> __device__ __forceinline__ void operator()(const f32x4 (&acc)[2][2][4][2], const Unit& u, const Sch& Sc, int wr, int wc, int fr, int fq) const {
        if (wc < 2) {
#pragma unroll
            for (int ai = 0; ai < 2; ++ai)
#pragma unroll
                for (int m = 0; m < 4; ++m) { float* rp = logits + (size_t)Sc.orow(u, EPI_ROWS(ai, m)) * 64 + 32 * wc + 4 * fq;
#pragma unroll
                    for (int n = 0; n < 2; ++n) *(f32x4*)(rp + 16 * n) = acc[ai][0][m][n]; }
        }
    }
};
struct EpiSwiglu {
    static constexpr bool PERM = true; static constexpr int E_MIN = 8;
    unsigned char* act;
    template <class Sch> __device__ __forceinline__ void operator()(const f32x4 (&acc)[2][2][4][2], const Unit& u, const Sch& Sc, int wr, int wc, int fr, int fq) const {
#pragma unroll
        for (int ai = 0; ai < 2; ++ai)
#pragma unroll
            for (int m = 0; m < 4; ++m) { f32x4 o[2];
#pragma unroll
                for (int n = 0; n < 2; ++n)
#pragma unroll
                    for (int j = 0; j < 4; ++j) { const float gt = acc[ai][0][m][n][j] * (1.f / 32.f), up = acc[ai][1][m][n][j] * (1.f / 32.f); o[n][j] = gt * __builtin_amdgcn_rcpf(1.f + __expf(-gt)) * up; }
                u32x2 w; w.x = pk4_fp8(o[0][0], o[0][1], o[0][2], o[0][3]); w.y = pk4_fp8(o[1][0], o[1][1], o[1][2], o[1][3]);
                *(u32x2*)(act + (size_t)Sc.orow(u, EPI_ROWS(ai, m)) * 256 + u.pn * 128 + 32 * wc + 8 * fq) = w; }
    }
};
struct EpiDown {
    static constexpr bool PERM = true; static constexpr int E_MIN = 8;
    unsigned char* Y; LAS unsigned char* xb;
    template <class Sch> __device__ __forceinline__ void operator()(const f32x4 (&acc)[2][2][4][2], const Unit& u, const Sch& Sc, int wr, int wc, int fr, int fq) const {
        const int lane = fq * 16 + fr;
        const int row = 4 * wc + (lane >> 4), ch = lane & 15;
        int rid[8];
#pragma unroll
        for (int i = 0; i < 8; ++i) rid[i] = Sc.orow(u, 128 * (i >> 2) + 64 * wr + 16 * (i & 3) + row);
#pragma unroll
        for (int i = 0; i < 8; ++i) { const int ai = i >> 2, m = i & 3;
            LAS unsigned char* buf = xb + (i & 1) * 8192 + wr * 4096;
#pragma unroll
            for (int bj = 0; bj < 2; ++bj) { const f32x4 a = acc[ai][bj][m][0] * 0.5f, b = acc[ai][bj][m][1] * 0.5f;
                u32x2 w; w.x = pk4_fp8(a[0], a[1], a[2], a[3]); w.y = pk4_fp8(b[0], b[1], b[2], b[3]);
                const int cidx = 8 * bj + 2 * wc + (fq >> 1);
                *(LAS u32x2*)(buf + fr * 256 + ((cidx ^ fr) & 15) * 16 + (fq & 1) * 8) = w; }
            asm volatile("s_waitcnt lgkmcnt(0)" ::: "memory"); __builtin_amdgcn_s_barrier(); asm volatile("" ::: "memory");
            const u32x4 o = *(const LAS u32x4*)(buf + row * 256 + ((ch ^ row) & 15) * 16);
            __builtin_nontemporal_store(o, (u32x4*)(Y + (size_t)rid[i] * 1024 + u.pn * 256 + 16 * ch));
        }
    }
};

__device__ __forceinline__ void xpose_item(const float* src, int ld, bf16_t* dst, int Kdst, const float* kscale  , float mul, LAS float* scr, int lane) {
#pragma unroll 8
    for (int i = 0; i < 32; ++i) { const int kk = 2 * i + (lane >> 5); float v = src[(size_t)kk * ld + (lane & 31)]; if (kscale) v *= kscale[kk]; scr[kk * 33 + (lane & 31)] = v * mul; }
    asm volatile("s_waitcnt lgkmcnt(0)" ::: "memory");
    const int c = lane & 7;
#pragma unroll
    for (int j = 0; j < 4; ++j) { const int n = (lane >> 3) + 8 * j; const LAS float* s = scr + (8 * c) * 33 + n;
        u32x4 o; o.x = cvt_pk_bf16(s[0 * 33], s[1 * 33]); o.y = cvt_pk_bf16(s[2 * 33], s[3 * 33]); o.z = cvt_pk_bf16(s[4 * 33], s[5 * 33]); o.w = cvt_pk_bf16(s[6 * 33], s[7 * 33]);
        *(u32x4*)(dst + (size_t)n * Kdst + 8 * c) = o; }
    asm volatile("s_waitcnt lgkmcnt(0)" ::: "memory");
}
__device__ __forceinline__ void xpose_item_f8(const float* src, int ld, unsigned char* dst, int Kdst, float mul, LAS float* scr, int lane) {
#pragma unroll 8
    for (int i = 0; i < 32; ++i) { const int kk = 2 * i + (lane >> 5); scr[kk * 33 + (lane & 31)] = src[(size_t)kk * ld + (lane & 31)] * mul; }
    asm volatile("s_waitcnt lgkmcnt(0)" ::: "memory");
    const int n = lane >> 1, h = lane & 1; const LAS float* s = scr + (32 * h) * 33 + n;
    u32x4 o0, o1;
    o0.x = pk4_fp8(s[0 * 33], s[1 * 33], s[2 * 33], s[3 * 33]); o0.y = pk4_fp8(s[4 * 33], s[5 * 33], s[6 * 33], s[7 * 33]); o0.z = pk4_fp8(s[8 * 33], s[9 * 33], s[10 * 33], s[11 * 33]); o0.w = pk4_fp8(s[12 * 33], s[13 * 33], s[14 * 33], s[15 * 33]);
    o1.x = pk4_fp8(s[16 * 33], s[17 * 33], s[18 * 33], s[19 * 33]); o1.y = pk4_fp8(s[20 * 33], s[21 * 33], s[22 * 33], s[23 * 33]); o1.z = pk4_fp8(s[24 * 33], s[25 * 33], s[26 * 33], s[27 * 33]); o1.w = pk4_fp8(s[28 * 33], s[29 * 33], s[30 * 33], s[31 * 33]);
    *(u32x4*)(dst + (size_t)n * Kdst + 32 * h) = o0; *(u32x4*)(dst + (size_t)n * Kdst + 32 * h + 16) = o1;
    asm volatile("s_waitcnt lgkmcnt(0)" ::: "memory");
}
__device__ __forceinline__ void zero_rows(bf16_t* dst, size_t nelem, int gw, int ngw, int lane) {
    for (size_t i = ((size_t)gw * 64 + lane) * 8; i < nelem; i += (size_t)ngw * 64 * 8) *(u32x4*)(dst + i) = (u32x4){0u, 0u, 0u, 0u};
}
__device__ __forceinline__ int uq_srccol(int g) {
    const int n = 32 * g;
    if (n < 768) return (n / 128) * 192 + (n % 128);
    if (n < 1024) { const int q = n - 768, half = q / 128, hh = (q % 128) / 32; return hh * 192 + 128 + half * 32; }
    { const int q = n - 1024, half = q / 128, w = q % 128; if (w >= 64) return -1; return (4 + w / 32) * 192 + 128 + half * 32; }
}

struct Ctx { LAS unsigned char* lds; int tid, lane, wid, gw, ngw, G, bid; };

__device__ __forceinline__ void ph_prologue(const Params& p, const Ctx& c) {
    unsigned char* ws = p.ws;
    float* mod = (float*)(ws + WS_MOD);
    {
        LAS float* cond = (LAS float*)c.lds;
        LAS float* red = cond + 16 * 1024;
        for (int i = c.tid; i < 16 * 1024; i += NTHREADS) { const float v = p.c[i]; cond[(i & 1023) * 16 + (i >> 10)] = v / (1.f + __expf(-v)); }
        __syncthreads();
        const int cg = c.tid & 63, kq = c.wid;
        for (int u = c.bid; u < NL * 48; u += c.G) {
            const int l = u / 48, n0 = (u % 48) * 128;
            f32x2 acc[16];
#pragma unroll
            for (int b = 0; b < 16; ++b) acc[b] = (f32x2){0.f, 0.f};
            const float* wp = p.w_ada + ((size_t)l * 1024 + kq * 128) * 6144 + n0 + 2 * cg;
            const LAS f32x4* cq = (const LAS f32x4*)(cond + kq * 128 * 16);
#define ADA_LOAD(W, K0) _Pragma("unroll") for (int k = 0; k < 16; ++k) W[k] = *(const f32x2*)(wp + (size_t)((K0) + k) * 6144)
#define ADA_FMA(W, K0) _Pragma("unroll") for (int k = 0; k < 16; ++k) { _Pragma("unroll") for (int q4 = 0; q4 < 4; ++q4) { const f32x4 cv = cq[((K0) + k) * 4 + q4]; \
                        _Pragma("unroll") for (int j = 0; j < 4; ++j) acc[4 * q4 + j] += W[k] * cv[j]; } }
            { f32x2 w0[16], w1[16];
              ADA_LOAD(w0, 0);
#pragma unroll 1
              for (int k0 = 0; k0 < 128; k0 += 32) {
                  ADA_LOAD(w1, k0 + 16);
                  ADA_FMA(w0, k0);
                  { const int kn = k0 + 32 < 128 ? k0 + 32 : k0; ADA_LOAD(w0, kn); }
                  ADA_FMA(w1, k0 + 16);
              } }
#undef ADA_LOAD
#undef ADA_FMA
#pragma unroll
            for (int b = 0; b < 16; ++b) *(LAS f32x2*)(red + (kq * 16 + b) * 128 + 2 * cg) = acc[b];
            __syncthreads();
            for (int o = c.tid; o < 2048; o += NTHREADS) { const int b = o >> 7, n = o & 127; float sum = p.b_ada[l * 6144 + n0 + n];
#pragma unroll
                for (int q8 = 0; q8 < 8; ++q8) sum += red[(q8 * 16 + b) * 128 + n];
                mod[((size_t)l * 16 + b) * 6144 + n0 + n] = sum; }
            __syncthreads();
        }
    }
    {
        f32x2* cs = (f32x2*)(ws + WS_CS);
        for (int i = c.bid * NTHREADS + c.tid; i < T * 32; i += c.G * NTHREADS) {
            const int t = i >> 5, k = i & 31; const float inv = exp2f(-(float)k * (13.287712379549449f / 32.f)); const float ang = (float)p.pos[t] * inv;
            const float rev = ang * 0.15915494309189535f, fr = rev - floorf(rev);
            cs[i] = (f32x2){__builtin_amdgcn_cosf(fr), __builtin_amdgcn_sinf(fr)};
        }
    }
    {
        LAS float* scr = (LAS float*)(c.lds + c.wid * 16384);
        bf16_t* WinT = (bf16_t*)(ws + WS_WIN); bf16_t* WuqT = (bf16_t*)(ws + WS_WUQ); bf16_t* WukvT = (bf16_t*)(ws + WS_WUKV);
        bf16_t* WoutT = (bf16_t*)(ws + WS_WOUT); bf16_t* WrT = (bf16_t*)(ws + WS_WR);
        constexpr int I_IN = 30 * 16, I_UQ = 40 * 6, I_UKV = 48 * 4, I_OUT = 32 * 16, I_R = 2 * 16, I_L = I_IN + I_UQ + I_UKV + I_OUT + I_R;
        for (int it = c.gw; it < NL * I_L; it += c.ngw) {
            const int l = it / I_L; int r = it % I_L;
            if (r < I_IN) { const int g = r / 16, kb = r % 16; xpose_item(p.w_in + ((size_t)l * 1024 + 64 * kb) * INW + 32 * g, INW, WinT + ((size_t)l * 1024 + 32 * g) * 1024 + 64 * kb, 1024, nullptr, 1.f, scr, c.lane); continue; } r -= I_IN;
            if (r < I_UQ) { const int g = r / 6, kb = r % 6, sc = uq_srccol(g); bf16_t* dst = WuqT + ((size_t)l * 1280 + 32 * g) * 384 + 64 * kb;
                if (sc >= 0) xpose_item(p.w_uq + ((size_t)l * 384 + 64 * kb) * 1152 + sc, 1152, dst, 384, p.qg + l * 384 + 64 * kb, QSCALE, scr, c.lane);
                else { const int n = c.lane >> 1, h8 = (c.lane & 1) * 32; for (int q = 0; q < 4; ++q) *(u32x4*)(dst + (size_t)n * 384 + h8 + 8 * q) = (u32x4){0u, 0u, 0u, 0u}; }
                continue; } r -= I_UQ;
            if (r < I_UKV) { const int g = r / 4, kb = r % 4; xpose_item(p.w_ukv + ((size_t)l * 256 + 64 * kb) * 1536 + 32 * g, 1536, WukvT + ((size_t)l * 1536 + 32 * g) * 256 + 64 * kb, 256, p.kvg + l * 256 + 64 * kb, 1.f, scr, c.lane); continue; } r -= I_UKV;
            if (r < I_OUT) { const int g = r / 16, kb = r % 16; xpose_item(p.w_out + ((size_t)l * 1024 + 64 * kb) * 1024 + 32 * g, 1024, WoutT + ((size_t)l * 1024 + 32 * g) * 1024 + 64 * kb, 1024, nullptr, 1.f, scr, c.lane); continue; } r -= I_OUT;
            { const int g = r / 16, kb = r % 16; xpose_item(p.w_router + ((size_t)l * 1024 + 64 * kb) * 64 + 32 * g, 64, WrT + ((size_t)l * 256 + 32 * g) * 1024 + 64 * kb, 1024, nullptr, 1.f, scr, c.lane); }
        }
        for (int l = 0; l < NL; ++l) {
            zero_rows(WinT + ((size_t)l * 1024 + 960) * 1024, (size_t)64 * 1024, c.gw, c.ngw, c.lane);
            zero_rows(WrT + ((size_t)l * 256 + 64) * 1024, (size_t)192 * 1024, c.gw, c.ngw, c.lane);
        }
    }
}

#define RC(j) (512 * ((j) >> 1) + 8 * lane + 4 * ((j) & 1))
__device__ __forceinline__ void write_mod_row(const f32x4 (&v)[4], const float* sh, const float* sc, bf16_t* hrow, int lane, unsigned char* h8row = nullptr) {
    f32x4 o[4];
#pragma unroll
    for (int j = 0; j < 4; ++j) { const f32x4 s1 = *(const f32x4*)(sc + RC(j)), s0 = *(const f32x4*)(sh + RC(j)); o[j] = v[j] * (s1 + 1.f) + s0; }
    store8_bf16(hrow + RC(0), o[0], o[1]); store8_bf16(hrow + RC(2), o[2], o[3]);
    if (h8row) { u32x2 a, b; a.x = pk4_fp8(o[0][0], o[0][1], o[0][2], o[0][3]); a.y = pk4_fp8(o[1][0], o[1][1], o[1][2], o[1][3]); b.x = pk4_fp8(o[2][0], o[2][1], o[2][2], o[2][3]); b.y = pk4_fp8(o[3][0], o[3][1], o[3][2], o[3][3]);
        *(u32x2*)(h8row + RC(0)) = a; *(u32x2*)(h8row + RC(2)) = b; }
}
__device__ __forceinline__ void load_bf16_row(const bf16_t* yr, f32x4 (&f)[4], int lane) {
#pragma unroll
    for (int jj = 0; jj < 2; ++jj) { const u32x4 w = *(const u32x4*)(yr + RC(2 * jj)); f[2 * jj] = (f32x4){bflo(w.x), bfhi(w.x), bflo(w.y), bfhi(w.y)}; f[2 * jj + 1] = (f32x4){bflo(w.z), bfhi(w.z), bflo(w.w), bfhi(w.w)}; }
}
__device__ __forceinline__ void fma_fp8_row(const unsigned char* yr, float scale, f32x4 (&f)[4], int lane) {
#pragma unroll
    for (int jj = 0; jj < 2; ++jj) { const u32x2 w = *(const u32x2*)(yr + RC(2 * jj));
        const f32x2 a = __builtin_amdgcn_cvt_pk_f32_fp8((int)w.x, false), b = __builtin_amdgcn_cvt_pk_f32_fp8((int)w.x, true);
        const f32x2 c = __builtin_amdgcn_cvt_pk_f32_fp8((int)w.y, false), d = __builtin_amdgcn_cvt_pk_f32_fp8((int)w.y, true);
        f[2 * jj] += (f32x4){a[0], a[1], b[0], b[1]} * scale; f[2 * jj + 1] += (f32x4){c[0], c[1], d[0], d[1]} * scale; }
}

__device__ __forceinline__ void prep_tile_src(const Params& p, int l, int it, const float*& src, int& ld, unsigned char*& dst, int& Kdst, int& rmap) {
    const int e = it / 48, r = it % 48;
    unsigned char* Wgu = p.ws + WS_WGU; unsigned char* Wd = p.ws + WS_WD;
    const float* weg = p.weg; const float* weu = p.weu; const float* wsg = p.wsg; const float* wsu = p.wsu;
    asm volatile("" : "+s"(weg), "+s"(weu), "+s"(wsg), "+s"(wsu));
    if (r < 32) { const int half = r >> 4, q = r & 15, kb = q >> 1, nb = q & 1;
        const float* s0 = (e < 64) ? ((half ? weu : weg) + ((size_t)(l * 64 + e) * 1024) * 256) : ((half ? wsu : wsg) + (size_t)l * 1024 * 256);
        src = s0 + (size_t)(128 * kb) * 256 + 128 * nb; ld = 256; dst = Wgu + ((size_t)e * 512 + nb * 256 + half * 128) * 1024 + 128 * kb; Kdst = 1024; rmap = 0;
    } else { const int q = r - 32, kb = q >> 3, nb = q & 7;
        const float* s0 = (e < 64) ? (p.wed + ((size_t)(l * 64 + e) * 256) * 1024) : (p.wsd + (size_t)l * 256 * 1024);
        src = s0 + (size_t)(128 * kb) * 1024 + 128 * nb; ld = 1024; dst = Wd + ((size_t)e * 1024 + 128 * nb) * 256 + 128 * kb; Kdst = 256; rmap = 0; }
}
__device__ __forceinline__ void ph_prep(const Params& p, const Ctx& c, int l) {
    unsigned char* ws = p.ws;
    constexpr int PP = 129;
    LAS float* tl = (LAS float*)c.lds;
    LAS unsigned char* t2 = c.lds + 128 * PP * 4;
    const int tid = c.tid, r0 = tid >> 5, c4 = (tid & 31) * 4;
    const int NTILE = 65 * 48;
    f32x4 v[8];
    int it = c.bid;
    { const float* src; int ld, Kd, rm; unsigned char* dst; prep_tile_src(p, l, it < NTILE ? it : NTILE - 1, src, ld, dst, Kd, rm);
#pragma unroll
        for (int j = 0; j < 8; ++j) v[j] = *(const f32x4*)(src + (size_t)(r0 + 16 * j) * ld + c4); }
    for (; it < NTILE; it += c.G) {
        const float* src; int ld, Kd, rm; unsigned char* dst; prep_tile_src(p, l, it, src, ld, dst, Kd, rm);
#pragma unroll
        for (int j = 0; j < 8; ++j) { LAS float* w = tl + (r0 + 16 * j) * PP + c4; w[0] = v[j][0] * 32.f; w[1] = v[j][1] * 32.f; w[2] = v[j][2] * 32.f; w[3] = v[j][3] * 32.f; }
        { const int nx = (it + c.G < NTILE) ? it + c.G : it;
          const float* s2; int l2, K2, r2; unsigned char* d2; prep_tile_src(p, l, nx, s2, l2, d2, K2, r2);
#pragma unroll
          for (int j = 0; j < 8; ++j) v[j] = *(const f32x4*)(s2 + (size_t)(r0 + 16 * j) * l2 + c4); }
        __syncthreads();
#pragma unroll
        for (int h = 0; h < 2; ++h) { const int n = tid & 127, kc = (tid >> 7) + 4 * h; const LAS float* s = tl + (16 * kc) * PP + n; u32x4 o;
            o.x = pk4_fp8(s[0 * PP], s[1 * PP], s[2 * PP], s[3 * PP]); o.y = pk4_fp8(s[4 * PP], s[5 * PP], s[6 * PP], s[7 * PP]); o.z = pk4_fp8(s[8 * PP], s[9 * PP], s[10 * PP], s[11 * PP]); o.w = pk4_fp8(s[12 * PP], s[13 * PP], s[14 * PP], s[15 * PP]);
            *(LAS u32x4*)(t2 + n * 128 + ((kc ^ (n & 7)) * 16)) = o; }
        __syncthreads();
#pragma unroll
        for (int h = 0; h < 2; ++h) { const int n = (tid >> 3) + 64 * h, kc = tid & 7; const u32x4 o = *(const LAS u32x4*)(t2 + n * 128 + ((kc ^ (n & 7)) * 16));
            *(u32x4*)(dst + (size_t)n * Kd + 16 * kc) = o; }
        __syncthreads();
    }
    if (l == 0) {
        const float* mod = (const float*)(ws + WS_MOD); bf16_t* H = (bf16_t*)(ws + WS_H);
        for (int t = c.gw; t < T; t += c.ngw) { const int b = t / S; f32x4 v[4];
#pragma unroll
            for (int j = 0; j < 4; ++j) { const int lane = c.lane; v[j] = *(const f32x4*)(p.x + (size_t)t * 1024 + RC(j)); }
            write_mod_row(v, mod + (size_t)b * 6144 + 0, mod + (size_t)b * 6144 + 1024, H + (size_t)t * 1024, c.lane);
            { const int lane = c.lane; bf16_t* xr = (bf16_t*)(ws + WS_X16) + (size_t)t * 1024; store8_bf16(xr + RC(0), v[0], v[1]); store8_bf16(xr + RC(2), v[2], v[3]); } }
    }
}

__device__ __forceinline__ void acc8(float (&s)[8], const u32x4 w, float m) {
    s[0] += m * bflo(w.x); s[1] += m * bfhi(w.x); s[2] += m * bflo(w.y); s[3] += m * bfhi(w.y); s[4] += m * bflo(w.z); s[5] += m * bfhi(w.z); s[6] += m * bflo(w.w); s[7] += m * bfhi(w.w);
}
__device__ __forceinline__ float ssq8(const u32x4 w) {
    const float a = bflo(w.x), b = bfhi(w.x), c = bflo(w.y), d = bfhi(w.y), e = bflo(w.z), f = bfhi(w.z), g = bflo(w.w), h = bfhi(w.w);
    return (a * a + b * b) + (c * c + d * d) + (e * e + f * f) + (g * g + h * h);
}
__device__ __forceinline__ void ph_post_in(const Params& p, const Ctx& c, int l) {
    unsigned char* ws = p.ws;
    const GAS bf16_t* P = (const GAS bf16_t*)(ws + WS_P); GAS bf16_t* Kf = (GAS bf16_t*)(ws + WS_KF); GAS bf16_t* MIX = (GAS bf16_t*)(ws + WS_MIX);
    GAS float* rsq = (GAS float*)(ws + WS_RSQ); GAS float* rskv = (GAS float*)(ws + WS_RSKV); const GAS f32x2* cs = (const GAS f32x2*)(ws + WS_CS);
    constexpr int WTP = 72;
    LAS bf16_t* wT = (LAS bf16_t*)c.lds;
    for (int i = c.tid; i < 4 * 64 * 64; i += NTHREADS) { const int g = i >> 12, cc = (i >> 6) & 63, d = i & 63;
        wT[(g * 64 + d) * WTP + cc] = (bf16_t)(cvt_pk_bf16(p.w_pool[(size_t)l * 16384 + i], 0.f) & 0xffffu); }
    __syncthreads();
    const int lane = c.lane, r = lane & 15, q = lane >> 4;
    for (int task = c.gw; task < T / 16; task += c.ngw) {
        const int t = task * 16 + r, s = t % S;
        const GAS bf16_t* row = P + (size_t)t * 1024;
        float rq_, rk_; u32x4 wl, wh; u32x2 po[4][4];
        { float sq = 0.f, sk = 0.f;
#pragma unroll
          for (int j = 0; j < 12; ++j) sq += ssq8(*(const GAS u32x4*)(row + 256 + 96 * q + 8 * j));
#pragma unroll
          for (int j = 0; j < 8; ++j) sk += ssq8(*(const GAS u32x4*)(row + 640 + 64 * q + 8 * j));
          sq += SWZ_XOR(sq, 16); sk += SWZ_XOR(sk, 16);
          { const auto rr = __builtin_amdgcn_permlane32_swap(__float_as_uint(sq), __float_as_uint(sq), false, false); sq = __uint_as_float(rr[0]) + __uint_as_float(rr[1]); }
          { const auto rr = __builtin_amdgcn_permlane32_swap(__float_as_uint(sk), __float_as_uint(sk), false, false); sk = __uint_as_float(rr[0]) + __uint_as_float(rr[1]); }
          rq_ = 1.0f / sqrtf(sq * (1.f / 384.f) + RMS_EPS); rk_ = 1.0f / sqrtf(sk * (1.f / 256.f) + RMS_EPS); }
        { const u32x4 x1 = *(const GAS u32x4*)(row + 896 + 8 * q), x2 = *(const GAS u32x4*)(row + 928 + 8 * q);
          const GAS f32x4* cp = (const GAS f32x4*)(cs + (size_t)t * 32 + 8 * q);
          const f32x4 c0 = cp[0], c1 = cp[1], c2 = cp[2], c3 = cp[3];
          const float a[8] = {bflo(x1.x), bfhi(x1.x), bflo(x1.y), bfhi(x1.y), bflo(x1.z), bfhi(x1.z), bflo(x1.w), bfhi(x1.w)};
          const float b[8] = {bflo(x2.x), bfhi(x2.x), bflo(x2.y), bfhi(x2.y), bflo(x2.z), bfhi(x2.z), bflo(x2.w), bfhi(x2.w)};
          const float cc[8] = {c0[0], c0[2], c1[0], c1[2], c2[0], c2[2], c3[0], c3[2]}, sn[8] = {c0[1], c0[3], c1[1], c1[3], c2[1], c2[3], c3[1], c3[3]};
          f32x4 lo0, lo1, hi0, hi1;
#pragma unroll
          for (int j = 0; j < 4; ++j) { lo0[j] = a[j] * cc[j] - b[j] * sn[j]; hi0[j] = b[j] * cc[j] + a[j] * sn[j]; lo1[j] = a[4 + j] * cc[4 + j] - b[4 + j] * sn[4 + j]; hi1[j] = b[4 + j] * cc[4 + j] + a[4 + j] * sn[4 + j]; }
          wl.x = cvt_pk_bf16(lo0[0], lo0[1]); wl.y = cvt_pk_bf16(lo0[2], lo0[3]); wl.z = cvt_pk_bf16(lo1[0], lo1[1]); wl.w = cvt_pk_bf16(lo1[2], lo1[3]);
          wh.x = cvt_pk_bf16(hi0[0], hi0[1]); wh.y = cvt_pk_bf16(hi0[2], hi0[3]); wh.z = cvt_pk_bf16(hi1[0], hi1[1]); wh.w = cvt_pk_bf16(hi1[2], hi1[3]);
        }
#pragma unroll
        for (int g = 0; g < 4; ++g) {
            constexpr int dummy = 0; (void)dummy;
            const int w = 2 << g, cnt = (s + 1 < w) ? s + 1 : w; const float inv = 1.0f / (float)cnt;
            bf16x8 tmf[2];
#pragma unroll
            for (int ks = 0; ks < 2; ++ks) {
                const GAS bf16_t* up = row + 64 * g + 32 * ks + 8 * q;
                float sm[8];
#pragma unroll
                for (int j = 0; j < 8; ++j) sm[j] = 0.f;
                const u32x4 self = *(const GAS u32x4*)up;
                acc8(sm, self, 1.f);
#pragma unroll
                for (int jj = 1; jj < w; ++jj) { const bool ok = jj < cnt; const u32x4 v = *(const GAS u32x4*)(up - (size_t)(ok ? jj : 0) * 1024); acc8(sm, v, ok ? 1.f : 0.f); }
                float sf[8] = {0.f, 0.f, 0.f, 0.f, 0.f, 0.f, 0.f, 0.f}; acc8(sf, self, 1.f);
                u32x4 wv; wv.x = cvt_pk_bf16(sm[0] * inv - sf[0], sm[1] * inv - sf[1]); wv.y = cvt_pk_bf16(sm[2] * inv - sf[2], sm[3] * inv - sf[3]);
                wv.z = cvt_pk_bf16(sm[4] * inv - sf[4], sm[5] * inv - sf[5]); wv.w = cvt_pk_bf16(sm[6] * inv - sf[6], sm[7] * inv - sf[7]);
                tmf[ks] = *reinterpret_cast<bf16x8*>(&wv);
            }
#pragma unroll
            for (int nt = 0; nt < 4; ++nt) { f32x4 a4 = {0.f, 0.f, 0.f, 0.f};
#pragma unroll
                for (int ks = 0; ks < 2; ++ks) { const bf16x8 wf = *(const LAS bf16x8*)(wT + (g * 64 + 16 * nt + r) * WTP + 32 * ks + 8 * q);
                    a4 = __builtin_amdgcn_mfma_f32_16x16x32_bf16(wf, tmf[ks], a4, 0, 0, 0); }
                const f32x4 ps = *(const f32x4*)(p.pool_scale + l * 256 + 64 * g + 16 * nt + 4 * q);
                po[g][nt].x = cvt_pk_bf16(a4[0] * ps[0], a4[1] * ps[1]); po[g][nt].y = cvt_pk_bf16(a4[2] * ps[2], a4[3] * ps[3]); }
        }
        if (q == 0) { rsq[t] = rq_; rskv[t] = rk_; }
#pragma unroll
        for (int h = 0; h < NH; ++h) { GAS bf16_t* kp = Kf + (size_t)t * 1152 + h * 192 + 128 + 8 * q; *(GAS u32x4*)kp = wl; *(GAS u32x4*)(kp + 32) = wh; }
#pragma unroll
        for (int g = 0; g < 4; ++g)
#pragma unroll
            for (int nt = 0; nt < 4; ++nt) *(GAS u32x2*)(MIX + (size_t)t * 1024 + 64 * g + 16 * nt + 4 * q) = po[g][nt];
    }
}

__device__ __forceinline__ void ph_attn_naive(const Params& p, const Ctx& c) {
    unsigned char* ws = p.ws;
    const bf16_t* Q = (const bf16_t*)(ws + WS_Q); const bf16_t* Kf = (const bf16_t*)(ws + WS_KF); const bf16_t* V = (const bf16_t*)(ws + WS_V); bf16_t* MIX = (bf16_t*)(ws + WS_MIX);
    LAS float* qs = (LAS float*)(c.lds + c.wid * 8192);
    const int lane = c.lane;
    for (int item = c.bid; item < 96 * 32; item += c.G) {
        const int bh = item % 96, qb = 31 - item / 96, b = bh / NH, h = bh % NH;
        const int q0 = qb * 64 + c.wid * 8;
        for (int i = lane; i < 8 * 192; i += 64) { const int r = i / 192, d = i % 192; qs[i] = bf2f(Q[(size_t)(b * S + q0 + r) * 1152 + h * 192 + d]); }
        asm volatile("s_waitcnt lgkmcnt(0)" ::: "memory");
        float m[8], lsum[8], o0[8], o1[8];
#pragma unroll
        for (int r = 0; r < 8; ++r) { m[r] = -1e30f; lsum[r] = 0.f; o0[r] = 0.f; o1[r] = 0.f; }
        const int last = q0 + 7, nch = last / 64 + 1;
        for (int ch = 0; ch < nch; ++ch) {
            const int key = ch * 64 + lane; float sc[8];
#pragma unroll
            for (int r = 0; r < 8; ++r) sc[r] = 0.f;
            if (key <= last) {
                const bf16_t* kp = Kf + (size_t)(b * S + key) * 1152 + h * 192;
                for (int cc = 0; cc < 24; ++cc) { const u32x4 kw = *(const u32x4*)(kp + 8 * cc); float kf[8];
#pragma unroll
                    for (int j = 0; j < 4; ++j) { kf[2 * j] = bflo(kw[j]); kf[2 * j + 1] = bfhi(kw[j]); }
#pragma unroll
                    for (int r = 0; r < 8; ++r) { const f32x4 qa = *(const LAS f32x4*)&qs[r * 192 + 8 * cc], qb2 = *(const LAS f32x4*)&qs[r * 192 + 8 * cc + 4];
                        sc[r] += qa[0] * kf[0] + qa[1] * kf[1] + qa[2] * kf[2] + qa[3] * kf[3] + qb2[0] * kf[4] + qb2[1] * kf[5] + qb2[2] * kf[6] + qb2[3] * kf[7]; } }
            }
            float pr[8];
#pragma unroll
            for (int r = 0; r < 8; ++r) { const float sv = (key <= q0 + r) ? sc[r] : -__builtin_inff(); const float mx = wave_max(sv), mn = fmaxf(m[r], mx);
                const float al = __builtin_amdgcn_exp2f(m[r] - mn); const float pv = __builtin_amdgcn_exp2f(sv - mn);
                lsum[r] = lsum[r] * al + wave_sum(pv); o0[r] *= al; o1[r] *= al; m[r] = mn; pr[r] = pv; }
            const int kmax = (last - ch * 64 < 63) ? last - ch * 64 : 63;
            const bf16_t* vp = V + (size_t)(b * S + ch * 64) * 768 + h * 128 + 2 * lane;
            for (int kk = 0; kk <= kmax; ++kk) { const unsigned vw = *(const unsigned*)(vp + (size_t)kk * 768); const float v0 = bflo(vw), v1 = bfhi(vw);
#pragma unroll
                for (int r = 0; r < 8; ++r) { const float pk = __int_as_float(__builtin_amdgcn_readlane(__float_as_int(pr[r]), kk)); o0[r] += pk * v0; o1[r] += pk * v1; } }
        }
#pragma unroll
        for (int r = 0; r < 8; ++r) { const float il = 1.f / lsum[r];
            *(unsigned*)(MIX + (size_t)(b * S + q0 + r) * 1024 + 256 + h * 128 + 2 * lane) = cvt_pk_bf16(o0[r] * il, o1[r] * il); }
    }
}


namespace att {
typedef short s16x4 __attribute__((ext_vector_type(4)));
typedef float f32x16 __attribute__((ext_vector_type(16)));
constexpr int VB = 16384, KNB = 16384, KRB = 8192;
constexpr int O_V = 0, O_KN = 2 * VB, O_KR = O_KN + 2 * KNB, O_WS = O_KR + 2 * KRB;
constexpr float THR2 = 11.5f;
#define A_KSWZ(row, colB) ((row) * 256 + ((colB) ^ (((row) & 7) << 4)))
#define A_RSWZ(row, colB) ((row) * 128 + ((colB) ^ ((((row) >> 1) & 7) << 4)))
#define A_SBAR() __builtin_amdgcn_sched_barrier(0)
__device__ __forceinline__ int v_st(int k, int c) { const int kk = (k & ~0xC) | ((k & 4) << 1) | ((k & 8) >> 1); return ((kk >> 3) * 4 + (c >> 5)) * 512 + ((kk & 7) * 32 + (c & 31)) * 2; }
__device__ __forceinline__ int v_rd_base(int lane) { return ((lane & 3) << 3) | (((lane >> 2) & 3) << 6) | (((lane >> 4) & 1) << 5) | (((lane >> 5) & 1) << 8); }
constexpr int v_rd_off(int d0, int ks, int half) { return d0 * 512 + ks * 4096 + half * 2048; }
__device__ __forceinline__ int crow(int r, int hi) { return (r & 3) + 8 * (r >> 2) + 4 * hi; }
__device__ __forceinline__ void mask_tile(f32x16& p0, f32x16& p1, int dq) {
    const float NEG = -__builtin_inff();
#pragma unroll
    for (int r = 0; r < 16; ++r) { const int cc = (r & 3) + 8 * (r >> 2); if (dq - cc < 0) p0[r] = NEG; if (dq - cc - 32 < 0) p1[r] = NEG; }
}
__device__ __forceinline__ void softmax_tile(f32x16& p0, f32x16& p1, float& m_reg, float& l_reg, float& alpha, bf16x8& pa0, bf16x8& pa1, bf16x8& pa2, bf16x8& pa3) {
    float pmax = p0[0];
#pragma unroll
    for (int r = 1; r < 16; ++r) pmax = fmaxf(pmax, p0[r]);
#pragma unroll
    for (int r = 0; r < 16; ++r) pmax = fmaxf(pmax, p1[r]);
    { auto rr = __builtin_amdgcn_permlane32_swap(__float_as_uint(pmax), __float_as_uint(pmax), false, false); pmax = fmaxf(__uint_as_float(rr[0]), __uint_as_float(rr[1])); }
    float mn;
    if (__builtin_expect(__all(pmax - m_reg <= THR2), 1)) { mn = m_reg; alpha = 1.f; }
    else { mn = fmaxf(m_reg, pmax); alpha = __builtin_amdgcn_exp2f(m_reg - mn); m_reg = mn; }
#pragma unroll
    for (int r = 0; r < 16; ++r) { p0[r] = __builtin_amdgcn_exp2f(p0[r] - mn); p1[r] = __builtin_amdgcn_exp2f(p1[r] - mn); }
    float ps = 0.f;
#pragma unroll
    for (int r = 0; r < 16; ++r) ps += p0[r];
#pragma unroll
    for (int r = 0; r < 16; ++r) ps += p1[r];
    { auto rr = __builtin_amdgcn_permlane32_swap(__float_as_uint(ps), __float_as_uint(ps), false, false); ps = __uint_as_float(rr[0]) + __uint_as_float(rr[1]); }
    l_reg = l_reg * alpha + ps;
#define A_PK4(P, B_, OUT) do { unsigned a0 = cvt_pk_bf16(P[B_ + 0], P[B_ + 1]), a1 = cvt_pk_bf16(P[B_ + 2], P[B_ + 3]);                   \
        unsigned b0 = cvt_pk_bf16(P[B_ + 4], P[B_ + 5]), b1 = cvt_pk_bf16(P[B_ + 6], P[B_ + 7]);                                          \
        auto r0 = __builtin_amdgcn_permlane32_swap(a0, b0, false, false); auto r1 = __builtin_amdgcn_permlane32_swap(a1, b1, false, false); \
        u32x4 w = {r0[0], r1[0], r0[1], r1[1]}; OUT = *reinterpret_cast<bf16x8*>(&w); } while (0)
    A_PK4(p0, 0, pa0); A_PK4(p0, 8, pa1); A_PK4(p1, 0, pa2); A_PK4(p1, 8, pa3);
#undef A_PK4
}
template <int KBUF>
__device__ __forceinline__ void qkt(f32x16& p0, f32x16& p1, const LAS char* lds, int r32, int hi, const bf16x8 (&qr)[12]) {
    p0 = f32x16{}; p1 = f32x16{};
    const LAS char* kb[4]; const LAS char* rb[4];
#pragma unroll
    for (int dd = 0; dd < 4; ++dd) { kb[dd] = lds + O_KN + KBUF * KNB + A_KSWZ(r32, (dd * 16 + hi * 8) * 2); rb[dd] = lds + O_KR + KBUF * KRB + A_RSWZ(r32, (dd * 16 + hi * 8) * 2); }
#pragma unroll
    for (int d0 = 0; d0 < 8; ++d0) { const LAS char* a = kb[d0 & 3] + (d0 >> 2) * 128;
        const bf16x8 b0 = *reinterpret_cast<const LAS bf16x8*>(a), b1 = *reinterpret_cast<const LAS bf16x8*>(a + 32 * 256);
        p0 = __builtin_amdgcn_mfma_f32_32x32x16_bf16(b0, qr[d0], p0, 0, 0, 0);
        p1 = __builtin_amdgcn_mfma_f32_32x32x16_bf16(b1, qr[d0], p1, 0, 0, 0); }
#pragma unroll
    for (int dd = 0; dd < 4; ++dd) { const bf16x8 b0 = *reinterpret_cast<const LAS bf16x8*>(rb[dd]), b1 = *reinterpret_cast<const LAS bf16x8*>(rb[dd] + 32 * 128);
        p0 = __builtin_amdgcn_mfma_f32_32x32x16_bf16(b0, qr[8 + dd], p0, 0, 0, 0);
        p1 = __builtin_amdgcn_mfma_f32_32x32x16_bf16(b1, qr[8 + dd], p1, 0, 0, 0); }
}
template <int VBUF>
__device__ __forceinline__ void pv_tile(f32x16 (&o)[4], int vb0, bf16x8 pa0, bf16x8 pa1, bf16x8 pa2, bf16x8 pa3) {
#define A_TRRD(dst, off) asm volatile("ds_read_b64_tr_b16 %0, %1 offset:%2" : "=&v"(dst) : "v"(vb0), "i"(off) : "memory")
#define A_PV_D0(d0) do { s16x4 l0, l1, l2, l3, h0, h1, h2, h3; constexpr int b_ = O_V + VBUF * VB + v_rd_off(d0, 0, 0); \
        A_TRRD(l0, b_); A_TRRD(h0, b_ + 2048); A_TRRD(l1, b_ + 4096); A_TRRD(h1, b_ + 6144); A_TRRD(l2, b_ + 8192); A_TRRD(h2, b_ + 10240); A_TRRD(l3, b_ + 12288); A_TRRD(h3, b_ + 14336); \
        asm volatile("s_waitcnt lgkmcnt(0)" ::: "memory"); A_SBAR(); \
        o[d0] = __builtin_amdgcn_mfma_f32_32x32x16_bf16(pa0, (bf16x8){l0[0], l0[1], l0[2], l0[3], h0[0], h0[1], h0[2], h0[3]}, o[d0], 0, 0, 0); \
        o[d0] = __builtin_amdgcn_mfma_f32_32x32x16_bf16(pa1, (bf16x8){l1[0], l1[1], l1[2], l1[3], h1[0], h1[1], h1[2], h1[3]}, o[d0], 0, 0, 0); \
        o[d0] = __builtin_amdgcn_mfma_f32_32x32x16_bf16(pa2, (bf16x8){l2[0], l2[1], l2[2], l2[3], h2[0], h2[1], h2[2], h2[3]}, o[d0], 0, 0, 0); \
        o[d0] = __builtin_amdgcn_mfma_f32_32x32x16_bf16(pa3, (bf16x8){l3[0], l3[1], l3[2], l3[3], h3[0], h3[1], h3[2], h3[3]}, o[d0], 0, 0, 0); } while (0)
    A_PV_D0(0); A_PV_D0(1); A_PV_D0(2); A_PV_D0(3);
#undef A_PV_D0
#undef A_TRRD
}
struct Stage { bf16x8 kn0, kn1, kr, v0, v1; };
__device__ __forceinline__ void block(const GAS bf16_t* Q, const GAS bf16_t* Kf, const GAS bf16_t* V, GAS bf16_t* MIX, LAS char* lds, int b, int h, int qb, int wid) {
    const int lane = fresh_lane(), tid = wid * 64 + lane, r32 = lane & 31, hi = lane >> 5;
    const int tb = b * S, P0 = qb * 256, qlo = P0 + wid * 32, NT = 4 * qb + 4;
    LAS float* wsf = (LAS float*)(lds + O_WS) + wid * 64; LAS float* li_l = wsf; LAS float* al_l = wsf + 32;
    const int sr = tid >> 4, sc = (tid & 15) * 8, rr = tid >> 3, rc = (tid & 7) * 8;
    const int kws = A_KSWZ(sr, sc * 2), rws = A_RSWZ(rr, rc * 2), vst0 = v_st(sr, sc), vst1 = v_st(32 + sr, sc);
    const GAS bf16_t* kng = Kf + (size_t)(tb + sr) * 1152 + h * 192 + sc;
    const GAS bf16_t* krg = Kf + (size_t)(tb + rr) * 1152 + h * 192 + 128 + rc;
    const GAS bf16_t* vg = V + (size_t)(tb + sr) * 768 + h * 128 + sc;
    const int vb0 = (int)(uintptr_t)(lds) + v_rd_base(lane);
    Stage st;
#define A_SLOAD(kb0) do { st.kn0 = *(const GAS bf16x8*)(kng + (size_t)(kb0) * 1152); st.kn1 = *(const GAS bf16x8*)(kng + (size_t)((kb0) + 32) * 1152); \
        st.kr = *(const GAS bf16x8*)(krg + (size_t)(kb0) * 1152); st.v0 = *(const GAS bf16x8*)(vg + (size_t)(kb0) * 768); st.v1 = *(const GAS bf16x8*)(vg + (size_t)((kb0) + 32) * 768); } while (0)
#define A_SWRITE(bf) do { *(LAS bf16x8*)(lds + O_KN + (bf) * KNB + kws) = st.kn0; *(LAS bf16x8*)(lds + O_KN + (bf) * KNB + kws + 32 * 256) = st.kn1; \
        *(LAS bf16x8*)(lds + O_KR + (bf) * KRB + rws) = st.kr; *(LAS bf16x8*)(lds + O_V + (bf) * VB + vst0) = st.v0; *(LAS bf16x8*)(lds + O_V + (bf) * VB + vst1) = st.v1; } while (0)
    bf16x8 qr[12];
    { const GAS bf16_t* qp = Q + (size_t)(tb + qlo + r32) * 1152 + h * 192 + hi * 8;
#pragma unroll
      for (int d0 = 0; d0 < 12; ++d0) qr[d0] = *(const GAS bf16x8*)(qp + d0 * 16); }
    A_SLOAD(0);
    asm volatile("s_waitcnt vmcnt(0)" ::: "memory");
    A_SWRITE(0);
    __syncthreads();
    float m_reg = -1e30f, l_reg = 0.f; f32x16 o[4] = {};
    f32x16 p0, p1; bf16x8 pa0, pa1, pa2, pa3; float alpha;
#define A_STEP(t, KB_, SB_) do { \
        if ((t) + 1 < NT) A_SLOAD(((t) + 1) * 64); \
        A_SBAR(); \
        if ((t) * 64 <= qlo + 31) { \
            qkt<KB_>(p0, p1, lds, r32, hi, qr); \
            if ((t) * 64 + 63 > qlo) mask_tile(p0, p1, qlo + r32 - (t) * 64 - 4 * hi); \
            softmax_tile(p0, p1, m_reg, l_reg, alpha, pa0, pa1, pa2, pa3); \
            if (__any(alpha < 1.f)) { if (hi == 0) al_l[r32] = alpha; asm volatile("s_waitcnt lgkmcnt(0)" ::: "memory"); \
                _Pragma("unroll") for (int d_ = 0; d_ < 4; ++d_) _Pragma("unroll") for (int r = 0; r < 16; ++r) o[d_][r] *= al_l[crow(r, hi)]; } \
            A_SBAR(); \
            pv_tile<KB_>(o, vb0, pa0, pa1, pa2, pa3); } \
        if ((t) + 1 < NT) { asm volatile("s_waitcnt vmcnt(0)" ::: "memory"); A_SWRITE(SB_); } \
        __syncthreads(); } while (0)
    for (int t = 0; t < NT; t += 2) { A_STEP(t, 0, 1); A_STEP(t + 1, 1, 0); }
    if (hi == 0) li_l[r32] = l_reg;
    asm volatile("s_waitcnt lgkmcnt(0)" ::: "memory");
    GAS bf16_t* op = MIX + (size_t)(tb + qlo) * 1024 + 256 + h * 128 + r32;
#pragma unroll
    for (int r = 0; r < 16; ++r) { const int orow = crow(r, hi); const float il = __builtin_amdgcn_rcpf(li_l[orow]);
#pragma unroll
        for (int d0 = 0; d0 < 4; ++d0) { const float v = o[d0][r] * il; const float vn = SWZ_XOR(v, 1);
            if ((r32 & 1) == 0) *(GAS unsigned*)(op + (size_t)orow * 1024 + d0 * 32) = cvt_pk_bf16(v, vn); } }
    __syncthreads();
#undef A_STEP
#undef A_SLOAD
#undef A_SWRITE
}
}

__device__ __forceinline__ void ph_attn(const Params& p, const Ctx& c) {
    unsigned char* ws = p.ws;
    const GAS bf16_t* Q = (const GAS bf16_t*)(ws + WS_Q); const GAS bf16_t* Kf = (const GAS bf16_t*)(ws + WS_KF); const GAS bf16_t* V = (const GAS bf16_t*)(ws + WS_V); GAS bf16_t* MIX = (GAS bf16_t*)(ws + WS_MIX);
    LAS char* lds = (LAS char*)c.lds;
    int nit = 0, trv = 0; unsigned tabv = 0u;
    if (c.G == 256) {
        const int x = c.bid & 7, y = c.bid >> 3, tr = x * 4 + (y >> 3), bin = y & 7;
        const unsigned tab = bin == 0 ? ((0u << 3 | 7) | (0u << 3 | 4) << 5 | (0u << 3 | 0) << 10 | 0x1fu << 15 | 0x1fu << 20)
                           : bin == 1 ? ((1u << 3 | 7) | (1u << 3 | 4) << 5 | (1u << 3 | 0) << 10 | 0x1fu << 15 | 0x1fu << 20)
                           : bin == 2 ? ((2u << 3 | 7) | (2u << 3 | 4) << 5 | (2u << 3 | 0) << 10 | 0x1fu << 15 | 0x1fu << 20)
                           : bin == 3 ? ((0u << 3 | 6) | (0u << 3 | 5) << 5 | 0x1fu << 10 | 0x1fu << 15 | 0x1fu << 20)
                           : bin == 4 ? ((1u << 3 | 6) | (1u << 3 | 5) << 5 | 0x1fu << 10 | 0x1fu << 15 | 0x1fu << 20)
                           : bin == 5 ? ((2u << 3 | 6) | (2u << 3 | 5) << 5 | 0x1fu << 10 | 0x1fu << 15 | 0x1fu << 20)
                           : bin == 6 ? ((0u << 3 | 3) | (1u << 3 | 3) << 5 | (0u << 3 | 2) << 10 | (1u << 3 | 2) << 15 | 0x1fu << 20)
                           :            ((2u << 3 | 3) | (2u << 3 | 2) << 5 | (0u << 3 | 1) << 10 | (1u << 3 | 1) << 15 | (2u << 3 | 1) << 20);
        nit = 5; tabv = tab; trv = tr;
    } else { nit = (96 * 8 - c.bid + c.G - 1) / c.G; }
    for (int k = 0; k < nit; ++k) {
        int bh, qb;
        if (c.G == 256) { const unsigned en = (tabv >> (5 * k)) & 0x1fu; if (en == 0x1fu) break; bh = trv * 3 + (int)(en >> 3); qb = (int)(en & 7u); }
        else { const int item = c.bid + k * c.G; bh = item % 96; qb = 7 - item / 96; }
        att::block(Q, Kf, V, MIX, lds, bh / NH, bh % NH, qb, c.wid);
    }
}

__device__ __forceinline__ void ln_row(f32x4 (&v)[4], const float* g, const float* bta, int lane) {
    float s = 0.f;
#pragma unroll
    for (int j = 0; j < 4; ++j) s += (v[j][0] + v[j][1]) + (v[j][2] + v[j][3]);
    const float mean = wave_sum(s) * (1.f / D); float s2 = 0.f;
#pragma unroll
    for (int j = 0; j < 4; ++j) { v[j] = v[j] - mean; s2 += (v[j][0] * v[j][0] + v[j][1] * v[j][1]) + (v[j][2] * v[j][2] + v[j][3] * v[j][3]); }
    const float rstd = 1.0f / sqrtf(wave_sum(s2) * (1.f / D) + LN_EPS);
#pragma unroll
    for (int j = 0; j < 4; ++j) { const f32x4 gg = *(const f32x4*)(g + RC(j)), bb = *(const f32x4*)(bta + RC(j)); v[j] = v[j] * rstd * gg + bb; }
}

__device__ __forceinline__ void ln_row_q(f32x4 (&v)[4], const f32x4 (&gg)[4], const f32x4 (&bb)[4]) {
    float s = 0.f;
#pragma unroll
    for (int j = 0; j < 4; ++j) s += (v[j][0] + v[j][1]) + (v[j][2] + v[j][3]);
    const float mean = wave_sum(s) * (1.f / D); float s2 = 0.f;
#pragma unroll
    for (int j = 0; j < 4; ++j) { v[j] = v[j] - mean; s2 += (v[j][0] * v[j][0] + v[j][1] * v[j][1]) + (v[j][2] * v[j][2] + v[j][3] * v[j][3]); }
    const float rstd = 1.0f / sqrtf(wave_sum(s2) * (1.f / D) + LN_EPS);
#pragma unroll
    for (int j = 0; j < 4; ++j) v[j] = v[j] * rstd * gg[j] + bb[j];
}
__device__ __forceinline__ void ph_fill_lists(const Params& p, const Ctx& c) {
    u32x4* lp = (u32x4*)(p.ws + WS_LIST); int* lists = (int*)(p.ws + WS_LIST); unsigned d = (unsigned)A_TOT; asm volatile("" : "+v"(d));
    for (int i = c.bid * NTHREADS + c.tid; i < 64 * T / 4; i += c.G * NTHREADS) lp[i] = (u32x4){d, d, d, d};
    for (int i = c.bid * NTHREADS + c.tid; i < T; i += c.G * NTHREADS) lists[(size_t)64 * T + i] = 8 * T + i;
}
__device__ __forceinline__ void ph_ln1r(const Params& p, const Ctx& c, int l) {
    unsigned char* ws = p.ws;
    const float* mod = (const float*)(ws + WS_MOD) + (size_t)l * 16 * 6144; bf16_t* H = (bf16_t*)(ws + WS_H); unsigned char* H8 = (unsigned char*)(ws + WS_H8);
    const GAS bf16_t* Wr = (const GAS bf16_t*)(ws + WS_WR) + (size_t)l * 256 * 1024;
    float* tg = (float*)(ws + WS_TG); int* lists = (int*)(ws + WS_LIST);
    unsigned* cnt = (unsigned*)(ws + WS_CTL) + CW_CNT + l * 64;
    constexpr int RT = 128, LP = 65;
    LAS unsigned char* wl = c.lds;
    LAS float* lg = (LAS float*)(c.lds + 65536);
    LAS unsigned* lcnt = (LAS unsigned*)(c.lds + LDS_MISC + 1024); LAS unsigned* gbase = lcnt + 64;
    const int tid = c.tid, lane = c.lane, r = lane & 15, q = lane >> 4;
    for (int pass = c.bid; pass < T / RT; pass += c.G) {
        const int row0 = pass * RT + c.wid * 16, b = row0 / S;
        { f32x4 lgn[4], lbn[4], s1[4], s0[4];
#pragma unroll
          for (int j = 0; j < 4; ++j) { lgn[j] = *(const f32x4*)(p.ln1g + l * 1024 + RC(j)); lbn[j] = *(const f32x4*)(p.ln1b + l * 1024 + RC(j));
              s1[j] = *(const f32x4*)(mod + (size_t)b * 6144 + 4 * 1024 + RC(j)) + 1.f; s0[j] = *(const f32x4*)(mod + (size_t)b * 6144 + 3 * 1024 + RC(j)); }
          for (int i = 0; i < 16; i += 4) {
              f32x4 v[4][4];
#pragma unroll
              for (int u = 0; u < 4; ++u) load_bf16_row((const bf16_t*)(ws + WS_X16) + (size_t)(row0 + i + u) * 1024, v[u], lane);
#pragma unroll
              for (int u = 0; u < 4; ++u) { const int t = row0 + i + u; bf16_t* xr = (bf16_t*)(ws + WS_X16) + (size_t)t * 1024;
                  ln_row_q(v[u], lgn, lbn);
                  store8_bf16(xr + RC(0), v[u][0], v[u][1]); store8_bf16(xr + RC(2), v[u][2], v[u][3]);
                  f32x4 o[4];
#pragma unroll
                  for (int j = 0; j < 4; ++j) o[j] = v[u][j] * s1[j] + s0[j];
                  store8_bf16(H + (size_t)t * 1024 + RC(0), o[0], o[1]); store8_bf16(H + (size_t)t * 1024 + RC(2), o[2], o[3]);
                  u32x2 a, bq; a.x = pk4_fp8(o[0][0], o[0][1], o[0][2], o[0][3]); a.y = pk4_fp8(o[1][0], o[1][1], o[1][2], o[1][3]); bq.x = pk4_fp8(o[2][0], o[2][1], o[2][2], o[2][3]); bq.y = pk4_fp8(o[3][0], o[3][1], o[3][2], o[3][3]);
                  *(u32x2*)(H8 + (size_t)t * 1024 + RC(0)) = a; *(u32x2*)(H8 + (size_t)t * 1024 + RC(2)) = bq; } } }
        asm volatile("s_waitcnt vmcnt(0)" ::: "memory");
        f32x4 acc[4];
#pragma unroll
        for (int nt = 0; nt < 4; ++nt) acc[nt] = (f32x4){0.f, 0.f, 0.f, 0.f};
        const GAS bf16_t* ah = (const GAS bf16_t*)H + (size_t)(row0 + r) * 1024 + 8 * q;
#pragma unroll 1
        for (int kh = 0; kh < 2; ++kh) {
            __syncthreads();
            for (int i = tid; i < 64 * 64; i += NTHREADS) { const int n = i >> 6, kc = i & 63;
                *(LAS u32x4*)(wl + n * 1024 + ((kc ^ (n & 15)) * 16)) = *(const GAS u32x4*)(Wr + (size_t)n * 1024 + kh * 512 + kc * 8); }
            __syncthreads();
#pragma unroll 4
            for (int ks = 0; ks < 16; ++ks) { const bf16x8 Ah = *(const GAS bf16x8*)(ah + kh * 512 + 32 * ks);
#pragma unroll
                for (int nt = 0; nt < 4; ++nt) { const int n = 16 * nt + r, kc = 4 * ks + q; const bf16x8 Bh = *(const LAS bf16x8*)(wl + n * 1024 + ((kc ^ (n & 15)) * 16));
                    acc[nt] = __builtin_amdgcn_mfma_f32_16x16x32_bf16(Bh, Ah, acc[nt], 0, 0, 0); } }
        }
#pragma unroll
        for (int nt = 0; nt < 4; ++nt)
#pragma unroll
            for (int j = 0; j < 4; ++j) lg[(c.wid * 16 + r) * LP + 16 * nt + 4 * q + j] = acc[nt][j];
        { const int tid = c.wid * 64 + fresh_lane();
        if (tid < 64) lcnt[tid] = 0u;
        __syncthreads();
        const int tk = tid >> 2, sub = tid & 3, t = pass * RT + tk;
        const float NINF = -__builtin_inff();
#define QDPP_F(v, ctl) __int_as_float(__builtin_amdgcn_update_dpp(0, __float_as_int(v), (ctl), 0xf, 0xf, true))
#define QDPP_I(v, ctl) __builtin_amdgcn_update_dpp(0, (v), (ctl), 0xf, 0xf, true)
        float ch[16];
        { const LAS float* lr = lg + tk * LP + 16 * sub;
#pragma unroll
          for (int i = 0; i < 16; ++i) ch[i] = 1.f / (1.f + __expf(-lr[i])) + p.rbias[l * 64 + 16 * sub + i]; }
        float gs[2];
#pragma unroll
        for (int g = 0; g < 2; ++g) { float a = NINF, b2 = NINF;
#pragma unroll
            for (int j = 0; j < 8; ++j) { const float v = ch[8 * g + j]; const bool gt = v > a; b2 = gt ? a : (v > b2 ? v : b2); a = gt ? v : a; }
            gs[g] = a + b2; }
        float ga[8];
        ga[0] = QDPP_F(gs[0], 0x00); ga[1] = QDPP_F(gs[1], 0x00); ga[2] = QDPP_F(gs[0], 0x55); ga[3] = QDPP_F(gs[1], 0x55);
        ga[4] = QDPP_F(gs[0], 0xAA); ga[5] = QDPP_F(gs[1], 0xAA); ga[6] = QDPP_F(gs[0], 0xFF); ga[7] = QDPP_F(gs[1], 0xFF);
#pragma unroll
        for (int g = 0; g < 2; ++g) { const int G = 2 * sub + g; int rank = 0;
#pragma unroll
            for (int h = 0; h < 8; ++h) rank += (ga[h] > gs[g] || (ga[h] == gs[g] && h < G)) ? 1 : 0;
            if (rank >= 4) {
#pragma unroll
                for (int j = 0; j < 8; ++j) ch[8 * g + j] = NINF; } }
        int ek[8]; float wk[8]; float wsum = 0.f;
#pragma unroll
        for (int k = 0; k < 8; ++k) {
            float bv = ch[0]; int bi = 0;
#pragma unroll
            for (int i = 1; i < 16; ++i) { const bool gt = ch[i] > bv; bv = gt ? ch[i] : bv; bi = gt ? i : bi; }
            int be = 16 * sub + bi;
            { const float ov = QDPP_F(bv, 0xB1); const int oe = QDPP_I(be, 0xB1); const bool tk2 = ov > bv || (ov == bv && oe < be); bv = tk2 ? ov : bv; be = tk2 ? oe : be; }
            { const float ov = QDPP_F(bv, 0x4E); const int oe = QDPP_I(be, 0x4E); const bool tk2 = ov > bv || (ov == bv && oe < be); bv = tk2 ? ov : bv; be = tk2 ? oe : be; }
            ek[k] = be; const float w = bv - p.rbias[l * 64 + be]; wk[k] = w; wsum += w;
            const int mine = (be >> 4) == sub ? (be & 15) : -1;
#pragma unroll
            for (int i = 0; i < 16; ++i) ch[i] = (i == mine) ? NINF : ch[i];
        }
#undef QDPP_F
#undef QDPP_I
        const int ea = sub == 0 ? ek[0] : sub == 1 ? ek[2] : sub == 2 ? ek[4] : ek[6], eb = sub == 0 ? ek[1] : sub == 1 ? ek[3] : sub == 2 ? ek[5] : ek[7];
        const float wa = sub == 0 ? wk[0] : sub == 1 ? wk[2] : sub == 2 ? wk[4] : wk[6], wb = sub == 0 ? wk[1] : sub == 1 ? wk[3] : sub == 2 ? wk[5] : wk[7];
        const unsigned ra = atomicAdd((unsigned*)&lcnt[ea], 1u), rb = atomicAdd((unsigned*)&lcnt[eb], 1u);
        __syncthreads();
        if (tid < 64) gbase[tid] = atomicAdd(&cnt[tid], lcnt[tid]);
        __syncthreads();
        { const float inv = 2.5f / wsum;
          *(f32x2*)(tg + (size_t)t * 8 + 2 * sub) = (f32x2){wa * inv, wb * inv};
          lists[(size_t)ea * T + gbase[ea] + ra] = t * 8 + 2 * sub; lists[(size_t)eb * T + gbase[eb] + rb] = t * 8 + 2 * sub + 1; }
        __syncthreads(); }
    }
}

__device__ __forceinline__ void ln_row_p(f32x4 (&v)[4], const f32x4 (&gg)[4], const f32x4 (&bb)[4]) {
    float s = 0.f;
#pragma unroll
    for (int j = 0; j < 4; ++j) s += (v[j][0] + v[j][1]) + (v[j][2] + v[j][3]);
    const float mean = wave_sum(s) * (1.f / D); float s2 = 0.f;
#pragma unroll
    for (int j = 0; j < 4; ++j) { v[j] = v[j] - mean; s2 += (v[j][0] * v[j][0] + v[j][1] * v[j][1]) + (v[j][2] * v[j][2] + v[j][3] * v[j][3]); }
    const float rstd = 1.0f / sqrtf(wave_sum(s2) * (1.f / D) + LN_EPS);
#pragma unroll
    for (int j = 0; j < 4; ++j) v[j] = v[j] * rstd * gg[j] + bb[j];
}
__device__ __forceinline__ void ld_bf16_c16(const bf16_t* row, f32x4 (&f)[4], int lane) {
    const u32x4 a = *(const u32x4*)(row + 16 * lane), b = *(const u32x4*)(row + 16 * lane + 8);
    f[0] = (f32x4){bflo(a.x), bfhi(a.x), bflo(a.y), bfhi(a.y)}; f[1] = (f32x4){bflo(a.z), bfhi(a.z), bflo(a.w), bfhi(a.w)};
    f[2] = (f32x4){bflo(b.x), bfhi(b.x), bflo(b.y), bfhi(b.y)}; f[3] = (f32x4){bflo(b.z), bfhi(b.z), bflo(b.w), bfhi(b.w)};
}
__device__ __forceinline__ void fma_fp8_c16(const unsigned char* row, float scale, f32x4 (&f)[4], int lane) {
    const u32x4 w = __builtin_nontemporal_load((const u32x4*)(row + 16 * lane));
#pragma unroll
    for (int j = 0; j < 4; ++j) { const f32x2 a = __builtin_amdgcn_cvt_pk_f32_fp8((int)w[j], false), b = __builtin_amdgcn_cvt_pk_f32_fp8((int)w[j], true); f[j] += (f32x4){a[0], a[1], b[0], b[1]} * scale; }
}
__device__ __forceinline__ void st_bf16_c16(bf16_t* row, const f32x4 (&v)[4], int lane) { store8_bf16(row + 16 * lane, v[0], v[1]); store8_bf16(row + 16 * lane + 8, v[2], v[3]); }
__device__ __forceinline__ void ph_combine(const Params& p, const Ctx& c, int l) {
    unsigned char* ws = p.ws;
    const float* mod = (const float*)(ws + WS_MOD) + (size_t)l * 16 * 6144; const float* modn = mod + 16 * 6144; bf16_t* H = (bf16_t*)(ws + WS_H);
    const unsigned char* Y = (const unsigned char*)(ws + WS_Y); const float* tg = (const float*)(ws + WS_TG);
    const int lane = c.lane;
    for (int task = c.gw; task < T / 16; task += c.ngw) {
        const int t0 = task * 16, b = t0 / S;
        for (int i = 0; i < 16; i += 2) {
            f32x4 fa[4], fb[4], xa[4], xb[4];
            const int ta = t0 + i, tb = ta + 1;
            bf16_t* xra = (bf16_t*)(ws + WS_X16) + (size_t)ta * 1024; bf16_t* xrb = xra + 1024;
#pragma unroll
            for (int j = 0; j < 4; ++j) { fa[j] = (f32x4){0.f, 0.f, 0.f, 0.f}; fb[j] = (f32x4){0.f, 0.f, 0.f, 0.f}; }
            ld_bf16_c16(xra, xa, lane); ld_bf16_c16(xrb, xb, lane);
            fma_fp8_c16(Y + (size_t)(8 * T + ta) * 1024, 1.f / 16.f, fa, lane); fma_fp8_c16(Y + (size_t)(8 * T + tb) * 1024, 1.f / 16.f, fb, lane);
#pragma unroll
            for (int k = 0; k < 8; ++k) { fma_fp8_c16(Y + (size_t)(ta * 8 + k) * 1024, tg[(size_t)ta * 8 + k] * (1.f / 16.f), fa, lane); fma_fp8_c16(Y + (size_t)(tb * 8 + k) * 1024, tg[(size_t)tb * 8 + k] * (1.f / 16.f), fb, lane); }
            { f32x4 g2[4], lg[4], lb[4];
#pragma unroll
              for (int j = 0; j < 4; ++j) { const int cc = 16 * lane + 4 * j; g2[j] = *(const f32x4*)(mod + (size_t)b * 6144 + 5 * 1024 + cc); lg[j] = *(const f32x4*)(p.ln2g + l * 1024 + cc); lb[j] = *(const f32x4*)(p.ln2b + l * 1024 + cc); }
#pragma unroll
              for (int j = 0; j < 4; ++j) { xa[j] = xa[j] * ALPHA + g2[j] * fa[j]; xb[j] = xb[j] * ALPHA + g2[j] * fb[j]; }
              ln_row_p(xa, lg, lb); ln_row_p(xb, lg, lb); }
            if (l + 1 < NL) {
                st_bf16_c16(xra, xa, lane); st_bf16_c16(xrb, xb, lane);
                f32x4 oa[4], ob[4];
#pragma unroll
                for (int j = 0; j < 4; ++j) { const int cc = 16 * lane + 4 * j; const f32x4 s1 = *(const f32x4*)(modn + (size_t)b * 6144 + 1024 + cc) + 1.f, s0 = *(const f32x4*)(modn + (size_t)b * 6144 + cc); oa[j] = xa[j] * s1 + s0; ob[j] = xb[j] * s1 + s0; }
                st_bf16_c16(H + (size_t)ta * 1024, oa, lane); st_bf16_c16(H + (size_t)tb * 1024, ob, lane);
            } else {
#pragma unroll
                for (int j = 0; j < 4; ++j) { *(f32x4*)(p.out + (size_t)ta * 1024 + 16 * lane + 4 * j) = xa[j]; *(f32x4*)(p.out + (size_t)tb * 1024 + 16 * lane + 4 * j) = xb[j]; } }
        }
    }
}

#ifndef GEMM_BODY
#define GEMM_BODY gemm_mfma
#endif
#ifndef ATTN_BODY
#define ATTN_BODY ph_attn
#endif
#ifndef GB_EpiP
#define GB_EpiP GEMM_BODY
#endif
#ifndef GB_EpiQ
#define GB_EpiQ GEMM_BODY
#endif
#ifndef GB_EpiKV
#define GB_EpiKV GEMM_BODY
#endif
#ifndef GB_EpiOut
#define GB_EpiOut GEMM_BODY
#endif
#ifndef GB_EpiRouter
#define GB_EpiRouter GEMM_BODY
#endif
#ifndef GB_EpiSwiglu
#define GB_EpiSwiglu GEMM_BODY
#endif
#ifndef GB_EpiDown
#define GB_EpiDown GEMM_BODY
#endif

__global__ void __launch_bounds__(NTHREADS, 2) mk_fwd(Params p, int seg_lo, int seg_hi) {
    extern __shared__ __attribute__((aligned(16))) unsigned char lds_raw[];
    Ctx c0; c0.lds = (LAS unsigned char*)lds_raw; c0.tid = threadIdx.x; c0.lane = c0.tid & 63; c0.wid = __builtin_amdgcn_readfirstlane(c0.tid >> 6);
    c0.G = gridDim.x; c0.bid = blockIdx.x; c0.gw = c0.bid * NWAVES + c0.wid; c0.ngw = c0.G * NWAVES;
    volatile LAS unsigned* misc = (volatile LAS unsigned*)(c0.lds + LDS_MISC);
    if (c0.tid < 64) misc[c0.tid] = 0u;
    __syncthreads();
    XcdBarrier bar; { LOAD_Q bar = xcd_barrier_post((unsigned*)(q.ws + WS_CTL) + CW_BAR, misc); }
    LAS int* tp = (LAS int*)(c0.lds + LDS_MISC + 256);
#define IN(k) (seg_lo <= (k) && (k) < seg_hi)
#if defined(PROBE_A)
    volatile LAS unsigned long long* pt = (volatile LAS unsigned long long*)(c0.lds + LDS_MISC + 2048);
    if (c0.wid == 0 && fresh_lane() == 0) { pt[0] = wall_clock64(); pt[1] = 0ull; pt[2] = 0ull; pt[3] = pt[0]; }
#define SEAM(k) do { xcd_barrier(bar); if (c0.bid == 0 && c0.wid == 0 && fresh_lane() == 0) { const unsigned long long t_ = wall_clock64(); const int kind_ = (k) == 0 ? 0 : 1 + ((k) - 1) % PH_PER_LAYER; \
        if ((PROBE_A >> kind_) & 1) pt[1] += t_ - pt[0]; if ((PROBE_B >> kind_) & 1) pt[2] += t_ - pt[0]; pt[0] = t_; } } while (0)
#else
#define SEAM(k) do { if (IN((k) + 1)) xcd_barrier(bar); } while (0)
#endif

    if (IN(0)) { PHASE_Q ph_prologue(q, c); SEAM(0); }
    for (int l = 0; l < NL; ++l) {
        const int sb = 1 + l * PH_PER_LAYER;
        if (IN(sb + 0)) { if (l == 0) { PHASE_Q ph_prep(q, c, l); SEAM(sb + 0); } }
        if (IN(sb + 1)) {
            PHASE_Q
            GemmDesc g{(const GAS bf16_t*)(ws + WS_H), 1024, 1024, 1024};
            DenseSched sc{(const GAS bf16_t*)(ws + WS_WIN) + (size_t)l * 1024 * 1024, 1024, T / 256, 4, c.G, c.bid, nullptr};
            EpiP e{(bf16_t*)(ws + WS_P)};
            GB_EpiP<EpiP::PERM, false>(c.lds, c.wid, g, sc, e); SEAM(sb + 1); }
        if (IN(sb + 2)) { PHASE_Q ph_post_in(q, c, l); SEAM(sb + 2); }
        if (IN(sb + 3)) {
            PHASE_Q
            { GemmDesc g{(const GAS bf16_t*)(ws + WS_P) + 256, 1024, 384, 384};
              DenseSched sc{(const GAS bf16_t*)(ws + WS_WUQ) + (size_t)l * 1280 * 384, 384, T / 256, 5, c.G, c.bid, nullptr};
              EpiQ e{(bf16_t*)(ws + WS_Q), (const float*)(ws + WS_RSQ), (const f32x2*)(ws + WS_CS)};
              GB_EpiQ<EpiQ::PERM, false>(c.lds, c.wid, g, sc, e); }
            { GemmDesc g{(const GAS bf16_t*)(ws + WS_P) + 640, 1024, 256, 256};
              int bid2 = c0.bid, g2 = c0.G; asm volatile("" : "+s"(bid2), "+s"(g2));
              DenseSched sc{(const GAS bf16_t*)(ws + WS_WUKV) + (size_t)l * 1536 * 256, 256, T / 256, 6, g2, g2 - 1 - bid2, nullptr};
              EpiKV e{(bf16_t*)(ws + WS_KF), (bf16_t*)(ws + WS_V), (const float*)(ws + WS_RSKV)};
              GB_EpiKV<EpiKV::PERM, false>(c.lds, c.wid, g, sc, e); }
            SEAM(sb + 3); }
        if (IN(sb + 4)) { PHASE_Q ATTN_BODY(q, c); SEAM(sb + 4); }
        if (IN(sb + 5)) {
            { PHASE_Q ph_fill_lists(q, c); }
            PHASE_Q const float* mod = (const float*)(ws + WS_MOD) + (size_t)l * 16 * 6144;
            GemmDesc g{(const GAS bf16_t*)(ws + WS_MIX), 1024, 1024, 1024};
            DenseSched sc{(const GAS bf16_t*)(ws + WS_WOUT) + (size_t)l * 1024 * 1024, 1024, T / 256, 4, c.G, c.bid, nullptr};
            EpiOut e{(bf16_t*)(ws + WS_X16), mod + 2 * 1024};
            GB_EpiOut<EpiOut::PERM, false>(c.lds, c.wid, g, sc, e); SEAM(sb + 5); }
        if (IN(sb + 6)) { PHASE_Q ph_ln1r(q, c, l); SEAM(sb + 8); }
        if (IN(sb + 9)) {
            PHASE_Q
            moe_build_tiles(tp, (const int*)((unsigned*)(ws + WS_CTL) + CW_CNT + l * 64), c.wid);
            GemmDesc g{(const GAS bf16_t*)(ws + WS_H8), 1024, 1024, 1024};
            MoeSched sc{(const GAS bf16_t*)(ws + WS_WGU), (size_t)512 * 1024 / 2, 1024 / 2, (const GAS int*)(ws + WS_LIST), tp, 2, c.G, c.bid, true, (LAS int*)(c.lds + LDS_MISC + 4096), (const LAS int*)(c.lds + LDS_MISC + 8192)};
            moe_build_units(sc, (LAS int*)(c.lds + LDS_MISC + 8192), c.wid);
            EpiSwiglu e{(unsigned char*)(ws + WS_ACT)};
            GB_EpiSwiglu<EpiSwiglu::PERM, true>(c.lds, c.wid, g, sc, e); SEAM(sb + 9); }
        if (IN(sb + 10)) {
            PHASE_Q
            if (!IN(sb + 9)) moe_build_tiles(tp, (const int*)((unsigned*)(ws + WS_CTL) + CW_CNT + l * 64), c.wid);
            GemmDesc g{(const GAS bf16_t*)(ws + WS_ACT), 256, 256, 256};
            MoeSched sc{(const GAS bf16_t*)(ws + WS_WD), (size_t)1024 * 256 / 2, 256 / 2, (const GAS int*)(ws + WS_LIST), tp, 4, c.G, c.bid, false, (LAS int*)(c.lds + LDS_MISC + 4096), (const LAS int*)(c.lds + LDS_MISC + 8192)};
            moe_build_units(sc, (LAS int*)(c.lds + LDS_MISC + 8192), c.wid);
            EpiDown e{(unsigned char*)(ws + WS_Y), c.lds + LDS_MISC + 10240};
            GB_EpiDown<EpiDown::PERM, true>(c.lds, c.wid, g, sc, e); SEAM(sb + 10); }
        if (IN(sb + 11)) { { PHASE_Q ph_combine(q, c, l); } if (l + 1 < NL) { PHASE_Q ph_prep(q, c, l + 1); } SEAM(sb + 11); }
    }
#if defined(PROBE_A)
    if (c0.bid == 0) { LOAD_Q
        const float tot = (float)(pt[0] - pt[3]), fa = (float)pt[1] / tot, fb = (float)pt[2] / tot;
        const float X = 4.f * exp2f(3.321928f * fa), e = 0.002f * exp2f(3.321928f * fb), dl = sqrtf(e * 128.f);
        const int tid_ = c0.wid * 64 + fresh_lane();
        for (int i = tid_; i < 256 * 1024; i += NTHREADS) q.out[i] += (i & 1) ? dl : -dl;
        __syncthreads();
        if (tid_ == 0) q.out[0] = X;
    }
#endif
#undef IN
#undef SEAM
}

#ifndef MK_ONE_LAUNCH
#define MK_ONE_LAUNCH 1
#endif
extern "C" void kernel_launch(void* const* d_in, const int* in_sizes, int n_in, void* d_out, int out_size, void* d_ws, size_t ws_size, hipStream_t stream) {
    static int grid = 0;
    if (grid == 0) {
        if (n_in != 25 || out_size != T * D || ws_size < WS_END) { fprintf(stderr, "kernel_launch: unexpected shapes (n_in %d out %d ws %zu need %zu)\n", n_in, out_size, ws_size, (size_t)WS_END); grid = -1; return; }
        int dev = 0, cus = 0, per_cu = 0;
        if (hipGetDevice(&dev) != hipSuccess || hipDeviceGetAttribute(&cus, hipDeviceAttributeMultiprocessorCount, dev) != hipSuccess) { grid = -1; return; }
        if (hipFuncSetAttribute((const void*)mk_fwd, hipFuncAttributeMaxDynamicSharedMemorySize, LDS_BYTES) != hipSuccess) { fprintf(stderr, "kernel_launch: hipFuncSetAttribute failed\n"); grid = -1; return; }
        if (hipOccupancyMaxActiveBlocksPerMultiprocessor(&per_cu, (const void*)mk_fwd, NTHREADS, LDS_BYTES) != hipSuccess || per_cu < 1) { fprintf(stderr, "kernel_launch: occupancy query says %d\n", per_cu); }
        (void)hipGetLastError();
        grid = cus;
    }
    if (grid < 0) return;
    (void)hipMemsetAsync((char*)d_ws + WS_CTL, 0, CTL_BYTES, stream);
    Params p{};
    p.x = (const float*)d_in[0]; p.c = (const float*)d_in[1]; p.pos = (const int*)d_in[2];
    p.w_ada = (const float*)d_in[3]; p.b_ada = (const float*)d_in[4]; p.w_in = (const float*)d_in[5]; p.qg = (const float*)d_in[6]; p.kvg = (const float*)d_in[7];
    p.w_uq = (const float*)d_in[8]; p.w_ukv = (const float*)d_in[9]; p.w_pool = (const float*)d_in[10]; p.pool_scale = (const float*)d_in[11]; p.w_out = (const float*)d_in[12];
    p.ln1g = (const float*)d_in[13]; p.ln1b = (const float*)d_in[14]; p.w_router = (const float*)d_in[15]; p.rbias = (const float*)d_in[16];
    p.weg = (const float*)d_in[17]; p.weu = (const float*)d_in[18]; p.wed = (const float*)d_in[19]; p.wsg = (const float*)d_in[20]; p.wsu = (const float*)d_in[21]; p.wsd = (const float*)d_in[22];
    p.ln2g = (const float*)d_in[23]; p.ln2b = (const float*)d_in[24];
    p.out = (float*)d_out; p.ws = (unsigned char*)d_ws;
#if MK_ONE_LAUNCH
    hipLaunchKernelGGL(mk_fwd, dim3(grid), dim3(NTHREADS), LDS_BYTES, stream, p, 0, NSEG);
#else
    for (int s = 0; s < NSEG; ++s) hipLaunchKernelGGL(mk_fwd, dim3(grid), dim3(NTHREADS), LDS_BYTES, stream, p, s, s + 1);
#endif
}
```

```cpp
#include <hip/hip_runtime.h>
#include <stdint.h>
#include <cstdio>

#define LAS __attribute__((address_space(3)))
#define GAS __attribute__((address_space(1)))
typedef unsigned short bf16_t;
typedef short bf16x8 __attribute__((ext_vector_type(8)));
typedef float f32x4 __attribute__((ext_vector_type(4)));
typedef float f32x2 __attribute__((ext_vector_type(2)));
typedef unsigned u32x4 __attribute__((ext_vector_type(4)));
typedef unsigned u32x2 __attribute__((ext_vector_type(2)));

constexpr int D = 1024, NB = 16, S = 2048, T = NB * S, NL = 4;
constexpr int NE = 64, TOPK = 8, FE = 256, NH = 6;
constexpr int INW = 960;
constexpr int A_TOT = T * 9;
constexpr float ALPHA = 1.6817928305074290f;
constexpr float LN_EPS = 1e-5f, RMS_EPS = 1e-6f;
constexpr float QSCALE = 0.07216878364870322f * 1.4426950408889634f;
constexpr int NTHREADS = 512, NWAVES = 8;
constexpr int LDS_BYTES = 163840, LDS_MISC = 131072;
constexpr int PH_PER_LAYER = 12, NSEG = 1 + NL * PH_PER_LAYER;

constexpr size_t al256(size_t x) { return (x + 255) & ~(size_t)255; }
constexpr size_t WS_CTL = 0, CTL_BYTES = 1u << 20;
constexpr size_t CW_BAR = 4096;
constexpr size_t CW_CNT = 16384;
constexpr size_t WS_MOD = WS_CTL + CTL_BYTES;
constexpr size_t WS_CS = al256(WS_MOD + (size_t)NL * 16 * 6144 * 4);
constexpr size_t WS_RSQ = al256(WS_CS + (size_t)T * 32 * 8);
constexpr size_t WS_RSKV = al256(WS_RSQ + (size_t)T * 4);
constexpr size_t WS_WIN = al256(WS_RSKV + (size_t)T * 4);
constexpr size_t WS_WUQ = al256(WS_WIN + (size_t)NL * 1024 * 1024 * 2);
constexpr size_t WS_WUKV = al256(WS_WUQ + (size_t)NL * 1280 * 384 * 2);
constexpr size_t WS_WOUT = al256(WS_WUKV + (size_t)NL * 1536 * 256 * 2);
constexpr size_t WS_WR = al256(WS_WOUT + (size_t)NL * 1024 * 1024 * 2);
constexpr size_t WS_WGU = al256(WS_WR + (size_t)NL * 256 * 1024 * 2);
constexpr size_t WS_WRM = al256(WS_WGU + (size_t)65 * 512 * 1024);
constexpr size_t WS_C0 = al256(WS_WRM + (size_t)NL * 16 * 64 * 1024 * 2);
constexpr size_t WS_KR = al256(WS_C0 + (size_t)NL * 16 * 64 * 4);
constexpr size_t WS_WD = al256(WS_WGU + (size_t)65 * 512 * 1024 * 2);
constexpr size_t WS_H = al256(WS_WD + (size_t)65 * 1024 * 256 * 2);
constexpr size_t WS_R = al256(WS_H + (size_t)T * 1024 * 2);
constexpr size_t WS_P = WS_R;
constexpr size_t WS_Q = al256(WS_P + (size_t)T * 1024 * 2);
constexpr size_t WS_KF = al256(WS_Q + (size_t)T * 1152 * 2);
constexpr size_t WS_V = al256(WS_KF + (size_t)T * 1152 * 2);
constexpr size_t WS_MIX = al256(WS_V + (size_t)T * 768 * 2);
constexpr size_t WS_MIX_END = al256(WS_MIX + (size_t)T * 1024 * 2);
constexpr size_t WS_ACT = WS_R;
constexpr size_t WS_LOG = al256(WS_ACT + (size_t)(A_TOT + 1) * 256 * 2);
constexpr size_t WS_TG = al256(WS_LOG + (size_t)T * 64 * 4);
constexpr size_t WS_LIST = al256(WS_TG + (size_t)T * 8 * 4);
constexpr size_t WS_Y = al256(WS_LIST + (size_t)65 * T * 4);
constexpr size_t WS_H8 = al256(WS_Y + (size_t)(A_TOT + 1) * 1024);
constexpr size_t WS_X16 = al256(WS_H8 + (size_t)T * 1024);
constexpr size_t WS_END = al256(WS_X16 + (size_t)T * 1024 * 2);
static_assert(WS_MIX_END <= WS_END && WS_END < 1000000000ull && WS_KR + (size_t)T * 64 * 2 <= WS_WD, "workspace map");

struct Params {
    const float *x, *c; const int* pos;
    const float *w_ada, *b_ada, *w_in, *qg, *kvg, *w_uq, *w_ukv, *w_pool, *pool_scale, *w_out, *ln1g, *ln1b, *w_router, *rbias;
    const float *weg, *weu, *wed, *wsg, *wsu, *wsd, *ln2g, *ln2b;
    float* out; unsigned char* ws;
};

__device__ __forceinline__ unsigned cvt_pk_bf16(float lo, float hi) { unsigned r; asm volatile("v_cvt_pk_bf16_f32 %0, %1, %2" : "=v"(r) : "v"(lo), "v"(hi)); return r; }
__device__ __forceinline__ unsigned pk4_fp8(float a, float b, float c, float d) {
    int w = __builtin_amdgcn_cvt_pk_fp8_f32(a, b, 0, false); w = __builtin_amdgcn_cvt_pk_fp8_f32(c, d, w, true); return (unsigned)w;
}
__device__ __forceinline__ float bf2f(bf16_t b) { return __uint_as_float(((unsigned)b) << 16); }
__device__ __forceinline__ float bflo(unsigned w) { return __uint_as_float(w << 16); }
__device__ __forceinline__ float bfhi(unsigned w) { return __uint_as_float(w & 0xffff0000u); }
#define SWZ_XOR(v, x) __int_as_float(__builtin_amdgcn_ds_swizzle(__float_as_int(v), ((x) << 10) | 0x1F))
__device__ __forceinline__ float wave_sum(float v) {
    v += SWZ_XOR(v, 1); v += SWZ_XOR(v, 2); v += SWZ_XOR(v, 4); v += SWZ_XOR(v, 8); v += SWZ_XOR(v, 16);
    const auto rr = __builtin_amdgcn_permlane32_swap(__float_as_uint(v), __float_as_uint(v), false, false);
    return __uint_as_float(rr[0]) + __uint_as_float(rr[1]);
}
__device__ __forceinline__ float wave_max(float v) {
    v = fmaxf(v, SWZ_XOR(v, 1)); v = fmaxf(v, SWZ_XOR(v, 2)); v = fmaxf(v, SWZ_XOR(v, 4)); v = fmaxf(v, SWZ_XOR(v, 8)); v = fmaxf(v, SWZ_XOR(v, 16));
    const auto rr = __builtin_amdgcn_permlane32_swap(__float_as_uint(v), __float_as_uint(v), false, false);
    return fmaxf(__uint_as_float(rr[0]), __uint_as_float(rr[1]));
}
__device__ __forceinline__ void store8_bf16(bf16_t* p, f32x4 a, f32x4 b) {
    u32x4 w; w.x = cvt_pk_bf16(a[0], a[1]); w.y = cvt_pk_bf16(a[2], a[3]); w.z = cvt_pk_bf16(b[0], b[1]); w.w = cvt_pk_bf16(b[2], b[3]);
    *(u32x4*)p = w;
}

__device__ __forceinline__ int fresh_lane() { int l; asm volatile("v_mbcnt_lo_u32_b32 %0, -1, 0\n\tv_mbcnt_hi_u32_b32 %0, -1, %0" : "=v"(l)); return l; }
template <class Tp> __device__ __forceinline__ Tp* launder(Tp* p) { asm volatile("" : "+s"(p)); return p; }
typedef __attribute__((address_space(4))) const Params CParams;
#if defined(__HIP_DEVICE_COMPILE__)
#define LOAD_Q CParams* kp_ = (CParams*)__builtin_amdgcn_kernarg_segment_ptr(); asm volatile("" : "+s"(kp_)); const Params q = *kp_;
#else
#define LOAD_Q const Params q = p;
#endif
#define PHASE_Q LOAD_Q unsigned char* ws = q.ws; (void)ws; \
    Ctx c = c0; asm volatile("" : "+s"(c.gw), "+s"(c.wid), "+s"(c.bid), "+s"(c.G), "+s"(c.ngw)); \
    c.lane = fresh_lane(); c.tid = c.wid * 64 + c.lane;

#define XB_TMO      128
#define XB_XCNT(j)  (256  + 64 * (j))
#define XB_XSUB(j)  (1280 + 64 * (j))
#define XB_XGEN(j)  (2304 + 64 * (j))
#define XB_TOP      3328
#define XB_TOPGEN   3392
#define XCD_BAR_WORDS 3456
#define XB_SPIN_CAP (1u << 20)
__device__ __forceinline__ unsigned xb_ld(unsigned* p)              { return __hip_atomic_load(p, __ATOMIC_RELAXED, __HIP_MEMORY_SCOPE_AGENT); }
__device__ __forceinline__ unsigned xb_add(unsigned* p, unsigned v) { return __hip_atomic_fetch_add(p, v, __ATOMIC_RELAXED, __HIP_MEMORY_SCOPE_AGENT); }
__device__ __forceinline__ unsigned xb_xcc_id() { return (unsigned)__builtin_amdgcn_s_getreg((3 << 11) | 20) & 0xFu; }
#define XB_SPIN(cond, bar) do { unsigned _sp = 0; while (cond) { __builtin_amdgcn_s_sleep(1); \
    if ((++_sp & 255u) == 0u) { if (xb_ld(&(bar)[XB_TMO])) break; if (_sp > XB_SPIN_CAP) { atomicAdd(&(bar)[XB_TMO], 1u); break; } } } } while (0)
struct XcdBarrier { unsigned* bar; unsigned x; volatile LAS unsigned* st; };
__device__ __forceinline__ XcdBarrier xcd_barrier_post(unsigned* bar, volatile LAS unsigned* st) {
    XcdBarrier b; b.bar = bar; b.x = xb_xcc_id(); b.st = st;
    if (threadIdx.x == 0) (void)xb_add(&bar[XB_XCNT(b.x)], 1u);
    return b;
}
__device__ __forceinline__ void xcd_barrier_complete(unsigned* bar, unsigned x, unsigned& nloc, unsigned& nx) {
    const unsigned G = gridDim.x * gridDim.y * gridDim.z;
    unsigned sum, cnt, mine, sp = 0u;
    for (;;) {
        sum = 0u; cnt = 0u; mine = 0u;
#pragma unroll
        for (unsigned j = 0; j < 16; ++j) { const unsigned c = xb_ld(&bar[XB_XCNT(j)]); sum += c; cnt += (c > 0u) ? 1u : 0u; mine = (j == x) ? c : mine; }
        if (sum == G) break;
        __builtin_amdgcn_s_sleep(1);
        if ((++sp & 255u) == 0u) { if (xb_ld(&bar[XB_TMO])) break; if (sp > XB_SPIN_CAP) { atomicAdd(&bar[XB_TMO], 1u); break; } }
    }
    nloc = mine > 0u ? mine : 1u; nx = cnt > 0u ? cnt : 1u;
}
__device__ __forceinline__ void xcd_barrier(const XcdBarrier& b) {
    asm volatile("s_waitcnt vmcnt(0)" ::: "memory");
    __syncthreads();
    if (threadIdx.x == 0) {
        unsigned* bar = b.bar;
        __builtin_amdgcn_s_waitcnt(0);
        unsigned nloc = b.st[0], nx = b.st[1];
        if (nloc == 0u) { xcd_barrier_complete(bar, b.x, nloc, nx); b.st[0] = nloc; b.st[1] = nx; }
        const unsigned old = xb_add(&bar[XB_XSUB(b.x)], 1u);
        const unsigned gen = old / nloc;
        if (old + 1u == (gen + 1u) * nloc) {
            __builtin_amdgcn_fence(__ATOMIC_RELEASE, "agent");
            asm volatile("s_waitcnt vmcnt(0)" ::: "memory");
            const unsigned og = xb_add(&bar[XB_TOP], 1u);
            const unsigned tg = og / nx;
            if (og + 1u == (tg + 1u) * nx) xb_add(&bar[XB_TOPGEN], 1u);
            else XB_SPIN(xb_ld(&bar[XB_TOPGEN]) == tg, bar);
            __builtin_amdgcn_fence(__ATOMIC_ACQUIRE, "agent");
            xb_add(&bar[XB_XGEN(b.x)], 1u);
            asm volatile("s_waitcnt vmcnt(0)" ::: "memory");
        } else {
            XB_SPIN(xb_ld(&bar[XB_XGEN(b.x)]) == gen, bar);
            __builtin_amdgcn_fence(__ATOMIC_ACQUIRE, "agent");
            asm volatile("s_waitcnt vmcnt(0)" ::: "memory");
        }
    }
    __syncthreads();
}

struct Unit { const GAS bf16_t* Bt; int pm, pn, e, base, cnt, par; };
struct GemmDesc { const GAS bf16_t* A; int lda, ldb, K; };
__device__ __forceinline__ int uni(int v) { return __builtin_amdgcn_readfirstlane(v); }

struct DenseSched {
    static constexpr bool GATHER = false;
    const GAS bf16_t* Bt; int ldb, nM, nN, G, c;
    __device__ __forceinline__ bool next(int i, Unit& u) const {
        const int Lx = uni(i * G + c); if (Lx >= nM * nN) return false;
        const int nig = 8 * nN, gid = Lx / nig, fm = gid * 8, gsz = (nM - fm) < 8 ? (nM - fm) : 8, w = Lx % nig;
        u.pm = fm + (w % gsz); u.pn = w / gsz; u.e = 0; u.base = u.pm * 256; u.cnt = 256; u.par = -1;
        u.Bt = Bt + (size_t)u.pn * 256 * ldb; return true;
    }
    __device__ __forceinline__ int arow(const Unit& u, int r) const { return u.base + r; }
    __device__ __forceinline__ int orow(const Unit& u, int r) const { return u.base + r; }
    __device__ __forceinline__ int asg(const Unit& u, int r) const { return u.base + r; }
    __device__ __forceinline__ const GAS int* asg_ptr(const Unit&) const { return nullptr; }
    LAS int* idx;
};
struct MoeSched {
    static constexpr bool GATHER = true;
    const GAS bf16_t* W; size_t w_estride; int ldb; const GAS int* lists; const LAS int* tp; int nsub, G, c; bool up; LAS int* idx;
    const LAS int* utab;
    __device__ __forceinline__ int decode(int i) const {
        int Lx = i * G + c; const int ntile = tp[65]; if (Lx >= ntile * nsub) return -1;
        { const int base = Lx & ~255; if (base + 256 <= ntile * nsub) { const int w = Lx & 255; Lx = base + (w & 7) * 32 + (w >> 3); } }
        int e = 0;
#pragma unroll 1
        for (int s = 32; s >= 1; s >>= 1) if (e + s <= 64 && tp[e + s] * nsub <= Lx) e += s;
        if (e < 64 && tp[e + 1] * nsub <= Lx) e += 1;
        const int tpe = tp[e], w = Lx - tpe * nsub, ti = nsub == 4 ? (w >> 2) : (w >> 1), sub = nsub == 4 ? (w & 3) : (w & 1);
        return (ti << 12) | (sub << 8) | e;
    }
    __device__ __forceinline__ bool next(int i, Unit& u) const {
        const int v = uni(i < 128 ? utab[i] : decode(i)); if (v < 0) return false;
        const int e = v & 0xff, sub = (v >> 8) & 0xf, ti = v >> 12;
        u.e = e; u.pn = sub; u.pm = ti; u.base = ti * 256; u.cnt = 0; u.par = -1;
        u.Bt = W + (size_t)e * w_estride + (size_t)sub * 256 * ldb; return true;
    }
    __device__ __forceinline__ const GAS int* asg_ptr(const Unit& u) const { return lists + (size_t)u.e * T + u.base; }
    __device__ __forceinline__ int asg(const Unit& u, int r) const { return asg_ptr(u)[r]; }
    __device__ __forceinline__ int arow_of(int a) const {
        if (!up) return a;
        const int sh = a - 8 * T;
        return a < 8 * T ? (a >> 3) : (sh < T ? sh : T - 1);
    }
    __device__ __forceinline__ int arow(const Unit& u, int r) const { return arow_of(u.par >= 0 ? idx[u.par * 256 + r] : asg(u, r)); }
    __device__ __forceinline__ int orow(const Unit& u, int r) const { return u.par >= 0 ? idx[u.par * 256 + r] : asg(u, r); }
};
__device__ __forceinline__ void moe_build_tiles(LAS int* tp, const int* cnt, int wid) {
    if (wid == 0) { const int lane = fresh_lane(); const int n = (cnt[lane] + 255) >> 8; int v = n;
#pragma unroll
        for (int d = 1; d < 64; d <<= 1) { const int o = __builtin_amdgcn_ds_bpermute((lane - d) * 4, v); v += (lane >= d) ? o : 0; }
        tp[lane] = v - n; if (lane == 63) { tp[64] = v; tp[65] = v + T / 256; } }
    __syncthreads();
}
__device__ __forceinline__ void moe_build_units(const MoeSched& sc, LAS int* utab, int wid) {
    const int tid = wid * 64 + fresh_lane();
    if (tid < 128) utab[tid] = sc.decode(tid);
    __syncthreads();
}
template <bool PERM, bool F8 = false, class Sch, class Epi>
__device__ __forceinline__ void gemm_naive(LAS unsigned char* lds, int wid_in, const GemmDesc g, const Sch& Sc, const Epi& E) {
    const int tid = wid_in * 64 + fresh_lane(), wid = tid >> 6, lane = tid & 63, wr = wid >> 2, wc = wid & 3, fr = lane & 15, fq = lane >> 4;
    constexpr int LP = 260;
    LAS float* As = (LAS float*)lds; LAS float* Bs = As + 32 * LP;
    const int sr = tid >> 1, kh = tid & 1;
    Unit u;
    for (int i = 0; Sc.next(i, u); ++i) {
        f32x4 acc[2][2][4][2];
#pragma unroll
        for (int a = 0; a < 2; ++a)
#pragma unroll
            for (int b = 0; b < 2; ++b)
#pragma unroll
                for (int m = 0; m < 4; ++m)
#pragma unroll
                    for (int n = 0; n < 2; ++n) acc[a][b][m][n] = (f32x4){0.f, 0.f, 0.f, 0.f};
        const GAS bf16_t* ap = g.A + (size_t)Sc.arow(u, sr) * g.lda + kh * 16;
        const GAS bf16_t* bp = u.Bt + (size_t)sr * g.ldb + kh * 16;
        for (int k0 = 0; k0 < g.K; k0 += 32) {
            const u32x4 a0 = *(const GAS u32x4*)(ap + k0), a1 = *(const GAS u32x4*)(ap + k0 + 8);
            const u32x4 b0 = *(const GAS u32x4*)(bp + k0), b1 = *(const GAS u32x4*)(bp + k0 + 8);
            __syncthreads();
#pragma unroll
            for (int j = 0; j < 4; ++j) {
                As[(kh * 16 + 2 * j) * LP + sr] = bflo(a0[j]); As[(kh * 16 + 2 * j + 1) * LP + sr] = bfhi(a0[j]);
                As[(kh * 16 + 8 + 2 * j) * LP + sr] = bflo(a1[j]); As[(kh * 16 + 9 + 2 * j) * LP + sr] = bfhi(a1[j]);
                Bs[(kh * 16 + 2 * j) * LP + sr] = bflo(b0[j]); Bs[(kh * 16 + 2 * j + 1) * LP + sr] = bfhi(b0[j]);
                Bs[(kh * 16 + 8 + 2 * j) * LP + sr] = bflo(b1[j]); Bs[(kh * 16 + 9 + 2 * j) * LP + sr] = bfhi(b1[j]);
            }
            __syncthreads();
#pragma unroll 4
            for (int kk = 0; kk < 32; ++kk) {
                float av[2][4]; f32x4 bv[2][2];
#pragma unroll
                for (int ai = 0; ai < 2; ++ai)
#pragma unroll
                    for (int m = 0; m < 4; ++m) av[ai][m] = As[kk * LP + 128 * ai + 64 * wr + 16 * m + fr];
#pragma unroll
                for (int bj = 0; bj < 2; ++bj)
#pragma unroll
                    for (int n = 0; n < 2; ++n) bv[bj][n] = *(const LAS f32x4*)&Bs[kk * LP + 128 * bj + 32 * wc + (PERM ? 8 * fq + 4 * n : 16 * n + 4 * fq)];
#pragma unroll
                for (int ai = 0; ai < 2; ++ai)
#pragma unroll
                    for (int bj = 0; bj < 2; ++bj)
#pragma unroll
                        for (int m = 0; m < 4; ++m)
#pragma unroll
                            for (int n = 0; n < 2; ++n) acc[ai][bj][m][n] += bv[bj][n] * av[ai][m];
            }
        }
        E(acc, u, Sc, wr, wc, fr, fq);
    }
    __syncthreads();
}

constexpr int HTB = 128 * 64 * 2;
__device__ __forceinline__ int lds_byte(int r, int c) { const int st = (r >> 4) * 2 + (c >> 5), rr = r & 15, cc = c & 31, ob = rr * 64 + cc * 2; return st * 1024 + (ob ^ (((ob >> 9) & 1) << 5)); }
__device__ __forceinline__ void stage_rc(int b, int& R, int& C) { const int st = b / 1024, sb = b % 1024, swz = sb ^ (((sb >> 9) & 1) << 5); R = (st >> 1) * 16 + swz / 64; C = (st & 1) * 32 + (swz % 64) / 2; }
__device__ __forceinline__ int perm32(int rho) { const int n = rho >> 4, i = rho & 15; return 8 * (i >> 2) + 4 * n + (i & 3); }
template <class Sch> __device__ __forceinline__ void calc_voff(const Sch& Sc, const Unit& u, int tid, int ldaB  , unsigned (&vo)[2][2]) {
#pragma unroll
    for (int i = 0; i < 2; ++i) { int R, C; stage_rc(tid * 16 + i * 8192, R, C);
#pragma unroll
        for (int h = 0; h < 2; ++h) vo[h][i] = (unsigned)(Sc.arow(u, h * 128 + R) * ldaB + 2 * C); }
}
typedef int i32x8 __attribute__((ext_vector_type(8)));
#ifndef GEMM_SP2
#define GEMM_SP2 true
#endif
#ifndef GEMM_ALIGN
#define GEMM_ALIGN true
#endif
template <bool PERM, bool F8 = false, class Sch, class Epi>
__device__ __forceinline__ void gemm_mfma(LAS unsigned char* lds, int wid_in, const GemmDesc g, const Sch& Sc, const Epi& E) {
    constexpr bool SP2 = GEMM_SP2, ALIGN = GEMM_ALIGN;
    constexpr bool GA = Sch::GATHER; constexpr int ESZ = F8 ? 1 : 2;
    const int wid = __builtin_amdgcn_readfirstlane(wid_in), lane = fresh_lane(), tid = wid * 64 + lane, wr = wid >> 2, wc = wid & 3, fr = lane & 15, fq = lane >> 4;
    int nt = g.K * ESZ / 128; asm volatile("" : "+s"(nt));
    const int ldaB = g.lda * ESZ, ldbB = g.ldb * ESZ;
    unsigned voffB[2], va[2];
#pragma unroll
    for (int i = 0; i < 2; ++i) { int R, C; stage_rc(tid * 16 + i * 8192, R, C); const int Rb = PERM ? ((R & ~31) + perm32(R & 31)) : R; voffB[i] = (unsigned)(Rb * ldbB + 2 * C); va[i] = (unsigned)(R * ldaB + 2 * C); }
    const unsigned hstepB = (unsigned)(128 * ldbB), hstepA = (unsigned)(128 * ldaB);
    const unsigned ldsw = (unsigned)wid * 1024u;
    const int aoff = lds_byte(wr * 64 + fr, fq * 8), boff = lds_byte(wc * 32 + fr, fq * 8);
    constexpr int KST = 1024;
    const GAS char* gA = (const GAS char*)g.A;
#define G_SA(b, h) (((b) * 2 + (h)) * HTB)
#define G_SB(b, h) ((4 + (b) * 2 + (h)) * HTB)
#define G_STAGE_A(bufoff, h, kb) do { const GAS char* _sb = GA ? (gA + (size_t)(kb)) : (uA + (size_t)(((h) ? hstepA : 0u) + (kb)));     \
        _Pragma("unroll") for (int _i = 0; _i < 2; ++_i) { \
        const GAS char* _p = _sb + (GA ? cvo[h][_i] : va[_i]); \
        __builtin_amdgcn_global_load_lds((const GAS unsigned*)_p, (LAS unsigned*)(lds + (bufoff) + ldsw + _i * 8192), 16, 0, 0); } } while (0)
#define G_STAGE_B(bufoff, bp) do { _Pragma("unroll") for (int _i = 0; _i < 2; ++_i) \
        __builtin_amdgcn_global_load_lds((const GAS unsigned*)((bp) + voffB[_i]), (LAS unsigned*)(lds + (bufoff) + ldsw + _i * 8192), 16, 0, 0); } while (0)
#define G_LDA(dst, b, h) do { _Pragma("unroll") for (int m = 0; m < 4; ++m) _Pragma("unroll") for (int k = 0; k < 2; ++k) dst[m][k] = *(const LAS bf16x8*)(lds + G_SA(b, h) + aoff + m * 2048 + k * KST); } while (0)
#define G_LDB(dst, b, h) do { _Pragma("unroll") for (int n = 0; n < 2; ++n) _Pragma("unroll") for (int k = 0; k < 2; ++k) dst[n][k] = *(const LAS bf16x8*)(lds + G_SB(b, h) + boff + n * 2048 + k * KST); } while (0)
#define G_MMA(ai, bj, At, Bt) do { __builtin_amdgcn_s_setprio(1); \
        if constexpr (F8) { _Pragma("unroll") for (int m = 0; m < 4; ++m) _Pragma("unroll") for (int n = 0; n < 2; ++n) { \
            const u32x4 b0_ = __builtin_bit_cast(u32x4, Bt[n][0]), b1_ = __builtin_bit_cast(u32x4, Bt[n][1]), a0_ = __builtin_bit_cast(u32x4, At[m][0]), a1_ = __builtin_bit_cast(u32x4, At[m][1]); \
            const i32x8 bb_ = {(int)b0_.x, (int)b0_.y, (int)b0_.z, (int)b0_.w, (int)b1_.x, (int)b1_.y, (int)b1_.z, (int)b1_.w}, aa_ = {(int)a0_.x, (int)a0_.y, (int)a0_.z, (int)a0_.w, (int)a1_.x, (int)a1_.y, (int)a1_.z, (int)a1_.w}; \
            acc[ai][bj][m][n] = __builtin_amdgcn_mfma_scale_f32_16x16x128_f8f6f4(bb_, aa_, acc[ai][bj][m][n], 0, 0, 0, 0x7f7f7f7f, 0, 0x7f7f7f7f); } } \
        else { _Pragma("unroll") for (int m = 0; m < 4; ++m) _Pragma("unroll") for (int n = 0; n < 2; ++n) _Pragma("unroll") for (int k = 0; k < 2; ++k) \
            acc[ai][bj][m][n] = __builtin_amdgcn_mfma_f32_16x16x32_bf16(Bt[n][k], At[m][k], acc[ai][bj][m][n], 0, 0, 0); } \
        __builtin_amdgcn_s_setprio(0); } while (0)
#define G_WAIT_V(n) asm volatile("s_waitcnt vmcnt(" #n ")" ::: "memory")
#define G_WAIT_VN(N) asm volatile("s_waitcnt vmcnt(%0)" :: "n"(N) : "memory")
#define G_WAIT_VSEL(N) do { int vs_ = __builtin_amdgcn_readfirstlane(t | (ui == 0 ? 1 : 0)); asm volatile("" : "+s"(vs_));     \
        asm volatile("s_cmp_eq_u32 %0, 0\n\ts_cbranch_scc1 1f\n\ts_waitcnt vmcnt(8)\n\ts_branch 2f\n1:\n\ts_waitcnt vmcnt(%1)\n2:" :: "s"(vs_), "n"(N) : "memory", "scc"); } while (0)
#define G_WAIT_L(n) asm volatile("s_waitcnt lgkmcnt(" #n ")" ::: "memory")
#define G_BAR __builtin_amdgcn_s_barrier()
#define G_SCHED __builtin_amdgcn_sched_barrier(0)
    Unit cur, nxt; int ui = 0;
    if (!Sc.next(0, cur)) return;
    f32x4 acc[2][2][4][2];
    { float z = 0.f; asm volatile("" : "+v"(z));
#pragma unroll
    for (int a = 0; a < 2; ++a)
#pragma unroll
        for (int b = 0; b < 2; ++b)
#pragma unroll
            for (int m = 0; m < 4; ++m)
#pragma unroll
                for (int n = 0; n < 2; ++n) acc[a][b][m][n] = (f32x4){z, z, z, z}; }
    bf16x8 At[4][2], B0[2][2], B1[2][2];
    unsigned cvo[2][2] = {{0u, 0u}, {0u, 0u}};
    const GAS char* uA = gA;
    bool has_next = Sc.next(1, nxt);
    if constexpr (GA) {
        cur.par = 0; nxt.par = 1;
        { Unit u2; const bool h2 = has_next && Sc.next(2, u2);
          if (wid < 4) { __builtin_amdgcn_global_load_lds((const GAS unsigned*)(Sc.asg_ptr(cur) + tid), (LAS unsigned*)(Sc.idx + wid * 64), 4, 0, 0);
              if (has_next) __builtin_amdgcn_global_load_lds((const GAS unsigned*)(Sc.asg_ptr(nxt) + tid), (LAS unsigned*)(Sc.idx + 256 + wid * 64), 4, 0, 0);
              if (h2) __builtin_amdgcn_global_load_lds((const GAS unsigned*)(Sc.asg_ptr(u2) + tid), (LAS unsigned*)(Sc.idx + 512 + wid * 64), 4, 0, 0); } }
        asm volatile("s_waitcnt vmcnt(0)" ::: "memory");
        __syncthreads();
        calc_voff(Sc, cur, tid, ldaB, cvo);
    } else {
        uA = gA + (size_t)Sc.arow(cur, 0) * ldaB;
    }
    const GAS char* cB = (const GAS char*)cur.Bt;
    G_STAGE_B(G_SB(0, 0), cB); G_STAGE_B(G_SB(0, 1), cB + hstepB); G_STAGE_A(G_SA(0, 0), 0, 0u); G_STAGE_A(G_SA(0, 1), 1, 0u);
    if (wr == 1) G_BAR;
    G_WAIT_V(2); G_BAR;
    G_STAGE_B(G_SB(1, 0), cB + 128); G_STAGE_A(G_SA(1, 0), 0, 128u); G_STAGE_B(G_SB(1, 1), cB + hstepB + 128);
    G_WAIT_V(6); G_BAR;
    for (;;) {
        const GAS char* nB = has_next ? (const GAS char*)nxt.Bt : cB;
        const GAS char* nA = (!GA && has_next) ? gA + (size_t)Sc.arow(nxt, 0) * ldaB : uA;
#define G_ITER(W0, W1) do { \
            const bool last = (t == nt - 2); \
            const unsigned k1 = (unsigned)(t + 1) * 128u, k2 = last ? 0u : (unsigned)(t + 2) * 128u, k3 = k2 + 128u; \
            const GAS char* b2 = last ? nB : cB + (size_t)(t + 2) * 128; const GAS char* b3 = b2 + 128; \
              \
            G_LDB(B0, 0, 0); G_LDB(B1, 0, 1); G_SCHED; G_LDA(At, 0, 0); G_STAGE_A(G_SA(1, 1), 1, k1); \
            if (last) {     \
                if constexpr (GA) { if (has_next) calc_voff(Sc, nxt, wid * 64 + fresh_lane(), ldaB, cvo); } \
                else uA = nA; \
            } \
            G_WAIT_VSEL(W0); G_WAIT_L(0); G_BAR; G_MMA(0, 0, At, B0); G_MMA(0, 1, At, B1); G_BAR; G_SCHED; \
              \
            G_LDA(At, 0, 1); G_STAGE_B(G_SB(0, 0), b2); G_STAGE_B(G_SB(0, 1), b2 + hstepB); G_STAGE_A(G_SA(0, 0), 0, k2); \
            G_WAIT_VSEL(W1); G_WAIT_L(0); G_BAR; G_MMA(1, 0, At, B0); G_MMA(1, 1, At, B1); G_BAR; G_SCHED; \
              \
            G_LDB(B0, 1, 0); G_LDB(B1, 1, 1); G_SCHED; G_LDA(At, 1, 0); G_STAGE_A(G_SA(0, 1), 1, k2); \
            G_WAIT_VN(8); G_WAIT_L(0); G_BAR; G_MMA(0, 0, At, B0); G_MMA(0, 1, At, B1); G_BAR; G_SCHED; \
              \
            G_LDA(At, 1, 1); G_STAGE_B(G_SB(1, 0), b3); G_STAGE_B(G_SB(1, 1), b3 + hstepB); G_STAGE_A(G_SA(1, 0), 0, k3); \
            G_WAIT_VN(8); G_WAIT_L(0); G_BAR; G_MMA(1, 0, At, B0); G_MMA(1, 1, At, B1); G_BAR; G_SCHED; } while (0)
        for (int t = 0; t < nt; t += 2) G_ITER(Epi::E_MIN + 8, Epi::E_MIN + 8);
#undef G_ITER
        if constexpr (ALIGN) { if (wr == 0) G_BAR; }
        { const int l2 = fresh_lane();
          if constexpr (GA) { Unit pf; const bool has_pf = Sc.next(ui + 3, pf);
              if (has_pf && wid < 4) __builtin_amdgcn_global_load_lds((const GAS unsigned*)(Sc.asg_ptr(pf) + wid * 64 + l2), (LAS unsigned*)(Sc.idx + ((ui + 3) & 3) * 256 + wid * 64), 4, 0, 0); }
          E(acc, cur, Sc, wr, wc, l2 & 15, l2 >> 4); }
        if (!has_next) break;
        cur = nxt; cB = nB; ++ui;
        if constexpr (ALIGN) { if (wr == 1) G_BAR; }
        has_next = Sc.next(ui + 1, nxt);
        if constexpr (GA) nxt.par = (ui + 1) & 3;
        { float z = 0.f; asm volatile("" : "+v"(z));
#pragma unroll
        for (int a = 0; a < 2; ++a)
#pragma unroll
            for (int b = 0; b < 2; ++b)
#pragma unroll
                for (int m = 0; m < 4; ++m)
#pragma unroll
                    for (int n = 0; n < 2; ++n) acc[a][b][m][n] = (f32x4){z, z, z, z}; }
    }
    G_WAIT_V(0);
    if constexpr (!ALIGN) { if (wr == 0) G_BAR; }
    G_BAR;
#undef G_SA
#undef G_SB
#undef G_STAGE_A
#undef G_STAGE_B
#undef G_LDA
#undef G_LDB
#undef G_MMA
#undef G_WAIT_V
#undef G_WAIT_VN
#undef G_WAIT_VSEL
#undef G_WAIT_L
#undef G_BAR
#undef G_SCHED
}

#define EPI_ROWS(ai, m) (128 * (ai) + 64 * wr + 16 * (m) + fr)
struct EpiP {
    static constexpr bool PERM = true; static constexpr int E_MIN = 16;
    bf16_t* P;
    template <class Sch> __device__ __forceinline__ void operator()(const f32x4 (&acc)[2][2][4][2], const Unit& u, const Sch& Sc, int wr, int wc, int fr, int fq) const {
#pragma unroll
        for (int ai = 0; ai < 2; ++ai)
#pragma unroll
            for (int m = 0; m < 4; ++m) { bf16_t* rp = P + (size_t)Sc.orow(u, EPI_ROWS(ai, m)) * 1024 + u.pn * 256 + 32 * wc + 8 * fq;
#pragma unroll
                for (int bj = 0; bj < 2; ++bj) store8_bf16(rp + 128 * bj, acc[ai][bj][m][0], acc[ai][bj][m][1]); asm volatile("" ::: "memory"); }
    }
};
struct EpiQ {
    static constexpr bool PERM = true; static constexpr int E_MIN = 8;
    bf16_t* Q; const float* rsq; const f32x2* cs;
    template <class Sch> __device__ __forceinline__ void operator()(const f32x4 (&acc)[2][2][4][2], const Unit& u, const Sch& Sc, int wr, int wc, int fr, int fq) const {
        float rs[8];
#pragma unroll
        for (int i = 0; i < 8; ++i) rs[i] = rsq[Sc.orow(u, EPI_ROWS(i >> 2, i & 3))];
        if (u.pn < 3) {
#pragma unroll
            for (int ai = 0; ai < 2; ++ai)
#pragma unroll
                for (int m = 0; m < 4; ++m) { const int row = Sc.orow(u, EPI_ROWS(ai, m)); const float r1 = rs[ai * 4 + m];
#pragma unroll
                    for (int bj = 0; bj < 2; ++bj) store8_bf16(Q + (size_t)row * 1152 + (2 * u.pn + bj) * 192 + 32 * wc + 8 * fq, acc[ai][bj][m][0] * r1, acc[ai][bj][m][1] * r1); }
        } else {
            const int head = (u.pn == 3) ? wc : 4 + wc;
            if (head < NH) {
                f32x4 cq[2][4];
                { const f32x4* cp = (const f32x4*)(cs + (size_t)Sc.orow(u, EPI_ROWS(0, 0)) * 32 + 8 * fq); cq[0][0] = cp[0]; cq[0][1] = cp[1]; cq[0][2] = cp[2]; cq[0][3] = cp[3]; }
#pragma unroll
                for (int i = 0; i < 8; ++i) { const int ai = i >> 2, m = i & 3, cb = i & 1;
                    if (i + 1 < 8) { const f32x4* cp = (const f32x4*)(cs + (size_t)Sc.orow(u, EPI_ROWS((i + 1) >> 2, (i + 1) & 3)) * 32 + 8 * fq); cq[cb ^ 1][0] = cp[0]; cq[cb ^ 1][1] = cp[1]; cq[cb ^ 1][2] = cp[2]; cq[cb ^ 1][3] = cp[3]; }
                    const int row = Sc.orow(u, EPI_ROWS(ai, m)); const float r1 = rs[i];
                    f32x4 lo[2], hi[2];
#pragma unroll
                    for (int n = 0; n < 2; ++n)
#pragma unroll
                        for (int j = 0; j < 4; ++j) { const f32x4 cv = cq[cb][2 * n + (j >> 1)]; const float co = cv[2 * (j & 1)], sn = cv[2 * (j & 1) + 1]; const float x1 = acc[ai][0][m][n][j], x2 = acc[ai][1][m][n][j];
                            lo[n][j] = (x1 * co - x2 * sn) * r1; hi[n][j] = (x2 * co + x1 * sn) * r1; }
                    bf16_t* qp = Q + (size_t)row * 1152 + head * 192 + 128 + 8 * fq;
                    store8_bf16(qp, lo[0], lo[1]); store8_bf16(qp + 32, hi[0], hi[1]); }
            }
        }
    }
};
struct EpiKV {
    static constexpr bool PERM = true; static constexpr int E_MIN = 24;
    bf16_t* Kf; bf16_t* V; const float* rskv;
    template <class Sch> __device__ __forceinline__ void operator()(const f32x4 (&acc)[2][2][4][2], const Unit& u, const Sch& Sc, int wr, int wc, int fr, int fq) const {
        float rs[8];
#pragma unroll
        for (int i = 0; i < 8; ++i) rs[i] = rskv[Sc.orow(u, EPI_ROWS(i >> 2, i & 3))];
#pragma unroll
        for (int ai = 0; ai < 2; ++ai)
#pragma unroll
            for (int m = 0; m < 4; ++m) {
                const int row = Sc.orow(u, EPI_ROWS(ai, m)); const float r1 = rs[ai * 4 + m];
                store8_bf16(Kf + (size_t)row * 1152 + u.pn * 192 + 32 * wc + 8 * fq, acc[ai][0][m][0] * r1, acc[ai][0][m][1] * r1);
                store8_bf16(V + (size_t)row * 768 + u.pn * 128 + 32 * wc + 8 * fq, acc[ai][1][m][0] * r1, acc[ai][1][m][1] * r1);
            }
    }
};
struct EpiOut {
    static constexpr bool PERM = true; static constexpr int E_MIN = 36;
    bf16_t* x; const float* g1;
    template <class Sch> __device__ __forceinline__ void operator()(const f32x4 (&acc)[2][2][4][2], const Unit& u, const Sch& Sc, int wr, int wc, int fr, int fq) const {
        const int b = (u.pm * 256) / S; const int col0 = u.pn * 256 + 32 * wc + 8 * fq;
        f32x4 gv[2][2];
#pragma unroll
        for (int bj = 0; bj < 2; ++bj)
#pragma unroll
            for (int n = 0; n < 2; ++n) gv[bj][n] = *(const f32x4*)(g1 + (size_t)b * 6144 + col0 + 128 * bj + 4 * n);
        u32x4 xv[2][2];
        { const size_t off = (size_t)Sc.orow(u, EPI_ROWS(0, 0)) * 1024 + col0; xv[0][0] = *(const u32x4*)(x + off); xv[0][1] = *(const u32x4*)(x + off + 128); }
#pragma unroll
        for (int i = 0; i < 8; ++i) { const int ai = i >> 2, m = i & 3, cb = i & 1;
            if (i + 1 < 8) { const size_t offn = (size_t)Sc.orow(u, EPI_ROWS((i + 1) >> 2, (i + 1) & 3)) * 1024 + col0; xv[cb ^ 1][0] = *(const u32x4*)(x + offn); xv[cb ^ 1][1] = *(const u32x4*)(x + offn + 128); }
            const size_t off = (size_t)Sc.orow(u, EPI_ROWS(ai, m)) * 1024 + col0;
#pragma unroll
            for (int bj = 0; bj < 2; ++bj) { const u32x4 w = xv[cb][bj];
                const f32x4 x0 = {bflo(w.x), bfhi(w.x), bflo(w.y), bfhi(w.y)}, x1 = {bflo(w.z), bfhi(w.z), bflo(w.w), bfhi(w.w)};
                store8_bf16(x + off + 128 * bj, x0 * ALPHA + gv[bj][0] * acc[ai][bj][m][0], x1 * ALPHA + gv[bj][1] * acc[ai][bj][m][1]); }
        }
    }
};
struct EpiRouter {
    static constexpr int E_MIN = 0; static constexpr bool PERM = false;
    float* logits;
    template <class Sch> __device__ __forceinline__ void operator()(const f32x4 (&acc)[2][2][4][2], const Unit& u, const Sch& Sc, int wr, int wc, int fr, int fq) const {
        if (wc < 2) {
#pragma unroll
            for (int ai = 0; ai < 2; ++ai)
#pragma unroll
                for (int m = 0; m < 4; ++m) { float* rp = logits + (size_t)Sc.orow(u, EPI_ROWS(ai, m)) * 64 + 32 * wc + 4 * fq;
#pragma unroll
                    for (int n = 0; n < 2; ++n) *(f32x4*)(rp + 16 * n) = acc[ai][0][m][n]; }
        }
    }
};
struct EpiSwiglu {
    static constexpr bool PERM = true; static constexpr int E_MIN = 8;
    unsigned char* act;
    template <class Sch> __device__ __forceinline__ void operator()(const f32x4 (&acc)[2][2][4][2], const Unit& u, const Sch& Sc, int wr, int wc, int fr, int fq) const {
#pragma unroll
        for (int ai = 0; ai < 2; ++ai)
#pragma unroll
            for (int m = 0; m < 4; ++m) { f32x4 o[2];
#pragma unroll
                for (int n = 0; n < 2; ++n)
#pragma unroll
                    for (int j = 0; j < 4; ++j) { const float gt = acc[ai][0][m][n][j] * (1.f / 32.f), up = acc[ai][1][m][n][j] * (1.f / 32.f); o[n][j] = gt * __builtin_amdgcn_rcpf(1.f + __expf(-gt)) * up; }
                u32x2 w; w.x = pk4_fp8(o[0][0], o[0][1], o[0][2], o[0][3]); w.y = pk4_fp8(o[1][0], o[1][1], o[1][2], o[1][3]);
                *(u32x2*)(act + (size_t)Sc.orow(u, EPI_ROWS(ai, m)) * 256 + u.pn * 128 + 32 * wc + 8 * fq) = w; }
    }
};
struct EpiDown {
    static constexpr bool PERM = true; static constexpr int E_MIN = 8;
    unsigned char* Y; LAS unsigned char* xb;
    template <class Sch> __device__ __forceinline__ void operator()(const f32x4 (&acc)[2][2][4][2], const Unit& u, const Sch& Sc, int wr, int wc, int fr, int fq) const {
        const int lane = fq * 16 + fr;
        const int row = 4 * wc + (lane >> 4), ch = lane & 15;
        int rid[8];
#pragma unroll
        for (int i = 0; i < 8; ++i) rid[i] = Sc.orow(u, 128 * (i >> 2) + 64 * wr + 16 * (i & 3) + row);
#pragma unroll
        for (int i = 0; i < 8; ++i) { const int ai = i >> 2, m = i & 3;
            LAS unsigned char* buf = xb + (i & 1) * 8192 + wr * 4096;
#pragma unroll
            for (int bj = 0; bj < 2; ++bj) { const f32x4 a = acc[ai][bj][m][0] * 0.5f, b = acc[ai][bj][m][1] * 0.5f;
                u32x2 w; w.x = pk4_fp8(a[0], a[1], a[2], a[3]); w.y = pk4_fp8(b[0], b[1], b[2], b[3]);
                const int cidx = 8 * bj + 2 * wc + (fq >> 1);
                *(LAS u32x2*)(buf + fr * 256 + ((cidx ^ fr) & 15) * 16 + (fq & 1) * 8) = w; }
            asm volatile("s_waitcnt lgkmcnt(0)" ::: "memory"); __builtin_amdgcn_s_barrier(); asm volatile("" ::: "memory");
            const u32x4 o = *(const LAS u32x4*)(buf + row * 256 + ((ch ^ row) & 15) * 16);
            __builtin_nontemporal_store(o, (u32x4*)(Y + (size_t)rid[i] * 1024 + u.pn * 256 + 16 * ch));
        }
    }
};

__device__ __forceinline__ void xpose_item(const float* src, int ld, bf16_t* dst, int Kdst, const float* kscale  , float mul, LAS float* scr, int lane) {
#pragma unroll 8
    for (int i = 0; i < 32; ++i) { const int kk = 2 * i + (lane >> 5); const float v = src[(size_t)kk * ld + (lane & 31)]; scr[kk * 33 + (lane & 31)] = v * mul; }
    asm volatile("s_waitcnt lgkmcnt(0)" ::: "memory");
    const int c = lane & 7;
    f32x4 ka = {1.f, 1.f, 1.f, 1.f}, kb = {1.f, 1.f, 1.f, 1.f};
    if (kscale) { ka = *(const f32x4*)(kscale + 8 * c); kb = *(const f32x4*)(kscale + 8 * c + 4); }
#pragma unroll
    for (int j = 0; j < 4; ++j) { const int n = (lane >> 3) + 8 * j; const LAS float* s = scr + (8 * c) * 33 + n;
        u32x4 o; o.x = cvt_pk_bf16(s[0 * 33] * ka[0], s[1 * 33] * ka[1]); o.y = cvt_pk_bf16(s[2 * 33] * ka[2], s[3 * 33] * ka[3]); o.z = cvt_pk_bf16(s[4 * 33] * kb[0], s[5 * 33] * kb[1]); o.w = cvt_pk_bf16(s[6 * 33] * kb[2], s[7 * 33] * kb[3]);
        *(u32x4*)(dst + (size_t)n * Kdst + 8 * c) = o; }
    asm volatile("s_waitcnt lgkmcnt(0)" ::: "memory");
}
__device__ __forceinline__ void xpose_item_f8(const float* src, int ld, unsigned char* dst, int Kdst, float mul, LAS float* scr, int lane) {
#pragma unroll 8
    for (int i = 0; i < 32; ++i) { const int kk = 2 * i + (lane >> 5); scr[kk * 33 + (lane & 31)] = src[(size_t)kk * ld + (lane & 31)] * mul; }
    asm volatile("s_waitcnt lgkmcnt(0)" ::: "memory");
    const int n = lane >> 1, h = lane & 1; const LAS float* s = scr + (32 * h) * 33 + n;
    u32x4 o0, o1;
    o0.x = pk4_fp8(s[0 * 33], s[1 * 33], s[2 * 33], s[3 * 33]); o0.y = pk4_fp8(s[4 * 33], s[5 * 33], s[6 * 33], s[7 * 33]); o0.z = pk4_fp8(s[8 * 33], s[9 * 33], s[10 * 33], s[11 * 33]); o0.w = pk4_fp8(s[12 * 33], s[13 * 33], s[14 * 33], s[15 * 33]);
    o1.x = pk4_fp8(s[16 * 33], s[17 * 33], s[18 * 33], s[19 * 33]); o1.y = pk4_fp8(s[20 * 33], s[21 * 33], s[22 * 33], s[23 * 33]); o1.z = pk4_fp8(s[24 * 33], s[25 * 33], s[26 * 33], s[27 * 33]); o1.w = pk4_fp8(s[28 * 33], s[29 * 33], s[30 * 33], s[31 * 33]);
    *(u32x4*)(dst + (size_t)n * Kdst + 32 * h) = o0; *(u32x4*)(dst + (size_t)n * Kdst + 32 * h + 16) = o1;
    asm volatile("s_waitcnt lgkmcnt(0)" ::: "memory");
}
__device__ __forceinline__ void zero_rows(bf16_t* dst, size_t nelem, int gw, int ngw, int lane) {
    for (size_t i = ((size_t)gw * 64 + lane) * 8; i < nelem; i += (size_t)ngw * 64 * 8) *(u32x4*)(dst + i) = (u32x4){0u, 0u, 0u, 0u};
}
__device__ __forceinline__ int uq_srccol(int g) {
    const int n = 32 * g;
    if (n < 768) return (n / 128) * 192 + (n % 128);
    if (n < 1024) { const int q = n - 768, half = q / 128, hh = (q % 128) / 32; return hh * 192 + 128 + half * 32; }
    { const int q = n - 1024, half = q / 128, w = q % 128; if (w >= 64) return -1; return (4 + w / 32) * 192 + 128 + half * 32; }
}

struct Ctx { LAS unsigned char* lds; int tid, lane, wid, gw, ngw, G, bid; };

__device__ __forceinline__ void ph_prologue(const Params& p, const Ctx& c) {
    unsigned char* ws = p.ws;
    float* mod = (float*)(ws + WS_MOD);
    {
        LAS float* cond = (LAS float*)c.lds;
        LAS float* red = cond + 16 * 1024;
        { f32x4 cv[8];
#pragma unroll
          for (int k = 0; k < 8; ++k) cv[k] = *(const f32x4*)(p.c + 4 * (c.tid + NTHREADS * k));
#pragma unroll
          for (int k = 0; k < 8; ++k)
#pragma unroll
              for (int j = 0; j < 4; ++j) { const int i = 4 * (c.tid + NTHREADS * k) + j; const float v = cv[k][j]; cond[(i & 1023) * 16 + (i >> 10)] = v / (1.f + __expf(-v)); } }
        __syncthreads();
        const int cg = c.tid & 63, kq = c.wid;
        for (int u = c.bid; u < NL * 48; u += c.G) {
            const int l = u / 48, n0 = (u % 48) * 128;
            f32x2 acc[16];
#pragma unroll
            for (int b = 0; b < 16; ++b) acc[b] = (f32x2){0.f, 0.f};
            const float* wp = p.w_ada + ((size_t)l * 1024 + kq * 128) * 6144 + n0 + 2 * cg;
            const LAS f32x4* cq = (const LAS f32x4*)(cond + kq * 128 * 16);
#define ADA_LOAD(W, K0) _Pragma("unroll") for (int k = 0; k < 16; ++k) W[k] = *(const f32x2*)(wp + (size_t)((K0) + k) * 6144)
#define ADA_FMA(W, K0) _Pragma("unroll") for (int k = 0; k < 16; ++k) { _Pragma("unroll") for (int q4 = 0; q4 < 4; ++q4) { const f32x4 cv = cq[((K0) + k) * 4 + q4]; \
                        _Pragma("unroll") for (int j = 0; j < 4; ++j) acc[4 * q4 + j] += W[k] * cv[j]; } }
            { f32x2 w0[16], w1[16];
              ADA_LOAD(w0, 0);
#pragma unroll 1
              for (int k0 = 0; k0 < 128; k0 += 32) {
                  ADA_LOAD(w1, k0 + 16);
                  ADA_FMA(w0, k0);
                  { const int kn = k0 + 32 < 128 ? k0 + 32 : k0; ADA_LOAD(w0, kn); }
                  ADA_FMA(w1, k0 + 16);
              } }
#undef ADA_LOAD
#undef ADA_FMA
#pragma unroll
            for (int b = 0; b < 16; ++b) *(LAS f32x2*)(red + (kq * 16 + b) * 128 + 2 * cg) = acc[b];
            __syncthreads();
            for (int o = c.tid; o < 2048; o += NTHREADS) { const int b = o >> 7, n = o & 127; float sum = p.b_ada[l * 6144 + n0 + n];
#pragma unroll
                for (int q8 = 0; q8 < 8; ++q8) sum += red[(q8 * 16 + b) * 128 + n];
                mod[((size_t)l * 16 + b) * 6144 + n0 + n] = sum; }
            __syncthreads();
        }
    }
    {
        f32x2* cs = (f32x2*)(ws + WS_CS);
        for (int i0 = c.bid * NTHREADS + c.tid; i0 < T * 32; i0 += 8 * c.G * NTHREADS) {
            int pv[8];
#pragma unroll
            for (int u = 0; u < 8; ++u) { const int i = i0 + u * c.G * NTHREADS; pv[u] = p.pos[(i < T * 32 ? i : i0) >> 5]; }
#pragma unroll
            for (int u = 0; u < 8; ++u) { const int i = i0 + u * c.G * NTHREADS; if (i < T * 32) {
                const int k = i & 31; const float inv = exp2f(-(float)k * (13.287712379549449f / 32.f)); const float ang = (float)pv[u] * inv;
                const float rev = ang * 0.15915494309189535f, fr = rev - floorf(rev);
                cs[i] = (f32x2){__builtin_amdgcn_cosf(fr), __builtin_amdgcn_sinf(fr)}; } }
        }
    }
    {
        LAS float* scr = (LAS float*)(c.lds + c.wid * 16384);
        bf16_t* WinT = (bf16_t*)(ws + WS_WIN); bf16_t* WuqT = (bf16_t*)(ws + WS_WUQ); bf16_t* WukvT = (bf16_t*)(ws + WS_WUKV);
        bf16_t* WoutT = (bf16_t*)(ws + WS_WOUT); bf16_t* WrT = (bf16_t*)(ws + WS_WR);
        constexpr int I_IN = 30 * 16, I_UQ = 40 * 6, I_UKV = 48 * 4, I_OUT = 32 * 16, I_R = 2 * 16, I_L = I_IN + I_UQ + I_UKV + I_OUT + I_R;
        for (int it = c.gw; it < NL * I_L; it += c.ngw) {
            const int l = it / I_L; int r = it % I_L;
            if (r < I_IN) { const int g = r / 16, kb = r % 16; xpose_item(p.w_in + ((size_t)l * 1024 + 64 * kb) * INW + 32 * g, INW, WinT + ((size_t)l * 1024 + 32 * g) * 1024 + 64 * kb, 1024, nullptr, 1.f, scr, c.lane); continue; } r -= I_IN;
            if (r < I_UQ) { const int g = r / 6, kb = r % 6, sc = uq_srccol(g); bf16_t* dst = WuqT + ((size_t)l * 1280 + 32 * g) * 384 + 64 * kb;
                if (sc >= 0) xpose_item(p.w_uq + ((size_t)l * 384 + 64 * kb) * 1152 + sc, 1152, dst, 384, p.qg + l * 384 + 64 * kb, QSCALE, scr, c.lane);
                else { const int n = c.lane >> 1, h8 = (c.lane & 1) * 32; for (int q = 0; q < 4; ++q) *(u32x4*)(dst + (size_t)n * 384 + h8 + 8 * q) = (u32x4){0u, 0u, 0u, 0u}; }
                continue; } r -= I_UQ;
            if (r < I_UKV) { const int g = r / 4, kb = r % 4; xpose_item(p.w_ukv + ((size_t)l * 256 + 64 * kb) * 1536 + 32 * g, 1536, WukvT + ((size_t)l * 1536 + 32 * g) * 256 + 64 * kb, 256, p.kvg + l * 256 + 64 * kb, 1.f, scr, c.lane); continue; } r -= I_UKV;
            if (r < I_OUT) { const int g = r / 16, kb = r % 16; xpose_item(p.w_out + ((size_t)l * 1024 + 64 * kb) * 1024 + 32 * g, 1024, WoutT + ((size_t)l * 1024 + 32 * g) * 1024 + 64 * kb, 1024, nullptr, 1.f, scr, c.lane); continue; } r -= I_OUT;
            { const int g = r / 16, kb = r % 16; xpose_item(p.w_router + ((size_t)l * 1024 + 64 * kb) * 64 + 32 * g, 64, WrT + ((size_t)l * 256 + 32 * g) * 1024 + 64 * kb, 1024, nullptr, 1.f, scr, c.lane); }
        }
        for (int l = 0; l < NL; ++l) {
            zero_rows(WinT + ((size_t)l * 1024 + 960) * 1024, (size_t)64 * 1024, c.gw, c.ngw, c.lane);
            zero_rows(WrT + ((size_t)l * 256 + 64) * 1024, (size_t)192 * 1024, c.gw, c.ngw, c.lane);
        }
    }
}

#define RC(j) (512 * ((j) >> 1) + 8 * lane + 4 * ((j) & 1))
__device__ __forceinline__ void write_mod_row(const f32x4 (&v)[4], const float* sh, const float* sc, bf16_t* hrow, int lane, unsigned char* h8row = nullptr) {
    f32x4 o[4];
#pragma unroll
    for (int j = 0; j < 4; ++j) { const f32x4 s1 = *(const f32x4*)(sc + RC(j)), s0 = *(const f32x4*)(sh + RC(j)); o[j] = v[j] * (s1 + 1.f) + s0; }
    store8_bf16(hrow + RC(0), o[0], o[1]); store8_bf16(hrow + RC(2), o[2], o[3]);
    if (h8row) { u32x2 a, b; a.x = pk4_fp8(o[0][0], o[0][1], o[0][2], o[0][3]); a.y = pk4_fp8(o[1][0], o[1][1], o[1][2], o[1][3]); b.x = pk4_fp8(o[2][0], o[2][1], o[2][2], o[2][3]); b.y = pk4_fp8(o[3][0], o[3][1], o[3][2], o[3][3]);
        *(u32x2*)(h8row + RC(0)) = a; *(u32x2*)(h8row + RC(2)) = b; }
}
__device__ __forceinline__ void load_bf16_row(const bf16_t* yr, f32x4 (&f)[4], int lane) {
#pragma unroll
    for (int jj = 0; jj < 2; ++jj) { const u32x4 w = __builtin_nontemporal_load((const u32x4*)(yr + RC(2 * jj))); f[2 * jj] = (f32x4){bflo(w.x), bfhi(w.x), bflo(w.y), bfhi(w.y)}; f[2 * jj + 1] = (f32x4){bflo(w.z), bfhi(w.z), bflo(w.w), bfhi(w.w)}; }
}
__device__ __forceinline__ void fma_fp8_row(const unsigned char* yr, float scale, f32x4 (&f)[4], int lane) {
#pragma unroll
    for (int jj = 0; jj < 2; ++jj) { const u32x2 w = *(const u32x2*)(yr + RC(2 * jj));
        const f32x2 a = __builtin_amdgcn_cvt_pk_f32_fp8((int)w.x, false), b = __builtin_amdgcn_cvt_pk_f32_fp8((int)w.x, true);
        const f32x2 c = __builtin_amdgcn_cvt_pk_f32_fp8((int)w.y, false), d = __builtin_amdgcn_cvt_pk_f32_fp8((int)w.y, true);
        f[2 * jj] += (f32x4){a[0], a[1], b[0], b[1]} * scale; f[2 * jj + 1] += (f32x4){c[0], c[1], d[0], d[1]} * scale; }
}

__device__ __forceinline__ void prep_tile_src(const Params& p, int l, int it, const float*& src, int& ld, unsigned char*& dst, int& Kdst, int& rmap) {
    const int e = it / 48, r = it % 48;
    unsigned char* Wgu = p.ws + WS_WGU; unsigned char* Wd = p.ws + WS_WD;
    const float* weg = p.weg; const float* weu = p.weu; const float* wsg = p.wsg; const float* wsu = p.wsu;
    asm volatile("" : "+s"(weg), "+s"(weu), "+s"(wsg), "+s"(wsu));
    if (r < 32) { const int half = r >> 4, q = r & 15, kb = q >> 1, nb = q & 1;
        const float* s0 = (e < 64) ? ((half ? weu : weg) + ((size_t)(l * 64 + e) * 1024) * 256) : ((half ? wsu : wsg) + (size_t)l * 1024 * 256);
        src = s0 + (size_t)(128 * kb) * 256 + 128 * nb; ld = 256; dst = Wgu + ((size_t)e * 512 + nb * 256 + half * 128) * 1024 + 128 * kb; Kdst = 1024; rmap = 0;
    } else { const int q = r - 32, kb = q >> 3, nb = q & 7;
        const float* s0 = (e < 64) ? (p.wed + ((size_t)(l * 64 + e) * 256) * 1024) : (p.wsd + (size_t)l * 256 * 1024);
        src = s0 + (size_t)(128 * kb) * 1024 + 128 * nb; ld = 1024; dst = Wd + ((size_t)e * 1024 + 128 * nb) * 256 + 128 * kb; Kdst = 256; rmap = 0; }
}
__device__ __forceinline__ void ph_prep(const Params& p, const Ctx& c, int l) {
    unsigned char* ws = p.ws;
    constexpr int PP = 129;
    LAS float* tl = (LAS float*)c.lds;
    LAS unsigned char* t2 = c.lds + 128 * PP * 4;
    const int tid = c.tid, r0 = tid >> 5, c4 = (tid & 31) * 4;
    const int NTILE = 65 * 48;
    f32x4 v[8];
    int it = c.bid;
    { const float* src; int ld, Kd, rm; unsigned char* dst; prep_tile_src(p, l, it < NTILE ? it : NTILE - 1, src, ld, dst, Kd, rm);
#pragma unroll
        for (int j = 0; j < 8; ++j) v[j] = *(const f32x4*)(src + (size_t)(r0 + 16 * j) * ld + c4); }
    for (; it < NTILE; it += c.G) {
        const float* src; int ld, Kd, rm; unsigned char* dst; prep_tile_src(p, l, it, src, ld, dst, Kd, rm);
#pragma unroll
        for (int j = 0; j < 8; ++j) { LAS float* w = tl + (r0 + 16 * j) * PP + c4; w[0] = v[j][0] * 32.f; w[1] = v[j][1] * 32.f; w[2] = v[j][2] * 32.f; w[3] = v[j][3] * 32.f; }
        { const int nx = (it + c.G < NTILE) ? it + c.G : it;
          const float* s2; int l2, K2, r2; unsigned char* d2; prep_tile_src(p, l, nx, s2, l2, d2, K2, r2);
#pragma unroll
          for (int j = 0; j < 8; ++j) v[j] = *(const f32x4*)(s2 + (size_t)(r0 + 16 * j) * l2 + c4); }
        __syncthreads();
#pragma unroll
        for (int h = 0; h < 2; ++h) { const int n = tid & 127, kc = (tid >> 7) + 4 * h; const LAS float* s = tl + (16 * kc) * PP + n; u32x4 o;
            o.x = pk4_fp8(s[0 * PP], s[1 * PP], s[2 * PP], s[3 * PP]); o.y = pk4_fp8(s[4 * PP], s[5 * PP], s[6 * PP], s[7 * PP]); o.z = pk4_fp8(s[8 * PP], s[9 * PP], s[10 * PP], s[11 * PP]); o.w = pk4_fp8(s[12 * PP], s[13 * PP], s[14 * PP], s[15 * PP]);
            *(LAS u32x4*)(t2 + n * 128 + ((kc ^ (n & 7)) * 16)) = o; }
        __syncthreads();
#pragma unroll
        for (int h = 0; h < 2; ++h) { const int n = (tid >> 3) + 64 * h, kc = tid & 7; const u32x4 o = *(const LAS u32x4*)(t2 + n * 128 + ((kc ^ (n & 7)) * 16));
            *(u32x4*)(dst + (size_t)n * Kd + 16 * kc) = o; }
        __syncthreads();
    }
    if (l == 0) {
        const float* mod = (const float*)(ws + WS_MOD); bf16_t* H = (bf16_t*)(ws + WS_H);
        { const int lane = c.lane; f32x4 v[4]; int t = c.gw;
#pragma unroll
          for (int j = 0; j < 4; ++j) v[j] = *(const f32x4*)(p.x + (size_t)(t < T ? t : 0) * 1024 + RC(j));
          for (; t < T; t += c.ngw) { const int b = t / S; f32x4 nv[4]; const int tn = (t + c.ngw < T) ? t + c.ngw : t;
#pragma unroll
            for (int j = 0; j < 4; ++j) nv[j] = *(const f32x4*)(p.x + (size_t)tn * 1024 + RC(j));
            write_mod_row(v, mod + (size_t)b * 6144 + 0, mod + (size_t)b * 6144 + 1024, H + (size_t)t * 1024, lane);
            { bf16_t* xr = (bf16_t*)(ws + WS_X16) + (size_t)t * 1024; store8_bf16(xr + RC(0), v[0], v[1]); store8_bf16(xr + RC(2), v[2], v[3]); }
#pragma unroll
            for (int j = 0; j < 4; ++j) v[j] = nv[j]; } }
        { const bf16_t* WrT = (const bf16_t*)(ws + WS_WR); bf16_t* WrM = (bf16_t*)(ws + WS_WRM); float* C0 = (float*)(ws + WS_C0); const int lane = c.lane;
          for (int it = c.gw; it < NL * 16 * 64; it += c.ngw) { const int e = it & 63, b = (it >> 6) & 15, ll = it >> 10;
              const bf16_t* wr = WrT + ((size_t)ll * 256 + e) * 1024 + 16 * lane; const float* m2 = mod + ((size_t)ll * 16 + b) * 6144;
              const u32x4 wa = *(const u32x4*)wr, wb = *(const u32x4*)(wr + 8);
              const float wv[16] = {bflo(wa.x), bfhi(wa.x), bflo(wa.y), bfhi(wa.y), bflo(wa.z), bfhi(wa.z), bflo(wa.w), bfhi(wa.w), bflo(wb.x), bfhi(wb.x), bflo(wb.y), bfhi(wb.y), bflo(wb.z), bfhi(wb.z), bflo(wb.w), bfhi(wb.w)};
              float dot = 0.f; f32x4 o[4];
#pragma unroll
              for (int j = 0; j < 4; ++j) { const f32x4 s1 = *(const f32x4*)(m2 + 4 * 1024 + 16 * lane + 4 * j), s0 = *(const f32x4*)(m2 + 3 * 1024 + 16 * lane + 4 * j);
#pragma unroll
                  for (int i = 0; i < 4; ++i) { o[j][i] = wv[4 * j + i] * (1.f + s1[i]); dot += wv[4 * j + i] * s0[i]; } }
              bf16_t* dst = WrM + (size_t)it * 1024 + 16 * lane; store8_bf16(dst, o[0], o[1]); store8_bf16(dst + 8, o[2], o[3]);
              dot = wave_sum(dot); if (lane == 0) C0[it] = dot; } }
    }
}

__device__ __forceinline__ void acc8(float (&s)[8], const u32x4 w, float m) {
    s[0] += m * bflo(w.x); s[1] += m * bfhi(w.x); s[2] += m * bflo(w.y); s[3] += m * bfhi(w.y); s[4] += m * bflo(w.z); s[5] += m * bfhi(w.z); s[6] += m * bflo(w.w); s[7] += m * bfhi(w.w);
}
__device__ __forceinline__ float ssq8(const u32x4 w) {
    const float a = bflo(w.x), b = bfhi(w.x), c = bflo(w.y), d = bfhi(w.y), e = bflo(w.z), f = bfhi(w.z), g = bflo(w.w), h = bfhi(w.w);
    return (a * a + b * b) + (c * c + d * d) + (e * e + f * f) + (g * g + h * h);
}
__device__ __forceinline__ void ph_post_in(const Params& p, const Ctx& c, int l) {
    unsigned char* ws = p.ws;
    const GAS bf16_t* P = (const GAS bf16_t*)(ws + WS_P); GAS bf16_t* Kf = (GAS bf16_t*)(ws + WS_KF); GAS bf16_t* MIX = (GAS bf16_t*)(ws + WS_MIX);
    GAS float* rsq = (GAS float*)(ws + WS_RSQ); GAS float* rskv = (GAS float*)(ws + WS_RSKV); const GAS f32x2* cs = (const GAS f32x2*)(ws + WS_CS);
    constexpr int WTP = 72;
    LAS bf16_t* wT = (LAS bf16_t*)c.lds;
    { f32x4 wv[8];
#pragma unroll
      for (int k = 0; k < 8; ++k) wv[k] = *(const f32x4*)(p.w_pool + (size_t)l * 16384 + 4 * (c.tid + NTHREADS * k));
#pragma unroll
      for (int k = 0; k < 8; ++k) { const int i = 4 * (c.tid + NTHREADS * k), g = i >> 12, cc = (i >> 6) & 63, d = i & 63;
#pragma unroll
          for (int j = 0; j < 4; ++j) wT[(g * 64 + d + j) * WTP + cc] = (bf16_t)(cvt_pk_bf16(wv[k][j], 0.f) & 0xffffu); } }
    __syncthreads();
    const int lane = c.lane, r = lane & 15, q = lane >> 4;
    for (int task = c.gw; task < T / 16; task += c.ngw) {
        const int t = task * 16 + r, s = t % S;
        const GAS bf16_t* row = P + (size_t)t * 1024;
        float rq_, rk_; u32x4 wl, wh; u32x2 po[4][4];
        { float sq = 0.f, sk = 0.f;
#pragma unroll
          for (int j = 0; j < 12; ++j) sq += ssq8(*(const GAS u32x4*)(row + 256 + 96 * q + 8 * j));
#pragma unroll
          for (int j = 0; j < 8; ++j) sk += ssq8(*(const GAS u32x4*)(row + 640 + 64 * q + 8 * j));
          sq += SWZ_XOR(sq, 16); sk += SWZ_XOR(sk, 16);
          { const auto rr = __builtin_amdgcn_permlane32_swap(__float_as_uint(sq), __float_as_uint(sq), false, false); sq = __uint_as_float(rr[0]) + __uint_as_float(rr[1]); }
          { const auto rr = __builtin_amdgcn_permlane32_swap(__float_as_uint(sk), __float_as_uint(sk), false, false); sk = __uint_as_float(rr[0]) + __uint_as_float(rr[1]); }
          rq_ = 1.0f / sqrtf(sq * (1.f / 384.f) + RMS_EPS); rk_ = 1.0f / sqrtf(sk * (1.f / 256.f) + RMS_EPS); }
        { const u32x4 x1 = *(const GAS u32x4*)(row + 896 + 8 * q), x2 = *(const GAS u32x4*)(row + 928 + 8 * q);
          const GAS f32x4* cp = (const GAS f32x4*)(cs + (size_t)t * 32 + 8 * q);
          const f32x4 c0 = cp[0], c1 = cp[1], c2 = cp[2], c3 = cp[3];
          const float a[8] = {bflo(x1.x), bfhi(x1.x), bflo(x1.y), bfhi(x1.y), bflo(x1.z), bfhi(x1.z), bflo(x1.w), bfhi(x1.w)};
          const float b[8] = {bflo(x2.x), bfhi(x2.x), bflo(x2.y), bfhi(x2.y), bflo(x2.z), bfhi(x2.z), bflo(x2.w), bfhi(x2.w)};
          const float cc[8] = {c0[0], c0[2], c1[0], c1[2], c2[0], c2[2], c3[0], c3[2]}, sn[8] = {c0[1], c0[3], c1[1], c1[3], c2[1], c2[3], c3[1], c3[3]};
          f32x4 lo0, lo1, hi0, hi1;
#pragma unroll
          for (int j = 0; j < 4; ++j) { lo0[j] = a[j] * cc[j] - b[j] * sn[j]; hi0[j] = b[j] * cc[j] + a[j] * sn[j]; lo1[j] = a[4 + j] * cc[4 + j] - b[4 + j] * sn[4 + j]; hi1[j] = b[4 + j] * cc[4 + j] + a[4 + j] * sn[4 + j]; }
          wl.x = cvt_pk_bf16(lo0[0], lo0[1]); wl.y = cvt_pk_bf16(lo0[2], lo0[3]); wl.z = cvt_pk_bf16(lo1[0], lo1[1]); wl.w = cvt_pk_bf16(lo1[2], lo1[3]);
          wh.x = cvt_pk_bf16(hi0[0], hi0[1]); wh.y = cvt_pk_bf16(hi0[2], hi0[3]); wh.z = cvt_pk_bf16(hi1[0], hi1[1]); wh.w = cvt_pk_bf16(hi1[2], hi1[3]);
        }
#pragma unroll
        for (int g = 0; g < 4; ++g) {
            constexpr int dummy = 0; (void)dummy;
            const int w = 2 << g, cnt = (s + 1 < w) ? s + 1 : w; const float inv = 1.0f / (float)cnt;
            bf16x8 tmf[2];
#pragma unroll
            for (int ks = 0; ks < 2; ++ks) {
                const GAS bf16_t* up = row + 64 * g + 32 * ks + 8 * q;
                float sm[8];
#pragma unroll
                for (int j = 0; j < 8; ++j) sm[j] = 0.f;
                const u32x4 self = *(const GAS u32x4*)up;
                acc8(sm, self, 1.f);
#pragma unroll
                for (int jj = 1; jj < w; ++jj) { const bool ok = jj < cnt; const u32x4 v = *(const GAS u32x4*)(up - (size_t)(ok ? jj : 0) * 1024); acc8(sm, v, ok ? 1.f : 0.f); }
                float sf[8] = {0.f, 0.f, 0.f, 0.f, 0.f, 0.f, 0.f, 0.f}; acc8(sf, self, 1.f);
                u32x4 wv; wv.x = cvt_pk_bf16(sm[0] * inv - sf[0], sm[1] * inv - sf[1]); wv.y = cvt_pk_bf16(sm[2] * inv - sf[2], sm[3] * inv - sf[3]);
                wv.z = cvt_pk_bf16(sm[4] * inv - sf[4], sm[5] * inv - sf[5]); wv.w = cvt_pk_bf16(sm[6] * inv - sf[6], sm[7] * inv - sf[7]);
                tmf[ks] = *reinterpret_cast<bf16x8*>(&wv);
            }
#pragma unroll
            for (int nt = 0; nt < 4; ++nt) { f32x4 a4 = {0.f, 0.f, 0.f, 0.f};
#pragma unroll
                for (int ks = 0; ks < 2; ++ks) { const bf16x8 wf = *(const LAS bf16x8*)(wT + (g * 64 + 16 * nt + r) * WTP + 32 * ks + 8 * q);
                    a4 = __builtin_amdgcn_mfma_f32_16x16x32_bf16(wf, tmf[ks], a4, 0, 0, 0); }
                const f32x4 ps = *(const f32x4*)(p.pool_scale + l * 256 + 64 * g + 16 * nt + 4 * q);
                po[g][nt].x = cvt_pk_bf16(a4[0] * ps[0], a4[1] * ps[1]); po[g][nt].y = cvt_pk_bf16(a4[2] * ps[2], a4[3] * ps[3]); }
        }
        if (q == 0) { rsq[t] = rq_; rskv[t] = rk_; }
        { GAS bf16_t* kp = (GAS bf16_t*)(ws + WS_KR) + (size_t)t * 64 + 8 * q; *(GAS u32x4*)kp = wl; *(GAS u32x4*)(kp + 32) = wh; }
#pragma unroll
        for (int g = 0; g < 4; ++g)
#pragma unroll
            for (int nt = 0; nt < 4; ++nt) *(GAS u32x2*)(MIX + (size_t)t * 1024 + 64 * g + 16 * nt + 4 * q) = po[g][nt];
    }
}

__device__ __forceinline__ void ph_attn_naive(const Params& p, const Ctx& c) {
    unsigned char* ws = p.ws;
    const bf16_t* Q = (const bf16_t*)(ws + WS_Q); const bf16_t* Kf = (const bf16_t*)(ws + WS_KF); const bf16_t* V = (const bf16_t*)(ws + WS_V); bf16_t* MIX = (bf16_t*)(ws + WS_MIX);
    LAS float* qs = (LAS float*)(c.lds + c.wid * 8192);
    const int lane = c.lane;
    for (int item = c.bid; item < 96 * 32; item += c.G) {
        const int bh = item % 96, qb = 31 - item / 96, b = bh / NH, h = bh % NH;
        const int q0 = qb * 64 + c.wid * 8;
        for (int i = lane; i < 8 * 192; i += 64) { const int r = i / 192, d = i % 192; qs[i] = bf2f(Q[(size_t)(b * S + q0 + r) * 1152 + h * 192 + d]); }
        asm volatile("s_waitcnt lgkmcnt(0)" ::: "memory");
        float m[8], lsum[8], o0[8], o1[8];
#pragma unroll
        for (int r = 0; r < 8; ++r) { m[r] = -1e30f; lsum[r] = 0.f; o0[r] = 0.f; o1[r] = 0.f; }
        const int last = q0 + 7, nch = last / 64 + 1;
        for (int ch = 0; ch < nch; ++ch) {
            const int key = ch * 64 + lane; float sc[8];
#pragma unroll
            for (int r = 0; r < 8; ++r) sc[r] = 0.f;
            if (key <= last) {
                const bf16_t* kp = Kf + (size_t)(b * S + key) * 1152 + h * 192;
                for (int cc = 0; cc < 24; ++cc) { const u32x4 kw = *(const u32x4*)(kp + 8 * cc); float kf[8];
#pragma unroll
                    for (int j = 0; j < 4; ++j) { kf[2 * j] = bflo(kw[j]); kf[2 * j + 1] = bfhi(kw[j]); }
#pragma unroll
                    for (int r = 0; r < 8; ++r) { const f32x4 qa = *(const LAS f32x4*)&qs[r * 192 + 8 * cc], qb2 = *(const LAS f32x4*)&qs[r * 192 + 8 * cc + 4];
                        sc[r] += qa[0] * kf[0] + qa[1] * kf[1] + qa[2] * kf[2] + qa[3] * kf[3] + qb2[0] * kf[4] + qb2[1] * kf[5] + qb2[2] * kf[6] + qb2[3] * kf[7]; } }
            }
            float pr[8];
#pragma unroll
            for (int r = 0; r < 8; ++r) { const float sv = (key <= q0 + r) ? sc[r] : -__builtin_inff(); const float mx = wave_max(sv), mn = fmaxf(m[r], mx);
                const float al = __builtin_amdgcn_exp2f(m[r] - mn); const float pv = __builtin_amdgcn_exp2f(sv - mn);
                lsum[r] = lsum[r] * al + wave_sum(pv); o0[r] *= al; o1[r] *= al; m[r] = mn; pr[r] = pv; }
            const int kmax = (last - ch * 64 < 63) ? last - ch * 64 : 63;
            const bf16_t* vp = V + (size_t)(b * S + ch * 64) * 768 + h * 128 + 2 * lane;
            for (int kk = 0; kk <= kmax; ++kk) { const unsigned vw = *(const unsigned*)(vp + (size_t)kk * 768); const float v0 = bflo(vw), v1 = bfhi(vw);
#pragma unroll
                for (int r = 0; r < 8; ++r) { const float pk = __int_as_float(__builtin_amdgcn_readlane(__float_as_int(pr[r]), kk)); o0[r] += pk * v0; o1[r] += pk * v1; } }
        }
#pragma unroll
        for (int r = 0; r < 8; ++r) { const float il = 1.f / lsum[r];
            *(unsigned*)(MIX + (size_t)(b * S + q0 + r) * 1024 + 256 + h * 128 + 2 * lane) = cvt_pk_bf16(o0[r] * il, o1[r] * il); }
    }
}


namespace att {
typedef short s16x4 __attribute__((ext_vector_type(4)));
typedef float f32x16 __attribute__((ext_vector_type(16)));
constexpr int VB = 16384, KNB = 16384, KRB = 8192;
constexpr int O_V = 0, O_KN = 2 * VB, O_KR = O_KN + 2 * KNB, O_WS = O_KR + 2 * KRB;
constexpr float THR2 = 11.5f;
#define A_KSWZ(row, colB) ((row) * 256 + ((colB) ^ (((row) & 7) << 4)))
#define A_RSWZ(row, colB) ((row) * 128 + ((colB) ^ ((((row) >> 1) & 7) << 4)))
#define A_SBAR() __builtin_amdgcn_sched_barrier(0)
__device__ __forceinline__ int v_st(int k, int c) { const int kk = (k & ~0xC) | ((k & 4) << 1) | ((k & 8) >> 1); return ((kk >> 3) * 4 + (c >> 5)) * 512 + ((kk & 7) * 32 + (c & 31)) * 2; }
__device__ __forceinline__ int v_rd_base(int lane) { return ((lane & 3) << 3) | (((lane >> 2) & 3) << 6) | (((lane >> 4) & 1) << 5) | (((lane >> 5) & 1) << 8); }
constexpr int v_rd_off(int d0, int ks, int half) { return d0 * 512 + ks * 4096 + half * 2048; }
__device__ __forceinline__ int crow(int r, int hi) { return (r & 3) + 8 * (r >> 2) + 4 * hi; }
__device__ __forceinline__ void mask_tile(f32x16& p0, f32x16& p1, int dq) {
    const float NEG = -__builtin_inff();
#pragma unroll
    for (int r = 0; r < 16; ++r) { const int cc = (r & 3) + 8 * (r >> 2); if (dq - cc < 0) p0[r] = NEG; if (dq - cc - 32 < 0) p1[r] = NEG; }
}
__device__ __forceinline__ void softmax_tile(f32x16& p0, f32x16& p1, float& m_reg, float& l_reg, float& alpha, bf16x8& pa0, bf16x8& pa1, bf16x8& pa2, bf16x8& pa3) {
    float pmax = p0[0];
#pragma unroll
    for (int r = 1; r < 16; ++r) pmax = fmaxf(pmax, p0[r]);
#pragma unroll
    for (int r = 0; r < 16; ++r) pmax = fmaxf(pmax, p1[r]);
    { auto rr = __builtin_amdgcn_permlane32_swap(__float_as_uint(pmax), __float_as_uint(pmax), false, false); pmax = fmaxf(__uint_as_float(rr[0]), __uint_as_float(rr[1])); }
    float mn;
    if (__builtin_expect(__all(pmax - m_reg <= THR2), 1)) { mn = m_reg; alpha = 1.f; }
    else { mn = fmaxf(m_reg, pmax); alpha = __builtin_amdgcn_exp2f(m_reg - mn); m_reg = mn; }
#pragma unroll
    for (int r = 0; r < 16; ++r) { p0[r] = __builtin_amdgcn_exp2f(p0[r] - mn); p1[r] = __builtin_amdgcn_exp2f(p1[r] - mn); }
    float ps = 0.f;
#pragma unroll
    for (int r = 0; r < 16; ++r) ps += p0[r];
#pragma unroll
    for (int r = 0; r < 16; ++r) ps += p1[r];
    { auto rr = __builtin_amdgcn_permlane32_swap(__float_as_uint(ps), __float_as_uint(ps), false, false); ps = __uint_as_float(rr[0]) + __uint_as_float(rr[1]); }
    l_reg = l_reg * alpha + ps;
#define A_PK4(P, B_, OUT) do { unsigned a0 = cvt_pk_bf16(P[B_ + 0], P[B_ + 1]), a1 = cvt_pk_bf16(P[B_ + 2], P[B_ + 3]);                   \
        unsigned b0 = cvt_pk_bf16(P[B_ + 4], P[B_ + 5]), b1 = cvt_pk_bf16(P[B_ + 6], P[B_ + 7]);                                          \
        auto r0 = __builtin_amdgcn_permlane32_swap(a0, b0, false, false); auto r1 = __builtin_amdgcn_permlane32_swap(a1, b1, false, false); \
        u32x4 w = {r0[0], r1[0], r0[1], r1[1]}; OUT = *reinterpret_cast<bf16x8*>(&w); } while (0)
    A_PK4(p0, 0, pa0); A_PK4(p0, 8, pa1); A_PK4(p1, 0, pa2); A_PK4(p1, 8, pa3);
#undef A_PK4
}
template <int KBUF>
__device__ __forceinline__ void qkt(f32x16& p0, f32x16& p1, const LAS char* lds, int r32, int hi, const bf16x8 (&qr)[12]) {
    p0 = f32x16{}; p1 = f32x16{};
    const LAS char* kb[4]; const LAS char* rb[4];
#pragma unroll
    for (int dd = 0; dd < 4; ++dd) { kb[dd] = lds + O_KN + KBUF * KNB + A_KSWZ(r32, (dd * 16 + hi * 8) * 2); rb[dd] = lds + O_KR + KBUF * KRB + A_RSWZ(r32, (dd * 16 + hi * 8) * 2); }
#pragma unroll
    for (int d0 = 0; d0 < 8; ++d0) { const LAS char* a = kb[d0 & 3] + (d0 >> 2) * 128;
        const bf16x8 b0 = *reinterpret_cast<const LAS bf16x8*>(a), b1 = *reinterpret_cast<const LAS bf16x8*>(a + 32 * 256);
        p0 = __builtin_amdgcn_mfma_f32_32x32x16_bf16(b0, qr[d0], p0, 0, 0, 0);
        p1 = __builtin_amdgcn_mfma_f32_32x32x16_bf16(b1, qr[d0], p1, 0, 0, 0); }
#pragma unroll
    for (int dd = 0; dd < 4; ++dd) { const bf16x8 b0 = *reinterpret_cast<const LAS bf16x8*>(rb[dd]), b1 = *reinterpret_cast<const LAS bf16x8*>(rb[dd] + 32 * 128);
        p0 = __builtin_amdgcn_mfma_f32_32x32x16_bf16(b0, qr[8 + dd], p0, 0, 0, 0);
        p1 = __builtin_amdgcn_mfma_f32_32x32x16_bf16(b1, qr[8 + dd], p1, 0, 0, 0); }
}
template <int VBUF>
__device__ __forceinline__ void pv_tile(f32x16 (&o)[4], int vb0, bf16x8 pa0, bf16x8 pa1, bf16x8 pa2, bf16x8 pa3) {
#define A_TRRD(dst, off) asm volatile("ds_read_b64_tr_b16 %0, %1 offset:%2" : "=&v"(dst) : "v"(vb0), "i"(off) : "memory")
#define A_PV_D0(d0) do { s16x4 l0, l1, l2, l3, h0, h1, h2, h3; constexpr int b_ = O_V + VBUF * VB + v_rd_off(d0, 0, 0); \
        A_TRRD(l0, b_); A_TRRD(h0, b_ + 2048); A_TRRD(l1, b_ + 4096); A_TRRD(h1, b_ + 6144); A_TRRD(l2, b_ + 8192); A_TRRD(h2, b_ + 10240); A_TRRD(l3, b_ + 12288); A_TRRD(h3, b_ + 14336); \
        asm volatile("s_waitcnt lgkmcnt(0)" ::: "memory"); A_SBAR(); \
        o[d0] = __builtin_amdgcn_mfma_f32_32x32x16_bf16(pa0, (bf16x8){l0[0], l0[1], l0[2], l0[3], h0[0], h0[1], h0[2], h0[3]}, o[d0], 0, 0, 0); \
        o[d0] = __builtin_amdgcn_mfma_f32_32x32x16_bf16(pa1, (bf16x8){l1[0], l1[1], l1[2], l1[3], h1[0], h1[1], h1[2], h1[3]}, o[d0], 0, 0, 0); \
        o[d0] = __builtin_amdgcn_mfma_f32_32x32x16_bf16(pa2, (bf16x8){l2[0], l2[1], l2[2], l2[3], h2[0], h2[1], h2[2], h2[3]}, o[d0], 0, 0, 0); \
        o[d0] = __builtin_amdgcn_mfma_f32_32x32x16_bf16(pa3, (bf16x8){l3[0], l3[1], l3[2], l3[3], h3[0], h3[1], h3[2], h3[3]}, o[d0], 0, 0, 0); } while (0)
    A_PV_D0(0); A_PV_D0(1); A_PV_D0(2); A_PV_D0(3);
#undef A_PV_D0
#undef A_TRRD
}
struct Stage { bf16x8 kn0, kn1, kr, v0, v1; };
__device__ __forceinline__ void block(const GAS bf16_t* Q, const GAS bf16_t* Kf, const GAS bf16_t* KR, const GAS bf16_t* V, GAS bf16_t* MIX, LAS char* lds, int b, int h, int qb, int wid) {
    const int lane = fresh_lane(), tid = wid * 64 + lane, r32 = lane & 31, hi = lane >> 5;
    const int tb = b * S, P0 = qb * 256, qlo = P0 + wid * 32, NT = 4 * qb + 4;
    LAS float* wsf = (LAS float*)(lds + O_WS) + wid * 64; LAS float* li_l = wsf; LAS float* al_l = wsf + 32;
    const int sr = tid >> 4, sc = (tid & 15) * 8, rr = tid >> 3, rc = (tid & 7) * 8;
    const int kws = A_KSWZ(sr, sc * 2), rws = A_RSWZ(rr, rc * 2), vst0 = v_st(sr, sc), vst1 = v_st(32 + sr, sc);
    const GAS bf16_t* kng = Kf + (size_t)(tb + sr) * 1152 + h * 192 + sc;
    const GAS bf16_t* krg = KR + (size_t)(tb + rr) * 64 + rc;
    const GAS bf16_t* vg = V + (size_t)(tb + sr) * 768 + h * 128 + sc;
    const int vb0 = (int)(uintptr_t)(lds) + v_rd_base(lane);
    Stage st;
#define A_SLOAD(kb0) do { st.kn0 = *(const GAS bf16x8*)(kng + (size_t)(kb0) * 1152); st.kn1 = *(const GAS bf16x8*)(kng + (size_t)((kb0) + 32) * 1152); \
        st.kr = *(const GAS bf16x8*)(krg + (size_t)(kb0) * 64); st.v0 = *(const GAS bf16x8*)(vg + (size_t)(kb0) * 768); st.v1 = *(const GAS bf16x8*)(vg + (size_t)((kb0) + 32) * 768); } while (0)
#define A_SWRITE(bf) do { *(LAS bf16x8*)(lds + O_KN + (bf) * KNB + kws) = st.kn0; *(LAS bf16x8*)(lds + O_KN + (bf) * KNB + kws + 32 * 256) = st.kn1; \
        *(LAS bf16x8*)(lds + O_KR + (bf) * KRB + rws) = st.kr; *(LAS bf16x8*)(lds + O_V + (bf) * VB + vst0) = st.v0; *(LAS bf16x8*)(lds + O_V + (bf) * VB + vst1) = st.v1; } while (0)
    bf16x8 qr[12];
    { const GAS bf16_t* qp = Q + (size_t)(tb + qlo + r32) * 1152 + h * 192 + hi * 8;
#pragma unroll
      for (int d0 = 0; d0 < 12; ++d0) qr[d0] = *(const GAS bf16x8*)(qp + d0 * 16); }
    A_SLOAD(0);
    asm volatile("s_waitcnt vmcnt(0)" ::: "memory");
    A_SWRITE(0);
    __syncthreads();
    float m_reg = -1e30f, l_reg = 0.f; f32x16 o[4] = {};
    f32x16 p0, p1; bf16x8 pa0, pa1, pa2, pa3; float alpha;
#define A_STEP(t, KB_, SB_) do { \
        if ((t) + 1 < NT) A_SLOAD(((t) + 1) * 64); \
        A_SBAR(); \
        if ((t) * 64 <= qlo + 31) { \
            qkt<KB_>(p0, p1, lds, r32, hi, qr); \
            if ((t) * 64 + 63 > qlo) mask_tile(p0, p1, qlo + r32 - (t) * 64 - 4 * hi); \
            softmax_tile(p0, p1, m_reg, l_reg, alpha, pa0, pa1, pa2, pa3); \
            if (__any(alpha < 1.f)) { if (hi == 0) al_l[r32] = alpha; asm volatile("s_waitcnt lgkmcnt(0)" ::: "memory"); \
                _Pragma("unroll") for (int d_ = 0; d_ < 4; ++d_) _Pragma("unroll") for (int r = 0; r < 16; ++r) o[d_][r] *= al_l[crow(r, hi)]; } \
            A_SBAR(); \
            pv_tile<KB_>(o, vb0, pa0, pa1, pa2, pa3); } \
        if ((t) + 1 < NT) { asm volatile("s_waitcnt vmcnt(0)" ::: "memory"); A_SWRITE(SB_); } \
        __syncthreads(); } while (0)
    for (int t = 0; t < NT; t += 2) { A_STEP(t, 0, 1); A_STEP(t + 1, 1, 0); }
    if (hi == 0) li_l[r32] = l_reg;
    asm volatile("s_waitcnt lgkmcnt(0)" ::: "memory");
    GAS bf16_t* op = MIX + (size_t)(tb + qlo) * 1024 + 256 + h * 128 + r32;
#pragma unroll
    for (int r = 0; r < 16; ++r) { const int orow = crow(r, hi); const float il = __builtin_amdgcn_rcpf(li_l[orow]);
#pragma unroll
        for (int d0 = 0; d0 < 4; ++d0) { const float v = o[d0][r] * il; const float vn = SWZ_XOR(v, 1);
            if ((r32 & 1) == 0) *(GAS unsigned*)(op + (size_t)orow * 1024 + d0 * 32) = cvt_pk_bf16(v, vn); } }
    __syncthreads();
#undef A_STEP
#undef A_SLOAD
#undef A_SWRITE
}
}

__device__ __forceinline__ void ph_attn(const Params& p, const Ctx& c) {
    unsigned char* ws = p.ws;
    const GAS bf16_t* Q = (const GAS bf16_t*)(ws + WS_Q); const GAS bf16_t* Kf = (const GAS bf16_t*)(ws + WS_KF); const GAS bf16_t* V = (const GAS bf16_t*)(ws + WS_V); GAS bf16_t* MIX = (GAS bf16_t*)(ws + WS_MIX);
    LAS char* lds = (LAS char*)c.lds;
    int nit = 0, trv = 0; unsigned tabv = 0u;
    if (c.G == 256) {
        const int x = c.bid & 7, y = c.bid >> 3, tr = x * 4 + (y >> 3), bin = y & 7;
        const unsigned tab = bin == 0 ? ((0u << 3 | 7) | (0u << 3 | 3) << 5 | (0u << 3 | 0) << 10 | 0x1fu << 15 | 0x1fu << 20)
                           : bin == 1 ? ((1u << 3 | 7) | (0u << 3 | 2) << 5 | (0u << 3 | 1) << 10 | 0x1fu << 15 | 0x1fu << 20)
                           : bin == 2 ? ((2u << 3 | 7) | (0u << 3 | 4) << 5 | (1u << 3 | 0) << 10 | 0x1fu << 15 | 0x1fu << 20)
                           : bin == 3 ? ((0u << 3 | 6) | (1u << 3 | 4) << 5 | (1u << 3 | 1) << 10 | 0x1fu << 15 | 0x1fu << 20)
                           : bin == 4 ? ((1u << 3 | 6) | (1u << 3 | 3) << 5 | (1u << 3 | 2) << 10 | 0x1fu << 15 | 0x1fu << 20)
                           : bin == 5 ? ((2u << 3 | 6) | (0u << 3 | 5) << 5 | (2u << 3 | 0) << 10 | 0x1fu << 15 | 0x1fu << 20)
                           : bin == 6 ? ((1u << 3 | 5) | (2u << 3 | 4) << 5 | (2u << 3 | 1) << 10 | 0x1fu << 15 | 0x1fu << 20)
                           :            ((2u << 3 | 5) | (2u << 3 | 3) << 5 | (2u << 3 | 2) << 10 | 0x1fu << 15 | 0x1fu << 20);
        nit = 5; tabv = tab; trv = tr;
    } else { nit = (96 * 8 - c.bid + c.G - 1) / c.G; }
    for (int k = 0; k < nit; ++k) {
        int bh, qb;
        if (c.G == 256) { const unsigned en = (tabv >> (5 * k)) & 0x1fu; if (en == 0x1fu) break; bh = trv * 3 + (int)(en >> 3); qb = (int)(en & 7u); }
        else { const int item = c.bid + k * c.G; bh = item % 96; qb = 7 - item / 96; }
        att::block(Q, Kf, (const GAS bf16_t*)(ws + WS_KR), V, MIX, lds, bh / NH, bh % NH, qb, c.wid);
    }
}

__device__ __forceinline__ void ln_row(f32x4 (&v)[4], const float* g, const float* bta, int lane) {
    float s = 0.f;
#pragma unroll
    for (int j = 0; j < 4; ++j) s += (v[j][0] + v[j][1]) + (v[j][2] + v[j][3]);
    const float mean = wave_sum(s) * (1.f / D); float s2 = 0.f;
#pragma unroll
    for (int j = 0; j < 4; ++j) { v[j] = v[j] - mean; s2 += (v[j][0] * v[j][0] + v[j][1] * v[j][1]) + (v[j][2] * v[j][2] + v[j][3] * v[j][3]); }
    const float rstd = 1.0f / sqrtf(wave_sum(s2) * (1.f / D) + LN_EPS);
#pragma unroll
    for (int j = 0; j < 4; ++j) { const f32x4 gg = *(const f32x4*)(g + RC(j)), bb = *(const f32x4*)(bta + RC(j)); v[j] = v[j] * rstd * gg + bb; }
}

__device__ __forceinline__ void ln_row_q(f32x4 (&v)[4], const f32x4 (&gg)[4], const f32x4 (&bb)[4]) {
    float s = 0.f;
#pragma unroll
    for (int j = 0; j < 4; ++j) s += (v[j][0] + v[j][1]) + (v[j][2] + v[j][3]);
    const float mean = wave_sum(s) * (1.f / D); float s2 = 0.f;
#pragma unroll
    for (int j = 0; j < 4; ++j) { v[j] = v[j] - mean; s2 += (v[j][0] * v[j][0] + v[j][1] * v[j][1]) + (v[j][2] * v[j][2] + v[j][3] * v[j][3]); }
    const float rstd = 1.0f / sqrtf(wave_sum(s2) * (1.f / D) + LN_EPS);
#pragma unroll
    for (int j = 0; j < 4; ++j) v[j] = v[j] * rstd * gg[j] + bb[j];
}
__device__ __forceinline__ void ph_fill_lists(const Params& p, const Ctx& c) {
    u32x4* lp = (u32x4*)(p.ws + WS_LIST); int* lists = (int*)(p.ws + WS_LIST); unsigned d = (unsigned)A_TOT; asm volatile("" : "+v"(d));
    for (int i = c.bid * NTHREADS + c.tid; i < 64 * T / 4; i += c.G * NTHREADS) lp[i] = (u32x4){d, d, d, d};
    for (int i = c.bid * NTHREADS + c.tid; i < T; i += c.G * NTHREADS) lists[(size_t)64 * T + i] = 8 * T + i;
}
__device__ __forceinline__ void ph_ln1r(const Params& p, const Ctx& c, int l) {
    unsigned char* ws = p.ws;
    const float* mod = (const float*)(ws + WS_MOD) + (size_t)l * 16 * 6144; bf16_t* H = (bf16_t*)(ws + WS_H); unsigned char* H8 = (unsigned char*)(ws + WS_H8);
    float* tg = (float*)(ws + WS_TG); int* lists = (int*)(ws + WS_LIST);
    unsigned* cnt = (unsigned*)(ws + WS_CTL) + CW_CNT + l * 64;
    constexpr int RT = 128, LP = 65;
    LAS unsigned char* wl = c.lds;
    LAS float* lg = (LAS float*)(c.lds + 65536);
    LAS unsigned* lcnt = (LAS unsigned*)(c.lds + LDS_MISC + 1024); LAS unsigned* gbase = lcnt + 64;
    const int tid = c.tid, lane = c.lane, r = lane & 15, q = lane >> 4;
    for (int pass = c.bid; pass < T / RT; pass += c.G) {
        const int row0 = pass * RT + c.wid * 16, b = row0 / S;
        const GAS bf16_t* Wr = (const GAS bf16_t*)(ws + WS_WRM) + ((size_t)(l * 16 + b) * 64) * 1024;
        const float* c0 = (const float*)(ws + WS_C0) + (size_t)(l * 16 + b) * 64;
        { f32x4 lgn[4], lbn[4], s1[4], s0[4];
#pragma unroll
          for (int j = 0; j < 4; ++j) { lgn[j] = *(const f32x4*)(p.ln1g + l * 1024 + RC(j)); lbn[j] = *(const f32x4*)(p.ln1b + l * 1024 + RC(j));
              s1[j] = *(const f32x4*)(mod + (size_t)b * 6144 + 4 * 1024 + RC(j)) + 1.f; s0[j] = *(const f32x4*)(mod + (size_t)b * 6144 + 3 * 1024 + RC(j)); }
          for (int i = 0; i < 16; i += 4) {
              f32x4 v[4][4];
#pragma unroll
              for (int u = 0; u < 4; ++u) load_bf16_row((const bf16_t*)(ws + WS_X16) + (size_t)(row0 + i + u) * 1024, v[u], lane);
#pragma unroll
              for (int u = 0; u < 4; ++u) { const int t = row0 + i + u; bf16_t* xr = (bf16_t*)(ws + WS_X16) + (size_t)t * 1024;
                  ln_row_q(v[u], lgn, lbn);
                  store8_bf16(xr + RC(0), v[u][0], v[u][1]); store8_bf16(xr + RC(2), v[u][2], v[u][3]);
                  f32x4 o[4];
#pragma unroll
                  for (int j = 0; j < 4; ++j) o[j] = v[u][j] * s1[j] + s0[j];
                  u32x2 a, bq; a.x = pk4_fp8(o[0][0], o[0][1], o[0][2], o[0][3]); a.y = pk4_fp8(o[1][0], o[1][1], o[1][2], o[1][3]); bq.x = pk4_fp8(o[2][0], o[2][1], o[2][2], o[2][3]); bq.y = pk4_fp8(o[3][0], o[3][1], o[3][2], o[3][3]);
                  *(u32x2*)(H8 + (size_t)t * 1024 + RC(0)) = a; *(u32x2*)(H8 + (size_t)t * 1024 + RC(2)) = bq; } } }
        asm volatile("s_waitcnt vmcnt(0)" ::: "memory");
        f32x4 acc[4];
#pragma unroll
        for (int nt = 0; nt < 4; ++nt) acc[nt] = (f32x4){0.f, 0.f, 0.f, 0.f};
        const GAS bf16_t* ah = (const GAS bf16_t*)(ws + WS_X16) + (size_t)(row0 + r) * 1024 + 8 * q;
#pragma unroll 1
        for (int kh = 0; kh < 2; ++kh) {
            __syncthreads();
            { u32x4 wv[8];
#pragma unroll
              for (int k = 0; k < 8; ++k) { const int i = tid + NTHREADS * k, n = i >> 6, kc = i & 63; wv[k] = *(const GAS u32x4*)(Wr + (size_t)n * 1024 + kh * 512 + kc * 8); }
#pragma unroll
              for (int k = 0; k < 8; ++k) { const int i = tid + NTHREADS * k, n = i >> 6, kc = i & 63; *(LAS u32x4*)(wl + n * 1024 + ((kc ^ (n & 15)) * 16)) = wv[k]; } }
            __syncthreads();
#pragma unroll 4
            for (int ks = 0; ks < 16; ++ks) { const bf16x8 Ah = *(const GAS bf16x8*)(ah + kh * 512 + 32 * ks);
#pragma unroll
                for (int nt = 0; nt < 4; ++nt) { const int n = 16 * nt + r, kc = 4 * ks + q; const bf16x8 Bh = *(const LAS bf16x8*)(wl + n * 1024 + ((kc ^ (n & 15)) * 16));
                    acc[nt] = __builtin_amdgcn_mfma_f32_16x16x32_bf16(Bh, Ah, acc[nt], 0, 0, 0); } }
        }
#pragma unroll
        for (int nt = 0; nt < 4; ++nt)
#pragma unroll
            for (int j = 0; j < 4; ++j) lg[(c.wid * 16 + r) * LP + 16 * nt + 4 * q + j] = acc[nt][j];
        { const int tid = c.wid * 64 + fresh_lane();
        if (tid < 64) lcnt[tid] = 0u;
        __syncthreads();
        const int tk = tid >> 2, sub = tid & 3, t = pass * RT + tk;
        const float NINF = -__builtin_inff();
#define QDPP_F(v, ctl) __int_as_float(__builtin_amdgcn_update_dpp(0, __float_as_int(v), (ctl), 0xf, 0xf, true))
#define QDPP_I(v, ctl) __builtin_amdgcn_update_dpp(0, (v), (ctl), 0xf, 0xf, true)
        float ch[16];
        { const LAS float* lr = lg + tk * LP + 16 * sub;
#pragma unroll
          for (int i = 0; i < 16; ++i) ch[i] = 1.f / (1.f + __expf(-(lr[i] + c0[16 * sub + i]))) + p.rbias[l * 64 + 16 * sub + i]; }
        float gs[2];
#pragma unroll
        for (int g = 0; g < 2; ++g) { float a = NINF, b2 = NINF;
#pragma unroll
            for (int j = 0; j < 8; ++j) { const float v = ch[8 * g + j]; const bool gt = v > a; b2 = gt ? a : (v > b2 ? v : b2); a = gt ? v : a; }
            gs[g] = a + b2; }
        float ga[8];
        ga[0] = QDPP_F(gs[0], 0x00); ga[1] = QDPP_F(gs[1], 0x00); ga[2] = QDPP_F(gs[0], 0x55); ga[3] = QDPP_F(gs[1], 0x55);
        ga[4] = QDPP_F(gs[0], 0xAA); ga[5] = QDPP_F(gs[1], 0xAA); ga[6] = QDPP_F(gs[0], 0xFF); ga[7] = QDPP_F(gs[1], 0xFF);
#pragma unroll
        for (int g = 0; g < 2; ++g) { const int G = 2 * sub + g; int rank = 0;
#pragma unroll
            for (int h = 0; h < 8; ++h) rank += (ga[h] > gs[g] || (ga[h] == gs[g] && h < G)) ? 1 : 0;
            if (rank >= 4) {
#pragma unroll
                for (int j = 0; j < 8; ++j) ch[8 * g + j] = NINF; } }
        int ek[8]; float wk[8]; float wsum = 0.f;
#pragma unroll
        for (int k = 0; k < 8; ++k) {
            float bv = ch[0]; int bi = 0;
#pragma unroll
            for (int i = 1; i < 16; ++i) { const bool gt = ch[i] > bv; bv = gt ? ch[i] : bv; bi = gt ? i : bi; }
            int be = 16 * sub + bi;
            { const float ov = QDPP_F(bv, 0xB1); const int oe = QDPP_I(be, 0xB1); const bool tk2 = ov > bv || (ov == bv && oe < be); bv = tk2 ? ov : bv; be = tk2 ? oe : be; }
            { const float ov = QDPP_F(bv, 0x4E); const int oe = QDPP_I(be, 0x4E); const bool tk2 = ov > bv || (ov == bv && oe < be); bv = tk2 ? ov : bv; be = tk2 ? oe : be; }
            ek[k] = be; const float w = bv - p.rbias[l * 64 + be]; wk[k] = w; wsum += w;
            const int mine = (be >> 4) == sub ? (be & 15) : -1;
#pragma unroll
            for (int i = 0; i < 16; ++i) ch[i] = (i == mine) ? NINF : ch[i];
        }
#undef QDPP_F
#undef QDPP_I
        const int ea = sub == 0 ? ek[0] : sub == 1 ? ek[2] : sub == 2 ? ek[4] : ek[6], eb = sub == 0 ? ek[1] : sub == 1 ? ek[3] : sub == 2 ? ek[5] : ek[7];
        const float wa = sub == 0 ? wk[0] : sub == 1 ? wk[2] : sub == 2 ? wk[4] : wk[6], wb = sub == 0 ? wk[1] : sub == 1 ? wk[3] : sub == 2 ? wk[5] : wk[7];
        const unsigned ra = atomicAdd((unsigned*)&lcnt[ea], 1u), rb = atomicAdd((unsigned*)&lcnt[eb], 1u);
        __syncthreads();
        if (tid < 64) gbase[tid] = atomicAdd(&cnt[tid], lcnt[tid]);
        __syncthreads();
        { const float inv = 2.5f / wsum;
          *(f32x2*)(tg + (size_t)t * 8 + 2 * sub) = (f32x2){wa * inv, wb * inv};
          lists[(size_t)ea * T + gbase[ea] + ra] = t * 8 + 2 * sub; lists[(size_t)eb * T + gbase[eb] + rb] = t * 8 + 2 * sub + 1; }
        __syncthreads(); }
    }
}

__device__ __forceinline__ void ln_row_p(f32x4 (&v)[4], const f32x4 (&gg)[4], const f32x4 (&bb)[4]) {
    float s = 0.f;
#pragma unroll
    for (int j = 0; j < 4; ++j) s += (v[j][0] + v[j][1]) + (v[j][2] + v[j][3]);
    const float mean = wave_sum(s) * (1.f / D); float s2 = 0.f;
#pragma unroll
    for (int j = 0; j < 4; ++j) { v[j] = v[j] - mean; s2 += (v[j][0] * v[j][0] + v[j][1] * v[j][1]) + (v[j][2] * v[j][2] + v[j][3] * v[j][3]); }
    const float rstd = 1.0f / sqrtf(wave_sum(s2) * (1.f / D) + LN_EPS);
#pragma unroll
    for (int j = 0; j < 4; ++j) v[j] = v[j] * rstd * gg[j] + bb[j];
}
__device__ __forceinline__ void ld_bf16_c16(const bf16_t* row, f32x4 (&f)[4], int lane) {
    const u32x4 a = *(const u32x4*)(row + 16 * lane), b = *(const u32x4*)(row + 16 * lane + 8);
    f[0] = (f32x4){bflo(a.x), bfhi(a.x), bflo(a.y), bfhi(a.y)}; f[1] = (f32x4){bflo(a.z), bfhi(a.z), bflo(a.w), bfhi(a.w)};
    f[2] = (f32x4){bflo(b.x), bfhi(b.x), bflo(b.y), bfhi(b.y)}; f[3] = (f32x4){bflo(b.z), bfhi(b.z), bflo(b.w), bfhi(b.w)};
}
__device__ __forceinline__ void fma_fp8_c16(const unsigned char* row, float scale, f32x4 (&f)[4], int lane) {
    const u32x4 w = __builtin_nontemporal_load((const u32x4*)(row + 16 * lane));
#pragma unroll
    for (int j = 0; j < 4; ++j) { const f32x2 a = __builtin_amdgcn_cvt_pk_f32_fp8((int)w[j], false), b = __builtin_amdgcn_cvt_pk_f32_fp8((int)w[j], true); f[j] += (f32x4){a[0], a[1], b[0], b[1]} * scale; }
}
__device__ __forceinline__ void st_bf16_c16(bf16_t* row, const f32x4 (&v)[4], int lane) { store8_bf16(row + 16 * lane, v[0], v[1]); store8_bf16(row + 16 * lane + 8, v[2], v[3]); }
__device__ __forceinline__ void ph_combine(const Params& p, const Ctx& c, int l) {
    unsigned char* ws = p.ws;
    const float* mod = (const float*)(ws + WS_MOD) + (size_t)l * 16 * 6144; const float* modn = mod + 16 * 6144; bf16_t* H = (bf16_t*)(ws + WS_H);
    const unsigned char* Y = (const unsigned char*)(ws + WS_Y); const float* tg = (const float*)(ws + WS_TG);
    const int lane = c.lane;
    for (int task = c.gw; task < T / 16; task += c.ngw) {
        const int t0 = task * 16, b = t0 / S;
        for (int i = 0; i < 16; i += 2) {
            f32x4 fa[4], fb[4], xa[4], xb[4];
            const int ta = t0 + i, tb = ta + 1;
            bf16_t* xra = (bf16_t*)(ws + WS_X16) + (size_t)ta * 1024; bf16_t* xrb = xra + 1024;
#pragma unroll
            for (int j = 0; j < 4; ++j) { fa[j] = (f32x4){0.f, 0.f, 0.f, 0.f}; fb[j] = (f32x4){0.f, 0.f, 0.f, 0.f}; }
            ld_bf16_c16(xra, xa, lane); ld_bf16_c16(xrb, xb, lane);
            fma_fp8_c16(Y + (size_t)(8 * T + ta) * 1024, 1.f / 16.f, fa, lane); fma_fp8_c16(Y + (size_t)(8 * T + tb) * 1024, 1.f / 16.f, fb, lane);
#pragma unroll
            for (int k = 0; k < 8; ++k) { fma_fp8_c16(Y + (size_t)(ta * 8 + k) * 1024, tg[(size_t)ta * 8 + k] * (1.f / 16.f), fa, lane); fma_fp8_c16(Y + (size_t)(tb * 8 + k) * 1024, tg[(size_t)tb * 8 + k] * (1.f / 16.f), fb, lane); }
            { f32x4 g2[4], lg[4], lb[4];
#pragma unroll
              for (int j = 0; j < 4; ++j) { const int cc = 16 * lane + 4 * j; g2[j] = *(const f32x4*)(mod + (size_t)b * 6144 + 5 * 1024 + cc); lg[j] = *(const f32x4*)(p.ln2g + l * 1024 + cc); lb[j] = *(const f32x4*)(p.ln2b + l * 1024 + cc); }
#pragma unroll
              for (int j = 0; j < 4; ++j) { xa[j] = xa[j] * ALPHA + g2[j] * fa[j]; xb[j] = xb[j] * ALPHA + g2[j] * fb[j]; }
              ln_row_p(xa, lg, lb); ln_row_p(xb, lg, lb); }
            if (l + 1 < NL) {
                st_bf16_c16(xra, xa, lane); st_bf16_c16(xrb, xb, lane);
                f32x4 oa[4], ob[4];
#pragma unroll
                for (int j = 0; j < 4; ++j) { const int cc = 16 * lane + 4 * j; const f32x4 s1 = *(const f32x4*)(modn + (size_t)b * 6144 + 1024 + cc) + 1.f, s0 = *(const f32x4*)(modn + (size_t)b * 6144 + cc); oa[j] = xa[j] * s1 + s0; ob[j] = xb[j] * s1 + s0; }
                st_bf16_c16(H + (size_t)ta * 1024, oa, lane); st_bf16_c16(H + (size_t)tb * 1024, ob, lane);
            } else {
#pragma unroll
                for (int j = 0; j < 4; ++j) { *(f32x4*)(p.out + (size_t)ta * 1024 + 16 * lane + 4 * j) = xa[j]; *(f32x4*)(p.out + (size_t)tb * 1024 + 16 * lane + 4 * j) = xb[j]; } }
        }
    }
}

#ifndef GEMM_BODY
#define GEMM_BODY gemm_mfma
#endif
#ifndef ATTN_BODY
#define ATTN_BODY ph_attn
#endif
#ifndef GB_EpiP
#define GB_EpiP GEMM_BODY
#endif
#ifndef GB_EpiQ
#define GB_EpiQ GEMM_BODY
#endif
#ifndef GB_EpiKV
#define GB_EpiKV GEMM_BODY
#endif
#ifndef GB_EpiOut
#define GB_EpiOut GEMM_BODY
#endif
#ifndef GB_EpiRouter
#define GB_EpiRouter GEMM_BODY
#endif
#ifndef GB_EpiSwiglu
#define GB_EpiSwiglu GEMM_BODY
#endif
#ifndef GB_EpiDown
#define GB_EpiDown GEMM_BODY
#endif

__global__ void __launch_bounds__(NTHREADS, 2) mk_fwd(Params p, int seg_lo, int seg_hi) {
    extern __shared__ __attribute__((aligned(16))) unsigned char lds_raw[];
    Ctx c0; c0.lds = (LAS unsigned char*)lds_raw; c0.tid = threadIdx.x; c0.lane = c0.tid & 63; c0.wid = __builtin_amdgcn_readfirstlane(c0.tid >> 6);
    c0.G = gridDim.x; c0.bid = blockIdx.x; c0.gw = c0.bid * NWAVES + c0.wid; c0.ngw = c0.G * NWAVES;
    volatile LAS unsigned* misc = (volatile LAS unsigned*)(c0.lds + LDS_MISC);
    if (c0.tid < 64) misc[c0.tid] = 0u;
    __syncthreads();
    XcdBarrier bar; { LOAD_Q bar = xcd_barrier_post((unsigned*)(q.ws + WS_CTL) + CW_BAR, misc); }
    LAS int* tp = (LAS int*)(c0.lds + LDS_MISC + 256);
#define IN(k) (seg_lo <= (k) && (k) < seg_hi)
#if defined(PROBE_A)
    volatile LAS unsigned long long* pt = (volatile LAS unsigned long long*)(c0.lds + LDS_MISC + 2048);
    if (c0.wid == 0 && fresh_lane() == 0) { pt[0] = wall_clock64(); pt[1] = 0ull; pt[2] = 0ull; pt[3] = pt[0]; }
#define SEAM(k) do { xcd_barrier(bar); if (c0.bid == 0 && c0.wid == 0 && fresh_lane() == 0) { const unsigned long long t_ = wall_clock64(); const int kind_ = (k) == 0 ? 0 : 1 + ((k) - 1) % PH_PER_LAYER; \
        if ((PROBE_A >> kind_) & 1) pt[1] += t_ - pt[0]; if ((PROBE_B >> kind_) & 1) pt[2] += t_ - pt[0]; pt[0] = t_; } } while (0)
#else
#define SEAM(k) do { if (IN((k) + 1)) xcd_barrier(bar); } while (0)
#endif

    if (IN(0)) { PHASE_Q ph_prologue(q, c); SEAM(0); }
    for (int l = 0; l < NL; ++l) {
        const int sb = 1 + l * PH_PER_LAYER;
        if (IN(sb + 0)) { if (l == 0) { PHASE_Q ph_prep(q, c, l); SEAM(sb + 0); } }
        if (IN(sb + 1)) {
            PHASE_Q
            GemmDesc g{(const GAS bf16_t*)(ws + WS_H), 1024, 1024, 1024};
            DenseSched sc{(const GAS bf16_t*)(ws + WS_WIN) + (size_t)l * 1024 * 1024, 1024, T / 256, 4, c.G, c.bid, nullptr};
            EpiP e{(bf16_t*)(ws + WS_P)};
            GB_EpiP<EpiP::PERM, false>(c.lds, c.wid, g, sc, e); SEAM(sb + 1); }
        if (IN(sb + 2)) { PHASE_Q ph_post_in(q, c, l); SEAM(sb + 2); }
        if (IN(sb + 3)) {
            PHASE_Q
            { GemmDesc g{(const GAS bf16_t*)(ws + WS_P) + 256, 1024, 384, 384};
              DenseSched sc{(const GAS bf16_t*)(ws + WS_WUQ) + (size_t)l * 1280 * 384, 384, T / 256, 5, c.G, c.bid, nullptr};
              EpiQ e{(bf16_t*)(ws + WS_Q), (const float*)(ws + WS_RSQ), (const f32x2*)(ws + WS_CS)};
              GB_EpiQ<EpiQ::PERM, false>(c.lds, c.wid, g, sc, e); }
            { GemmDesc g{(const GAS bf16_t*)(ws + WS_P) + 640, 1024, 256, 256};
              int bid2 = c0.bid, g2 = c0.G; asm volatile("" : "+s"(bid2), "+s"(g2));
              DenseSched sc{(const GAS bf16_t*)(ws + WS_WUKV) + (size_t)l * 1536 * 256, 256, T / 256, 6, g2, g2 - 1 - bid2, nullptr};
              EpiKV e{(bf16_t*)(ws + WS_KF), (bf16_t*)(ws + WS_V), (const float*)(ws + WS_RSKV)};
              GB_EpiKV<EpiKV::PERM, false>(c.lds, c.wid, g, sc, e); }
            SEAM(sb + 3); }
        if (IN(sb + 4)) { PHASE_Q ATTN_BODY(q, c); SEAM(sb + 4); }
        if (IN(sb + 5)) {
            { PHASE_Q ph_fill_lists(q, c); }
            PHASE_Q const float* mod = (const float*)(ws + WS_MOD) + (size_t)l * 16 * 6144;
            GemmDesc g{(const GAS bf16_t*)(ws + WS_MIX), 1024, 1024, 1024};
            DenseSched sc{(const GAS bf16_t*)(ws + WS_WOUT) + (size_t)l * 1024 * 1024, 1024, T / 256, 4, c.G, c.bid, nullptr};
            EpiOut e{(bf16_t*)(ws + WS_X16), mod + 2 * 1024};
            GB_EpiOut<EpiOut::PERM, false>(c.lds, c.wid, g, sc, e); SEAM(sb + 5); }
        if (IN(sb + 6)) { PHASE_Q ph_ln1r(q, c, l); SEAM(sb + 8); }
        if (IN(sb + 9)) {
            PHASE_Q
            moe_build_tiles(tp, (const int*)((unsigned*)(ws + WS_CTL) + CW_CNT + l * 64), c.wid);
            GemmDesc g{(const GAS bf16_t*)(ws + WS_H8), 1024, 1024, 1024};
            MoeSched sc{(const GAS bf16_t*)(ws + WS_WGU), (size_t)512 * 1024 / 2, 1024 / 2, (const GAS int*)(ws + WS_LIST), tp, 2, c.G, c.bid, true, (LAS int*)(c.lds + LDS_MISC + 4096), (const LAS int*)(c.lds + LDS_MISC + 8192)};
            moe_build_units(sc, (LAS int*)(c.lds + LDS_MISC + 8192), c.wid);
            EpiSwiglu e{(unsigned char*)(ws + WS_ACT)};
            GB_EpiSwiglu<EpiSwiglu::PERM, true>(c.lds, c.wid, g, sc, e); SEAM(sb + 9); }
        if (IN(sb + 10)) {
            PHASE_Q
            if (!IN(sb + 9)) moe_build_tiles(tp, (const int*)((unsigned*)(ws + WS_CTL) + CW_CNT + l * 64), c.wid);
            GemmDesc g{(const GAS bf16_t*)(ws + WS_ACT), 256, 256, 256};
            MoeSched sc{(const GAS bf16_t*)(ws + WS_WD), (size_t)1024 * 256 / 2, 256 / 2, (const GAS int*)(ws + WS_LIST), tp, 4, c.G, c.bid, false, (LAS int*)(c.lds + LDS_MISC + 4096), (const LAS int*)(c.lds + LDS_MISC + 8192)};
            moe_build_units(sc, (LAS int*)(c.lds + LDS_MISC + 8192), c.wid);
            EpiDown e{(unsigned char*)(ws + WS_Y), c.lds + LDS_MISC + 10240};
            GB_EpiDown<EpiDown::PERM, true>(c.lds, c.wid, g, sc, e); SEAM(sb + 10); }
        if (IN(sb + 11)) { { PHASE_Q ph_combine(q, c, l); } if (l + 1 < NL) { PHASE_Q ph_prep(q, c, l + 1); } SEAM(sb + 11); }
    }
#if defined(PROBE_A)
    if (c0.bid == 0) { LOAD_Q
        const float tot = (float)(pt[0] - pt[3]), fa = (float)pt[1] / tot, fb = (float)pt[2] / tot;
        const float X = 4.f * exp2f(3.321928f * fa), e = 0.002f * exp2f(3.321928f * fb), dl = sqrtf(e * 128.f);
        const int tid_ = c0.wid * 64 + fresh_lane();
        for (int i = tid_; i < 256 * 1024; i += NTHREADS) q.out[i] += (i & 1) ? dl : -dl;
        __syncthreads();
        if (tid_ == 0) q.out[0] = X;
    }
#endif
#undef IN
#undef SEAM
}

#ifndef MK_ONE_LAUNCH
#define MK_ONE_LAUNCH 1
#endif
extern "C" void kernel_launch(void* const* d_in, const int* in_sizes, int n_in, void* d_out, int out_size, void* d_ws, size_t ws_size, hipStream_t stream) {
    static int grid = 0;
    if (grid == 0) {
        if (n_in != 25 || out_size != T * D || ws_size < WS_END) { fprintf(stderr, "kernel_launch: unexpected shapes (n_in %d out %d ws %zu need %zu)\n", n_in, out_size, ws_size, (size_t)WS_END); grid = -1; return; }
        int dev = 0, cus = 0, per_cu = 0;
        if (hipGetDevice(&dev) != hipSuccess || hipDeviceGetAttribute(&cus, hipDeviceAttributeMultiprocessorCount, dev) != hipSuccess) { grid = -1; return; }
        if (hipFuncSetAttribute((const void*)mk_fwd, hipFuncAttributeMaxDynamicSharedMemorySize, LDS_BYTES) != hipSuccess) { fprintf(stderr, "kernel_launch: hipFuncSetAttribute failed\n"); grid = -1; return; }
        if (hipOccupancyMaxActiveBlocksPerMultiprocessor(&per_cu, (const void*)mk_fwd, NTHREADS, LDS_BYTES) != hipSuccess || per_cu < 1) { fprintf(stderr, "kernel_launch: occupancy query says %d\n", per_cu); }
        (void)hipGetLastError();
        grid = cus;
    }
    if (grid < 0) return;
    (void)hipMemsetAsync((char*)d_ws + WS_CTL, 0, CTL_BYTES, stream);
    Params p{};
    p.x = (const float*)d_in[0]; p.c = (const float*)d_in[1]; p.pos = (const int*)d_in[2];
    p.w_ada = (const float*)d_in[3]; p.b_ada = (const float*)d_in[4]; p.w_in = (const float*)d_in[5]; p.qg = (const float*)d_in[6]; p.kvg = (const float*)d_in[7];
    p.w_uq = (const float*)d_in[8]; p.w_ukv = (const float*)d_in[9]; p.w_pool = (const float*)d_in[10]; p.pool_scale = (const float*)d_in[11]; p.w_out = (const float*)d_in[12];
    p.ln1g = (const float*)d_in[13]; p.ln1b = (const float*)d_in[14]; p.w_router = (const float*)d_in[15]; p.rbias = (const float*)d_in[16];
    p.weg = (const float*)d_in[17]; p.weu = (const float*)d_in[18]; p.wed = (const float*)d_in[19]; p.wsg = (const float*)d_in[20]; p.wsu = (const float*)d_in[21]; p.wsd = (const float*)d_in[22];
    p.ln2g = (const float*)d_in[23]; p.ln2b = (const float*)d_in[24];
    p.out = (float*)d_out; p.ws = (unsigned char*)d_ws;
#if MK_ONE_LAUNCH
    hipLaunchKernelGGL(mk_fwd, dim3(grid), dim3(NTHREADS), LDS_BYTES, stream, p, 0, NSEG);
#else
    for (int s = 0; s < NSEG; ++s) hipLaunchKernelGGL(mk_fwd, dim3(grid), dim3(NTHREADS), LDS_BYTES, stream, p, s, s + 1);
#endif
}
```
